# Optimizing an MI355X kernel written in HIP

```python
import jax
import jax.numpy as jnp
from jax import lax
import numpy as np

D_MODEL = 1024
BATCH = 2
SEQ = 8192
DEPTH = 2
DEC_BATCH = 128
DEC_SEQ = 4
PAST_LEN = 2048
PAGE_SIZE = 128

HEAD_DIM = 64
MIX_WIDTH = D_MODEL
NSA_WIDTH = MIX_WIDTH // 2
GMLP_WIDTH = MIX_WIDTH - NSA_WIDTH
NSA_HEADS = NSA_WIDTH // HEAD_DIM
NSA_KV_HEADS = 2
NSA_GROUP = NSA_HEADS // NSA_KV_HEADS
KV_WIDTH = NSA_KV_HEADS * HEAD_DIM
CMP_BLOCK = 32
CMP_HIDDEN = 4 * HEAD_DIM
SLC_BLOCK = 64
SLC_PER_CMP = SLC_BLOCK // CMP_BLOCK
N_SELECT = 16
WINDOW = 512
QUERY_BLOCK = 128
FORCE_BONUS = 1.0e4
GMLP_GROUPS = 8
GMLP_GROUP_DIM = GMLP_WIDTH // GMLP_GROUPS
GMLP_CHUNK = 128
FFN_HIDDEN = -(-8 * D_MODEL // (3 * 256)) * 256
ROPE_THETA = 10000.0
LN_EPS = 1e-5
DEEPNORM_ALPHA = (2 * DEPTH) ** 0.25
DEEPNORM_BETA = (8 * DEPTH) ** -0.25
NEG_INF = -1e30

O_CMP = NSA_WIDTH
O_SLC = O_CMP + 2 * KV_WIDTH
O_WIN = O_SLC + 2 * KV_WIDTH
O_GATE = O_WIN + 2 * KV_WIDTH
O_GMLP = O_GATE + 3 * NSA_HEADS
P_IN = O_GMLP + 2 * GMLP_WIDTH

kernel_name = 'nsa_gmlp_hybrid_step'


def layer_norm(x, g, b):
    xf = x.astype(jnp.float32)
    mu = jnp.mean(xf, axis=-1, keepdims=True)
    var = jnp.mean(jnp.square(xf - mu), axis=-1, keepdims=True)
    return ((xf - mu) * lax.rsqrt(var + LN_EPS) * g + b).astype(x.dtype)


def rope(x, pos):
    half = HEAD_DIM // 2
    inv_freq = ROPE_THETA ** (-jnp.arange(half, dtype=jnp.float32) / half)
    ang = pos.astype(jnp.float32)[:, None] * inv_freq[None, :]
    cos = jnp.cos(ang)[:, None, :]
    sin = jnp.sin(ang)[:, None, :]
    xf = x.astype(jnp.float32)
    x1, x2 = xf[..., :half], xf[..., half:]
    return jnp.concatenate([x1 * cos - x2 * sin, x2 * cos + x1 * sin], axis=-1).astype(x.dtype)


def rope_k(kv, pos):
    return jnp.stack([rope(kv[:, :, 0], pos), kv[:, :, 1]], axis=2)


def masked_softmax(s, mask):
    s = jnp.where(mask, s, NEG_INF)
    m = jnp.max(s, axis=-1, keepdims=True)
    e = jnp.where(mask, jnp.exp(s - m), 0.0)
    return e / jnp.maximum(jnp.sum(e, axis=-1, keepdims=True), 1e-30)


def project(x, pos, w_in):
    B, T, _ = x.shape
    z = jnp.einsum('btd,dp->btp', x, w_in)
    q = z[..., :O_CMP].reshape(B, T, NSA_HEADS, HEAD_DIM)
    q_raw = q.reshape(B, T, NSA_KV_HEADS, NSA_GROUP, HEAD_DIM)
    q_rot = rope(q, pos).reshape(B, T, NSA_KV_HEADS, NSA_GROUP, HEAD_DIM)
    kv_shape = (B, T, 2, NSA_KV_HEADS, HEAD_DIM)
    cmp_kv = z[..., O_CMP:O_SLC].reshape(kv_shape)
    slc_kv = rope_k(z[..., O_SLC:O_WIN].reshape(kv_shape), pos)
    win_kv = rope_k(z[..., O_WIN:O_GATE].reshape(kv_shape), pos)
    gates = jax.nn.sigmoid(z[..., O_GATE:O_GMLP].astype(jnp.float32)).astype(z.dtype)
    gates = gates.reshape(B, T, 3, NSA_KV_HEADS, NSA_GROUP, 1)
    uv = z[..., O_GMLP:]
    return q_raw, q_rot, cmp_kv, slc_kv, win_kv, gates, uv


def compress_blocks(kv, pe, w1, b1, w2):
    B, L = kv.shape[:2]
    nc = L // CMP_BLOCK
    blk = kv[:, :nc * CMP_BLOCK].reshape(B, nc, CMP_BLOCK, 2, NSA_KV_HEADS, HEAD_DIM)
    blk = blk + jnp.transpose(pe, (1, 0, 2))[None, None, :, :, None, :]
    h = jax.nn.silu(jnp.einsum('bnlkgd,kldh->bnkgh', blk, w1) + b1[:, None, :])
    return jnp.einsum('bnkgh,khd->bnkgd', h, w2)


def selection_blocks(kv):
    B, L = kv.shape[:2]
    ns = -(-L // SLC_BLOCK)
    kv = jnp.pad(kv, ((0, 0), (0, ns * SLC_BLOCK - L), (0, 0), (0, 0), (0, 0)))
    kv = kv.reshape(B, ns, SLC_BLOCK, 2, NSA_KV_HEADS, HEAD_DIM)
    return jnp.transpose(kv, (0, 3, 4, 1, 2, 5))


def nsa_attend(q_raw, q_rot, qpos, ckv, sel_kv, wkv, wpos, gates):
    B, T = q_raw.shape[:2]
    scale = HEAD_DIM ** -0.5
    ck, cv = ckv[:, :, 0], ckv[:, :, 1]
    nc = ck.shape[1]
    s_c = jnp.einsum('btgrd,bngd->btgrn', q_raw, ck).astype(jnp.float32) * scale
    cmp_end = (jnp.arange(nc, dtype=jnp.int32) + 1) * CMP_BLOCK - 1
    c_mask = cmp_end[None, :] <= qpos[:, None]
    p_c = masked_softmax(s_c, c_mask[None, :, None, None, :])
    o_cmp = jnp.einsum('btgrn,bngd->btgrd', p_c.astype(cv.dtype), cv)
    sk, sv = sel_kv[:, 0], sel_kv[:, 1]
    ns = sk.shape[2]
    imp = jnp.sum(p_c, axis=3)
    imp = jnp.pad(imp, ((0, 0), (0, 0), (0, 0), (0, ns * SLC_PER_CMP - nc)))
    imp = imp.reshape(B, T, NSA_KV_HEADS, ns, SLC_PER_CMP).sum(-1)
    blk = jnp.arange(ns, dtype=jnp.int32)[None, :]
    cur = (qpos // SLC_BLOCK)[:, None]
    forced = ((blk == 0) | (blk == cur) | (blk == cur - 1)).astype(jnp.float32)
    valid = blk <= cur
    score = jnp.where(valid[None, :, None, :], imp + FORCE_BONUS * forced[None, :, None, :], -1.0)
    _, idx = lax.top_k(score, min(N_SELECT, ns))
    n_sel = idx.shape[-1]
    sel_ok = idx <= cur[None, :, :, None]
    idx_g = jnp.transpose(idx, (0, 2, 1, 3))
    bi = jnp.arange(B)[:, None, None, None]
    gi = jnp.arange(NSA_KV_HEADS)[None, :, None, None]
    ks = sk[bi, gi, idx_g]
    vs = sv[bi, gi, idx_g]
    s_s = jnp.einsum('btgrd,bgtknd->btgrkn', q_rot, ks).astype(jnp.float32) * scale
    kpos = idx[..., None] * SLC_BLOCK + jnp.arange(SLC_BLOCK, dtype=jnp.int32)
    s_mask = (kpos <= qpos[None, :, None, None, None]) & sel_ok[..., None]
    s_mask = s_mask.reshape(B, T, NSA_KV_HEADS, 1, n_sel * SLC_BLOCK)
    p_s = masked_softmax(s_s.reshape(B, T, NSA_KV_HEADS, NSA_GROUP, n_sel * SLC_BLOCK), s_mask)
    p_s = p_s.reshape(B, T, NSA_KV_HEADS, NSA_GROUP, n_sel, SLC_BLOCK)
    o_slc = jnp.einsum('btgrkn,bgtknd->btgrd', p_s.astype(vs.dtype), vs)
    s_w = jnp.einsum('btgrd,bkgd->btgrk', q_rot, wkv[:, :, 0]).astype(jnp.float32) * scale
    diff = qpos[:, None] - wpos[None, :]
    w_mask = (diff >= 0) & (diff < WINDOW) & (wpos[None, :] >= 0)
    p_w = masked_softmax(s_w, w_mask[None, :, None, None, :])
    o_win = jnp.einsum('btgrk,bkgd->btgrd', p_w.astype(wkv.dtype), wkv[:, :, 1])
    o = gates[:, :, 0] * o_cmp + gates[:, :, 1] * o_slc + gates[:, :, 2] * o_win
    return o.reshape(B, T, NSA_WIDTH)


def gmlp_mix(uv, ln_g, ln_b, ws, bs):
    B, T, _ = uv.shape
    uv = jax.nn.gelu(uv)
    u, v = uv[..., :GMLP_WIDTH], uv[..., GMLP_WIDTH:]
    v = layer_norm(v, ln_g, ln_b)
    c = min(T, GMLP_CHUNK)
    vc = v.reshape(B, T // c, c, GMLP_GROUPS, GMLP_GROUP_DIM)
    w = jnp.tril(ws[:, :c, :c])
    s = jnp.einsum('hts,bnshd->bnthd', w, vc) + jnp.transpose(bs[:, :c])[None, None, :, :, None]
    return u * s.reshape(B, T, GMLP_WIDTH), v


def prompt_mixer(x, w_in, cmp_pe, cmp_w1, cmp_b1, cmp_w2, gmlp_ln_g, gmlp_ln_b, gmlp_ws, gmlp_bs):
    B, T, _ = x.shape
    pos = jnp.arange(T, dtype=jnp.int32)
    q_raw, q_rot, cmp_kv, slc_kv, win_kv, gates, uv = project(x, pos, w_in)
    ckv = compress_blocks(cmp_kv, cmp_pe, cmp_w1, cmp_b1, cmp_w2)
    sel_kv = selection_blocks(slc_kv)
    win_pad = jnp.pad(win_kv, ((0, 0), (WINDOW, 0), (0, 0), (0, 0), (0, 0)))
    nb = T // QUERY_BLOCK

    def to_blocks(a):
        return jnp.moveaxis(a.reshape((B, nb, QUERY_BLOCK) + a.shape[2:]), 1, 0)

    def attend_block(args):
        i, qr, qo, gt = args
        start = i * QUERY_BLOCK
        qpos = start + jnp.arange(QUERY_BLOCK, dtype=jnp.int32)
        wkv = lax.dynamic_slice_in_dim(win_pad, start, WINDOW + QUERY_BLOCK, axis=1)
        wpos = start - WINDOW + jnp.arange(WINDOW + QUERY_BLOCK, dtype=jnp.int32)
        return nsa_attend(qr, qo, qpos, ckv, sel_kv, wkv, wpos, gt)

    o = lax.map(attend_block, (jnp.arange(nb, dtype=jnp.int32), to_blocks(q_raw), to_blocks(q_rot), to_blocks(gates)))
    o_nsa = jnp.moveaxis(o, 0, 1).reshape(B, T, NSA_WIDTH)
    o_gmlp, _ = gmlp_mix(uv, gmlp_ln_g, gmlp_ln_b, gmlp_ws, gmlp_bs)
    n_keep = min(WINDOW, T)
    return jnp.concatenate([o_nsa, o_gmlp], axis=-1), cmp_kv, slc_kv, win_kv[:, T - n_keep:]


def sample_mixer(x, pool_cmp, pool_slc, win_buf, page_table, w_in, cmp_pe, cmp_w1, cmp_b1, cmp_w2,
                 gmlp_ln_g, gmlp_ln_b, gmlp_ws, gmlp_bs):
    B, S, _ = x.shape
    past = page_table.shape[1] * PAGE_SIZE
    pos = past + jnp.arange(S, dtype=jnp.int32)
    q_raw, q_rot, cmp_kv, slc_kv, win_kv, gates, uv = project(x, pos, w_in)
    kv_tail = (2, NSA_KV_HEADS, HEAD_DIM)
    past_cmp = pool_cmp[page_table].reshape((B, past) + kv_tail)
    past_slc = pool_slc[page_table].reshape((B, past) + kv_tail)
    ckv = compress_blocks(jnp.concatenate([past_cmp, cmp_kv], axis=1), cmp_pe, cmp_w1, cmp_b1, cmp_w2)
    sel_kv = selection_blocks(jnp.concatenate([past_slc, slc_kv], axis=1))
    n_buf = win_buf.shape[1]
    wkv = jnp.concatenate([win_buf, win_kv], axis=1)
    wpos = past - n_buf + jnp.arange(n_buf + S, dtype=jnp.int32)
    o_nsa = nsa_attend(q_raw, q_rot, pos, ckv, sel_kv, wkv, wpos, gates)
    o_gmlp, v_rows = gmlp_mix(uv, gmlp_ln_g, gmlp_ln_b, gmlp_ws, gmlp_bs)
    return jnp.concatenate([o_nsa, o_gmlp], axis=-1), cmp_kv, slc_kv, wkv[:, S:], v_rows


def residual_ffn(x, mix, w_out, ln1_g, ln1_b, w_gate, w_up, w_down, ln2_g, ln2_b):
    h = jnp.einsum('btm,md->btd', mix, w_out)
    x = layer_norm(DEEPNORM_ALPHA * x + h, ln1_g, ln1_b)
    f = jax.nn.silu(jnp.einsum('btd,df->btf', x, w_gate)) * jnp.einsum('btd,df->btf', x, w_up)
    f = jnp.einsum('btf,fd->btd', f, w_down)
    return layer_norm(DEEPNORM_ALPHA * x + f, ln2_g, ln2_b)


def setup_inputs(seed: int = 0) -> dict:
    key = jax.random.key(seed)
    ks = jax.random.split(key, 24)
    n_pages = PAST_LEN // PAGE_SIZE
    n_used = DEC_BATCH * n_pages
    n_pool = n_used + n_used // 4
    w_buf = min(WINDOW, PAST_LEN)

    def nrm(k, shape, scale):
        return jax.random.normal(k, shape, jnp.float32) * scale

    col_scale = np.ones((P_IN,), np.float32)
    for off in (O_CMP, O_SLC, O_WIN):
        col_scale[off + KV_WIDTH: off + 2 * KV_WIDTH] = DEEPNORM_BETA
    kv_page = (DEPTH, n_pool, PAGE_SIZE, 2, NSA_KV_HEADS, HEAD_DIM)
    return {
        'x_prompt': nrm(ks[0], (BATCH, SEQ, D_MODEL), 1.0),
        'x_sample': nrm(ks[1], (DEC_BATCH, DEC_SEQ, D_MODEL), 1.0),
        'cache_cmp_kv': nrm(ks[2], kv_page, 1.0),
        'cache_slc_kv': nrm(ks[3], kv_page, 1.0),
        'state_win_kv': nrm(ks[4], (DEPTH, DEC_BATCH, w_buf, 2, NSA_KV_HEADS, HEAD_DIM), 1.0),
        'page_table': jax.random.permutation(ks[5], n_pool)[:n_used].reshape(DEC_BATCH, n_pages).astype(jnp.int32),
        'w_in': nrm(ks[6], (DEPTH, D_MODEL, P_IN), D_MODEL ** -0.5) * jnp.asarray(col_scale),
        'cmp_pe': nrm(ks[7], (DEPTH, 2, CMP_BLOCK, HEAD_DIM), 0.1),
        'cmp_w1': nrm(ks[8], (DEPTH, 2, CMP_BLOCK, HEAD_DIM, CMP_HIDDEN), (CMP_BLOCK * HEAD_DIM) ** -0.5),
        'cmp_b1': nrm(ks[9], (DEPTH, 2, CMP_HIDDEN), 0.01),
        'cmp_w2': nrm(ks[10], (DEPTH, 2, CMP_HIDDEN, HEAD_DIM), CMP_HIDDEN ** -0.5),
        'gmlp_ln_g': 1.0 + nrm(ks[11], (DEPTH, GMLP_WIDTH), 0.01),
        'gmlp_ln_b': nrm(ks[12], (DEPTH, GMLP_WIDTH), 0.01),
        'gmlp_ws': nrm(ks[13], (DEPTH, GMLP_GROUPS, GMLP_CHUNK, GMLP_CHUNK), GMLP_CHUNK ** -0.5),
        'gmlp_bs': 1.0 + nrm(ks[14], (DEPTH, GMLP_GROUPS, GMLP_CHUNK), 0.01),
        'w_out': nrm(ks[15], (DEPTH, MIX_WIDTH, D_MODEL), MIX_WIDTH ** -0.5 * DEEPNORM_BETA),
        'ln1_g': 1.0 + nrm(ks[16], (DEPTH, D_MODEL), 0.01),
        'ln1_b': nrm(ks[17], (DEPTH, D_MODEL), 0.01),
        'w_gate': nrm(ks[18], (DEPTH, D_MODEL, FFN_HIDDEN), D_MODEL ** -0.5),
        'w_up': nrm(ks[19], (DEPTH, D_MODEL, FFN_HIDDEN), D_MODEL ** -0.5),
        'w_down': nrm(ks[20], (DEPTH, FFN_HIDDEN, D_MODEL), FFN_HIDDEN ** -0.5 * DEEPNORM_BETA),
        'ln2_g': 1.0 + nrm(ks[21], (DEPTH, D_MODEL), 0.01),
        'ln2_b': nrm(ks[22], (DEPTH, D_MODEL), 0.01),
    }


def reference(x_prompt, x_sample, cache_cmp_kv, cache_slc_kv, state_win_kv, page_table,
              w_in, cmp_pe, cmp_w1, cmp_b1, cmp_w2, gmlp_ln_g, gmlp_ln_b, gmlp_ws, gmlp_bs,
              w_out, ln1_g, ln1_b, w_gate, w_up, w_down, ln2_g, ln2_b):
    yp, ys = x_prompt, x_sample
    p_cmp, p_slc, p_win = [], [], []
    s_cmp, s_slc, s_win, s_v = [], [], [], []
    for l in range(DEPTH):
        mix_p, pc, psl, pw = prompt_mixer(yp, w_in[l], cmp_pe[l], cmp_w1[l], cmp_b1[l], cmp_w2[l],
                                          gmlp_ln_g[l], gmlp_ln_b[l], gmlp_ws[l], gmlp_bs[l])
        mix_s, sc, ssl, sw, sv = sample_mixer(ys, cache_cmp_kv[l], cache_slc_kv[l], state_win_kv[l], page_table,
                                              w_in[l], cmp_pe[l], cmp_w1[l], cmp_b1[l], cmp_w2[l],
                                              gmlp_ln_g[l], gmlp_ln_b[l], gmlp_ws[l], gmlp_bs[l])
        yp = residual_ffn(yp, mix_p, w_out[l], ln1_g[l], ln1_b[l], w_gate[l], w_up[l], w_down[l], ln2_g[l], ln2_b[l])
        ys = residual_ffn(ys, mix_s, w_out[l], ln1_g[l], ln1_b[l], w_gate[l], w_up[l], w_down[l], ln2_g[l], ln2_b[l])
        p_cmp.append(pc)
        p_slc.append(psl)
        p_win.append(pw)
        s_cmp.append(sc)
        s_slc.append(ssl)
        s_win.append(sw)
        s_v.append(sv)
    return (yp, ys, jnp.stack(p_cmp), jnp.stack(p_slc), jnp.stack(p_win),
            jnp.stack(s_cmp), jnp.stack(s_slc), jnp.stack(s_win), jnp.stack(s_v))
```

```cpp
#include <hip/hip_runtime.h>
#include <cstdio>
#include <cstdint>
#include <cmath>
namespace pg8 {
#define PG8_LAS __attribute__((address_space(3)))
typedef unsigned short bf16_t;
typedef short bf16x8 __attribute__((ext_vector_type(8)));
typedef float f32x4 __attribute__((ext_vector_type(4)));
typedef unsigned u32x4 __attribute__((ext_vector_type(4)));
constexpr int BM = 256, BK = 64, HALF = 128, HTB = HALF * BK * 2  , STAGE_BYTES = 8 * HTB, NXCD = 8, WGM = 8;

__host__ __device__ __forceinline__ int lds_byte(int r, int c) { const int st = (r >> 4) * 2 + (c >> 5), rr = r & 15, cc = c & 31, ob = rr * 64 + cc * 2; return st * 1024 + (ob ^ (((ob >> 9) & 1) << 5)); }
__host__ __device__ __forceinline__ void stage_rc(int b, int& R, int& C) { const int st = b / 1024, sb = b % 1024, swz = sb ^ (((sb >> 9) & 1) << 5); R = (st >> 1) * 16 + swz / 64; C = (st & 1) * 32 + (swz % 64) / 2; }
__host__ __device__ __forceinline__ int perm32(int rho) { const int n = rho >> 4, i = rho & 15; return 8 * (i >> 2) + 4 * n + (i & 3); }

struct Unit { int pm, pn; };
struct Gemm { const bf16_t* A; const bf16_t* Bt; int M, N, K; };

struct StaticOrder {
    int nM, nN, nwg, G, c;
    __host__ __device__ void init(int M, int N, int G_, int c_) { nM = M / BM; nN = N / BM; nwg = nM * nN; G = G_; c = c_; }
    __host__ __device__ bool next(int i, Unit& u) const {
        const long L = (long)i * G + c; if (L >= nwg) return false;
        int wgid = (int)L; { const int q = nwg / NXCD, r = nwg % NXCD, xcd = wgid % NXCD, off = wgid / NXCD; wgid = (xcd < r ? xcd * (q + 1) : r * (q + 1) + (xcd - r) * q) + off; }
        const int nig = WGM * nN, gid = wgid / nig, fm = gid * WGM, gsz = (nM - fm) < WGM ? (nM - fm) : WGM;
        u.pm = fm + ((wgid % nig) % gsz); u.pn = (wgid % nig) / gsz; return true;
    }
    __device__ __forceinline__ void a_ready(const Unit&) const {}
    __device__ __forceinline__ void done(const Unit&) const {}
};
__device__ __forceinline__ unsigned cvt_pk_bf16(float lo, float hi) { unsigned r; asm volatile("v_cvt_pk_bf16_f32 %0, %1, %2" : "=v"(r) : "v"(lo), "v"(hi)); return r; }
typedef float f32x2 __attribute__((ext_vector_type(2)));
template <class Epi, class Sched, bool ALIGN_EPI = false, bool SP2 = false>
__device__ __forceinline__ void gemm_phase(PG8_LAS unsigned char* lds, const Gemm g, const Sched& S, const Epi& E) {
    int tid_ = threadIdx.x; asm volatile("" : "+v"(tid_));
    const int tid = tid_, wid = __builtin_amdgcn_readfirstlane(tid >> 6), lane = tid & 63, wr = wid >> 2, wc = wid & 3, fr = lane & 15, fq = lane >> 4;
    const int K = g.K, nt = K / BK;
    unsigned voffA[2], voffB[2];
#pragma unroll
    for (int i = 0; i < 2; ++i) { int R, C; stage_rc(tid * 16 + i * 8192, R, C); const int Rb = Epi::PERM ? ((R & ~31) + perm32(R & 31)) : R;
        voffA[i] = (unsigned)(R * K + C) * 2u; voffB[i] = (unsigned)(Rb * K + C) * 2u; }
    const size_t kstep = (size_t)(BK * 2);
    const size_t hstep = (size_t)HALF * K * 2;
    const size_t tstep = 2 * hstep;
    const unsigned ldsw = (unsigned)wid * 1024u;
    const int aoff = lds_byte(wr * 64 + fr, fq * 8), boff = lds_byte(wc * 32 + fr, fq * 8);
#define PG8_SA(b, h) (((b) * 2 + (h)) * HTB)
#define PG8_SB(b, h) ((4 + (b) * 2 + (h)) * HTB)
#define PG8_STAGE(bufoff, gbase, voff) do { _Pragma("unroll") for (int _i = 0; _i < 2; ++_i) \
        __builtin_amdgcn_global_load_lds((const unsigned*)((const char*)(gbase) + (voff)[_i]), (PG8_LAS unsigned*)(lds + (bufoff) + ldsw + _i * 8192), 16, 0, 0); } while (0)
#define PG8_LDA(dst, b, h) do { _Pragma("unroll") for (int m = 0; m < 4; ++m) _Pragma("unroll") for (int k = 0; k < 2; ++k) dst[m][k] = *(const PG8_LAS bf16x8*)(lds + PG8_SA(b, h) + aoff + m * 2048 + k * 1024); } while (0)
#define PG8_LDB(dst, b, h) do { _Pragma("unroll") for (int n = 0; n < 2; ++n) _Pragma("unroll") for (int k = 0; k < 2; ++k) dst[n][k] = *(const PG8_LAS bf16x8*)(lds + PG8_SB(b, h) + boff + n * 2048 + k * 1024); } while (0)
#define PG8_MMA(ai, bj, At, Bt) do { __builtin_amdgcn_s_setprio(1); _Pragma("unroll") for (int m = 0; m < 4; ++m) _Pragma("unroll") for (int n = 0; n < 2; ++n) _Pragma("unroll") for (int k = 0; k < 2; ++k) \
        acc[ai][bj][m][n] = __builtin_amdgcn_mfma_f32_16x16x32_bf16(Bt[n][k], At[m][k], acc[ai][bj][m][n], 0, 0, 0); __builtin_amdgcn_s_setprio(0); } while (0)
#define PG8_WAIT_V(n) asm volatile("s_waitcnt vmcnt(" #n ")" ::: "memory")
#define PG8_WAIT_L(n) asm volatile("s_waitcnt lgkmcnt(" #n ")" ::: "memory")
#define PG8_BAR __builtin_amdgcn_s_barrier()
#define PG8_SCHED __builtin_amdgcn_sched_barrier(0)
    Unit cur, nxt; int ui = 0;
    if (!S.next(0, cur)) return;
    f32x4 acc[2][2][4][2];
#pragma unroll
    for (int a = 0; a < 2; ++a)
#pragma unroll
        for (int b = 0; b < 2; ++b)
#pragma unroll
            for (int m = 0; m < 4; ++m)
#pragma unroll
                for (int n = 0; n < 2; ++n) acc[a][b][m][n] = (f32x4){0.f, 0.f, 0.f, 0.f};
    bf16x8 At[4][2], B0[2][2], B1[2][2];
    const char* cA = (const char*)g.A + (size_t)cur.pm * tstep; const char* cB = (const char*)g.Bt + (size_t)cur.pn * tstep;
    S.a_ready(cur);
    if constexpr (SP2) {
        PG8_STAGE(PG8_SB(0, 0), cB, voffB); PG8_STAGE(PG8_SB(0, 1), cB + hstep, voffB); PG8_STAGE(PG8_SA(0, 0), cA, voffA); PG8_STAGE(PG8_SA(0, 1), cA + hstep, voffA);
        if (wr == 1) PG8_BAR;
        PG8_WAIT_V(2); PG8_BAR;
        PG8_STAGE(PG8_SB(1, 0), cB + kstep, voffB); PG8_STAGE(PG8_SA(1, 0), cA + kstep, voffA); PG8_STAGE(PG8_SB(1, 1), cB + hstep + kstep, voffB);
        PG8_WAIT_V(6); PG8_BAR;
    } else {
        PG8_STAGE(PG8_SB(0, 0), cB, voffB); PG8_STAGE(PG8_SA(0, 0), cA, voffA); PG8_STAGE(PG8_SB(0, 1), cB + hstep, voffB); PG8_STAGE(PG8_SA(0, 1), cA + hstep, voffA);
        if (wr == 1) PG8_BAR;
        PG8_WAIT_V(4); PG8_BAR;
        PG8_STAGE(PG8_SB(1, 0), cB + kstep, voffB); PG8_STAGE(PG8_SA(1, 0), cA + kstep, voffA); PG8_STAGE(PG8_SB(1, 1), cB + hstep + kstep, voffB);
        PG8_WAIT_V(6); PG8_BAR;
    }
    for (;;) {
        const bool has_next = S.next(ui + 1, nxt);
        const char* nA = has_next ? (const char*)g.A + (size_t)nxt.pm * tstep : cA; const char* nB = has_next ? (const char*)g.Bt + (size_t)nxt.pn * tstep : cB;
        for (int t = 0; t < nt; t += 2) {
            const bool last = (t == nt - 2);
            const char* a1 = cA + (size_t)(t + 1) * kstep;
            const char* a2 = last ? nA : cA + (size_t)(t + 2) * kstep; const char* b2 = last ? nB : cB + (size_t)(t + 2) * kstep;
            const char* a3 = a2 + kstep; const char* b3 = b2 + kstep;
            if (last && has_next) S.a_ready(nxt);
            if constexpr (SP2) {
            PG8_LDB(B0, 0, 0); PG8_LDB(B1, 0, 1); PG8_SCHED; PG8_LDA(At, 0, 0); PG8_STAGE(PG8_SA(1, 1), a1 + hstep, voffA);
            PG8_WAIT_V(8); PG8_WAIT_L(0); PG8_BAR; PG8_MMA(0, 0, At, B0); PG8_MMA(0, 1, At, B1); PG8_BAR; PG8_SCHED;
            PG8_LDA(At, 0, 1); PG8_STAGE(PG8_SB(0, 0), b2, voffB); PG8_STAGE(PG8_SB(0, 1), b2 + hstep, voffB); PG8_STAGE(PG8_SA(0, 0), a2, voffA);
            PG8_WAIT_V(8); PG8_WAIT_L(0); PG8_BAR; PG8_MMA(1, 0, At, B0); PG8_MMA(1, 1, At, B1); PG8_BAR; PG8_SCHED;
            PG8_LDB(B0, 1, 0); PG8_LDB(B1, 1, 1); PG8_SCHED; PG8_LDA(At, 1, 0); PG8_STAGE(PG8_SA(0, 1), a2 + hstep, voffA);
            PG8_WAIT_V(8); PG8_WAIT_L(0); PG8_BAR; PG8_MMA(0, 0, At, B0); PG8_MMA(0, 1, At, B1); PG8_BAR; PG8_SCHED;
            PG8_LDA(At, 1, 1); PG8_STAGE(PG8_SB(1, 0), b3, voffB); PG8_STAGE(PG8_SB(1, 1), b3 + hstep, voffB); PG8_STAGE(PG8_SA(1, 0), a3, voffA);
            PG8_WAIT_V(8); PG8_WAIT_L(0); PG8_BAR; PG8_MMA(1, 0, At, B0); PG8_MMA(1, 1, At, B1); PG8_BAR; PG8_SCHED;
            } else {
            PG8_LDB(B0, 0, 0); PG8_SCHED; PG8_LDA(At, 0, 0); PG8_STAGE(PG8_SA(1, 1), a1 + hstep, voffA);
            PG8_WAIT_L(8); PG8_BAR; PG8_WAIT_L(0); PG8_MMA(0, 0, At, B0); PG8_BAR; PG8_SCHED;
            PG8_LDB(B1, 0, 1); PG8_STAGE(PG8_SB(0, 0), b2, voffB);
            PG8_BAR; PG8_WAIT_L(0); PG8_MMA(0, 1, At, B1); PG8_BAR;
            PG8_LDA(At, 0, 1); PG8_STAGE(PG8_SA(0, 0), a2, voffA);
            PG8_BAR; PG8_WAIT_L(0); PG8_MMA(1, 0, At, B0); PG8_BAR; PG8_SCHED;
            PG8_STAGE(PG8_SB(0, 1), b2 + hstep, voffB);
            PG8_WAIT_V(6); PG8_BAR; PG8_MMA(1, 1, At, B1); PG8_BAR;
            PG8_LDB(B0, 1, 0); PG8_SCHED; PG8_LDA(At, 1, 0); PG8_STAGE(PG8_SA(0, 1), a2 + hstep, voffA);
            PG8_WAIT_L(8); PG8_BAR; PG8_WAIT_L(0); PG8_MMA(0, 0, At, B0); PG8_BAR; PG8_SCHED;
            PG8_LDB(B1, 1, 1); PG8_STAGE(PG8_SB(1, 0), b3, voffB);
            PG8_BAR; PG8_WAIT_L(0); PG8_MMA(0, 1, At, B1); PG8_BAR;
            PG8_LDA(At, 1, 1); PG8_STAGE(PG8_SA(1, 0), a3, voffA);
            PG8_BAR; PG8_WAIT_L(0); PG8_MMA(1, 0, At, B0); PG8_BAR; PG8_SCHED;
            PG8_STAGE(PG8_SB(1, 1), b3 + hstep, voffB);
            PG8_WAIT_V(6); PG8_BAR; PG8_MMA(1, 1, At, B1); PG8_BAR;
            }
        }
        if constexpr (ALIGN_EPI) { if (wr == 0) PG8_BAR; }
        if constexpr (!Epi::AFTER_DRAIN) { E(acc, cur, wr, wc, fr, fq); S.done(cur); }
        if (!has_next) break;
#pragma unroll
        for (int a = 0; a < 2; ++a)
#pragma unroll
            for (int b = 0; b < 2; ++b)
#pragma unroll
                for (int m = 0; m < 4; ++m)
#pragma unroll
                    for (int n = 0; n < 2; ++n) acc[a][b][m][n] = (f32x4){0.f, 0.f, 0.f, 0.f};
        cur = nxt; cA = nA; cB = nB; ++ui;
        if constexpr (ALIGN_EPI) { if (wr == 1) PG8_BAR; }
    }
    PG8_WAIT_V(0);
    if constexpr (!ALIGN_EPI) { if (wr == 0) PG8_BAR; }
    PG8_BAR;
    if constexpr (Epi::AFTER_DRAIN) { E.fused(acc, cur, wr, wc, fr, fq, lds, wid, lane); S.done(cur); }
#undef PG8_SA
#undef PG8_SB
#undef PG8_STAGE
#undef PG8_LDA
#undef PG8_LDB
#undef PG8_MMA
#undef PG8_WAIT_V
#undef PG8_WAIT_L
#undef PG8_BAR
#undef PG8_SCHED
}
}
#define GAS __attribute__((address_space(1)))
#define LAS __attribute__((address_space(3)))
typedef unsigned short bf16;
typedef unsigned v4u __attribute__((ext_vector_type(4)));
typedef float f32x4 __attribute__((ext_vector_type(4)));
typedef short bf16x8 __attribute__((ext_vector_type(8)));
typedef GAS unsigned gu32;
typedef GAS unsigned long long gu64;
#define RLX_AGENT __ATOMIC_RELAXED, __HIP_MEMORY_SCOPE_AGENT
#define LDS_WAIT() asm volatile("s_waitcnt lgkmcnt(0)" ::: "memory")
#define VM_WAIT() asm volatile("s_waitcnt vmcnt(0)" ::: "memory")
__device__ __forceinline__ unsigned long long rt() { return __builtin_amdgcn_s_memrealtime(); }
__device__ __forceinline__ unsigned f2bf(float f) { unsigned u = __builtin_bit_cast(unsigned, f); return (u + 0x7fffu + ((u >> 16) & 1u)) >> 16; }
__device__ __forceinline__ unsigned pk2(float lo, float hi) { return f2bf(lo) | (f2bf(hi) << 16); }

#define XB_TMO      128
#define XB_XCNT(j)  (256  + 64 * (j))
#define XB_XSUB(j)  (1280 + 64 * (j))
#define XB_XGEN(j)  (2304 + 64 * (j))
#define XB_TOP      3328
#define XB_TOPGEN   3392
#define XCD_BAR_WORDS 3456
#define XB_SPIN_CAP (1u << 18)

__device__ __forceinline__ unsigned xb_ld(unsigned* p)              { return __hip_atomic_load(p, __ATOMIC_RELAXED, __HIP_MEMORY_SCOPE_AGENT); }
__device__ __forceinline__ unsigned xb_add(unsigned* p, unsigned v) { return __hip_atomic_fetch_add(p, v, __ATOMIC_RELAXED, __HIP_MEMORY_SCOPE_AGENT); }
__device__ __forceinline__ unsigned xb_xcc_id() { return (unsigned)__builtin_amdgcn_s_getreg((3 << 11) | 20) & 0xFu; }
#define XB_SPIN(cond, bar) do { unsigned _sp = 0; while (cond) { __builtin_amdgcn_s_sleep(1); \
    if ((++_sp & 255u) == 0u) { if (xb_ld(&(bar)[XB_TMO])) break; if (_sp > XB_SPIN_CAP) { atomicAdd(&(bar)[XB_TMO], 1u); break; } } } } while (0)

struct XcdBarrier {
    unsigned* bar; unsigned x;
    volatile LAS unsigned* st;
};

__device__ __forceinline__ XcdBarrier xcd_barrier_post(unsigned* bar, volatile LAS unsigned* st) {
    XcdBarrier b; b.bar = bar; b.x = xb_xcc_id(); b.st = st;
    if (threadIdx.x == 0) (void)xb_add(&bar[XB_XCNT(b.x)], 1u);
    return b;
}
__device__ __forceinline__ void xcd_barrier_complete(unsigned* bar, unsigned x, unsigned& nloc, unsigned& nx) {
    const unsigned G = gridDim.x * gridDim.y * gridDim.z;
    unsigned sum, cnt, mine, sp = 0u;
    for (;;) {
        sum = 0u; cnt = 0u; mine = 0u;
#pragma unroll
        for (unsigned j = 0; j < 16; ++j) { const unsigned c = xb_ld(&bar[XB_XCNT(j)]); sum += c; cnt += (c > 0u) ? 1u : 0u; mine = (j == x) ? c : mine; }
        if (sum == G) break;
        __builtin_amdgcn_s_sleep(1);
        if ((++sp & 255u) == 0u) { if (xb_ld(&bar[XB_TMO])) break; if (sp > XB_SPIN_CAP) { atomicAdd(&bar[XB_TMO], 1u); break; } }
    }
    nloc = mine > 0u ? mine : 1u; nx = cnt > 0u ? cnt : 1u;
}

__device__ __forceinline__ void xcd_barrier(const XcdBarrier& b) {
    asm volatile("s_waitcnt vmcnt(0)" ::: "memory");
    __syncthreads();
    if (threadIdx.x == 0) {
        unsigned* bar = b.bar;
        __builtin_amdgcn_s_waitcnt(0);
        unsigned nloc = b.st[0], nx = b.st[1];
        if (nloc == 0u) { xcd_barrier_complete(bar, b.x, nloc, nx); b.st[0] = nloc; b.st[1] = nx; }
        const unsigned old = xb_add(&bar[XB_XSUB(b.x)], 1u);
        const unsigned gen = old / nloc;
        if (old + 1u == (gen + 1u) * nloc) {
            __builtin_amdgcn_fence(__ATOMIC_RELEASE, "agent");
            asm volatile("s_waitcnt vmcnt(0)" ::: "memory");
            const unsigned og = xb_add(&bar[XB_TOP], 1u);
            const unsigned tg = og / nx;
            if (og + 1u == (tg + 1u) * nx) xb_add(&bar[XB_TOPGEN], 1u);
            else XB_SPIN(xb_ld(&bar[XB_TOPGEN]) == tg, bar);
            __builtin_amdgcn_fence(__ATOMIC_ACQUIRE, "agent");
            xb_add(&bar[XB_XGEN(b.x)], 1u);
            asm volatile("s_waitcnt vmcnt(0)" ::: "memory");
        } else {
            XB_SPIN(xb_ld(&bar[XB_XGEN(b.x)]) == gen, bar);
            __builtin_amdgcn_fence(__ATOMIC_ACQUIRE, "agent");
            asm volatile("s_waitcnt vmcnt(0)" ::: "memory");
        }
    }
    __syncthreads();
}
constexpr int DM = 1024;
constexpr int TP = 8192, BP = 2, MP = BP * TP;
constexpr int NB_S = 128, SS = 4, MS = NB_S * SS;
constexpr int MT = MP + MS;
constexpr int PIN = 2328, NIN = 2560;
constexpr int FFN = 2816, NGU = 2 * FFN;
constexpr int PAST = 2048, PAGE = 128, NPG = PAST / PAGE, NPOOL = 2560;
constexpr int KVW = 256;
constexpr int NLAYER = 2;
constexpr float LN_EPS = 1e-5f;
constexpr float DN_ALPHA = 1.4142135623730951f;

constexpr size_t O_Y = 0;
constexpr size_t O_CMPP = (size_t)MT * DM;
constexpr size_t O_SLCP = O_CMPP + (size_t)NLAYER * MP * KVW;
constexpr size_t O_WINP = O_SLCP + (size_t)NLAYER * MP * KVW;
constexpr size_t O_CMPS = O_WINP + (size_t)NLAYER * BP * 512 * KVW;
constexpr size_t O_SLCS = O_CMPS + (size_t)NLAYER * MS * KVW;
constexpr size_t O_WINS = O_SLCS + (size_t)NLAYER * MS * KVW;
constexpr size_t O_GV = O_WINS + (size_t)NLAYER * NB_S * 512 * KVW;
constexpr size_t O_END = O_GV + (size_t)NLAYER * MS * 512;
static_assert(O_END == 69206016, "output size");

constexpr size_t MiB = 1u << 20;
constexpr size_t WS_CTL = 0, CTL_ZERO_BYTES = 1 * MiB;
constexpr size_t WS_ROPE = 1 * MiB;
constexpr size_t WS_WIN_T = 4 * MiB;
constexpr size_t WS_WOUT_T = 14 * MiB;
constexpr size_t WS_WGU_T = 18 * MiB;
constexpr size_t WS_WDN_T = 40 * MiB;
constexpr size_t WS_W1C_T = 52 * MiB;
constexpr size_t WS_W2C_T = 56 * MiB;
constexpr size_t WS_GWP = 57 * MiB;
constexpr size_t WS_GWS = 58 * MiB;
constexpr size_t WS_GBS = 59 * MiB;
constexpr size_t WS_XF = 64 * MiB;
constexpr size_t WS_XB = 130 * MiB;
constexpr size_t WS_PRE = 163 * MiB;
constexpr size_t WS_QRAW = 229 * MiB;
constexpr size_t WS_QROT = 246 * MiB;
constexpr size_t WS_KS = 263 * MiB;
constexpr size_t WS_VS = 267 * MiB;
constexpr size_t WS_KW = 271 * MiB;
constexpr size_t WS_VW = 275 * MiB;
constexpr size_t WS_U = 279 * MiB;
constexpr size_t WS_V = 296 * MiB;
constexpr size_t WS_GATES = 313 * MiB;
constexpr size_t WS_CKP = 315 * MiB;
constexpr size_t WS_CVP = WS_CKP + 512 * 1024;
constexpr size_t WS_CKS = 316 * MiB;
constexpr size_t WS_CVS = 320 * MiB;
constexpr size_t WS_MIX = 324 * MiB;
constexpr size_t WS_F = 357 * MiB;
constexpr size_t WS_END = 448 * MiB;
static_assert(WS_XF + (size_t)MT * DM * 4 <= WS_XB && WS_XB + (size_t)MT * DM * 2 <= WS_PRE && WS_PRE + (size_t)MT * DM * 4 <= WS_QRAW, "ws map 1");
static_assert(WS_QRAW + (size_t)MT * 512 * 2 <= WS_QROT && WS_QROT + (size_t)MT * 512 * 2 <= WS_KS && WS_U + (size_t)MT * 512 * 2 <= WS_V && WS_V + (size_t)MT * 512 * 2 <= WS_GATES, "ws map 2");
static_assert(WS_GATES + (size_t)MT * 24 * 4 <= WS_CKP && WS_MIX + (size_t)MT * DM * 2 <= WS_F && WS_F + (size_t)MT * FFN * 2 <= WS_END, "ws map 3");
static_assert(WS_WIN_T + (size_t)2 * NIN * DM * 2 <= WS_WOUT_T && WS_WGU_T + (size_t)2 * NGU * DM * 2 <= WS_WDN_T && WS_WDN_T + (size_t)2 * DM * FFN * 2 <= WS_W1C_T, "ws map 4");

constexpr int CW_TMO = 0, CW_CODE = 1;
constexpr int CW_BAR = 4096;

constexpr int NWAVES = 8;
constexpr int RING_OFF = 0, RING_BYTES = 131072;
constexpr int LDSCTL_OFF = RING_BYTES, MISC_OFF = LDSCTL_OFF + 320;
constexpr int LDS_BYTES = 147456;

constexpr int PH_P0A = 0, PH_P0B = 1, PH_L0 = 2, PH_PER_LAYER = 8, N_PHASES = PH_L0 + NLAYER * PH_PER_LAYER;
typedef float f32x2 __attribute__((ext_vector_type(2)));
typedef unsigned u32x2 __attribute__((ext_vector_type(2)));
__device__ __forceinline__ float bf2f(unsigned short h) { return __uint_as_float(((unsigned)h) << 16); }
__device__ __forceinline__ float bflo(unsigned w) { return __uint_as_float(w << 16); }
__device__ __forceinline__ float bfhi(unsigned w) { return __uint_as_float(w & 0xffff0000u); }
__device__ __forceinline__ float wave_sum(float v) {
#pragma unroll
    for (int o = 1; o < 64; o <<= 1) v += __shfl_xor(v, o);
    return v;
}
__device__ __forceinline__ float wave_max(float v) {
#pragma unroll
    for (int o = 1; o < 64; o <<= 1) v = fmaxf(v, __shfl_xor(v, o));
    return v;
}
__device__ __forceinline__ float sigmoidf_(float x) { return 1.0f / (1.0f + __expf(-x)); }
__device__ __forceinline__ float siluf_(float x) { return x / (1.0f + __expf(-x)); }
__device__ __forceinline__ float geluf_(float x) { const float u = 1.5957691216057308f * (x + 0.044715f * x * x * x); return x / (1.0f + __expf(-u)); }
#define WAVE_LDS_FENCE() asm volatile("s_waitcnt lgkmcnt(0)" ::: "memory")

struct EpiResid {
    static constexpr bool PERM = false, AFTER_DRAIN = false;
    const float* xf; float* pre;
    __device__ __forceinline__ void operator()(const pg8::f32x4 (&acc)[2][2][4][2], const pg8::Unit& u, int wr, int wc, int fr, int fq) const {
        const int col0 = u.pn * 256 + wc * 32 + 4 * fq;
#pragma unroll
        for (int ai = 0; ai < 2; ++ai)
#pragma unroll
            for (int m = 0; m < 4; ++m) {
                const size_t off = (size_t)(u.pm * 256 + ai * 128 + wr * 64 + m * 16 + fr) * DM + col0;
#pragma unroll
                for (int bj = 0; bj < 2; ++bj)
#pragma unroll
                    for (int n = 0; n < 2; ++n) {
                        const pg8::f32x4 x = *(const pg8::f32x4*)(xf + off + bj * 128 + n * 16);
                        *(pg8::f32x4*)(pre + off + bj * 128 + n * 16) = x * DN_ALPHA + acc[ai][bj][m][n];
                    }
            }
    }
};
struct EpiGateUp {
    static constexpr bool PERM = true, AFTER_DRAIN = false;
    bf16* f;
    __device__ __forceinline__ void operator()(const pg8::f32x4 (&acc)[2][2][4][2], const pg8::Unit& u, int wr, int wc, int fr, int fq) const {
        const int c8 = u.pn * 256 + wc * 32 + 8 * fq;
#pragma unroll
        for (int ai = 0; ai < 2; ++ai)
#pragma unroll
            for (int m = 0; m < 4; ++m) {
                const size_t row = (size_t)(u.pm * 256 + ai * 128 + wr * 64 + m * 16 + fr);
#pragma unroll
                for (int bj = 0; bj < 2; ++bj) {
                    const pg8::f32x4 v0 = acc[ai][bj][m][0], v1 = acc[ai][bj][m][1];
                    const float o0 = siluf_(v0[0]) * v0[1], o1 = siluf_(v0[2]) * v0[3], o2 = siluf_(v1[0]) * v1[1], o3 = siluf_(v1[2]) * v1[3];
                    u32x2 w; w.x = pk2(o0, o1); w.y = pk2(o2, o3);
                    *(u32x2*)(f + row * FFN + ((c8 + bj * 128) >> 1)) = w;
                }
            }
    }
};
struct EpiInProj {
    static constexpr bool PERM = true, AFTER_DRAIN = false;
    int layer; unsigned char* ws; float* out;
    __device__ __forceinline__ void operator()(const pg8::f32x4 (&acc)[2][2][4][2], const pg8::Unit& u, int wr, int wc, int fr, int fq) const {
        const int pn = u.pn;
        const f32x2* rope = (const f32x2*)(ws + WS_ROPE); bf16* qraw = (bf16*)(ws + WS_QRAW); bf16* qrot = (bf16*)(ws + WS_QROT);
        bf16* KS = (bf16*)(ws + WS_KS); bf16* VS = (bf16*)(ws + WS_VS); bf16* KW = (bf16*)(ws + WS_KW); bf16* VW = (bf16*)(ws + WS_VW);
        bf16* U = (bf16*)(ws + WS_U); bf16* V = (bf16*)(ws + WS_V); float* gates = (float*)(ws + WS_GATES);
#pragma unroll
        for (int ai = 0; ai < 2; ++ai)
#pragma unroll
            for (int m = 0; m < 4; ++m) {
                const int r = u.pm * 256 + ai * 128 + wr * 64 + m * 16 + fr;
                const bool prompt = r < MP;
                const int b = r >> 13, t = r & (TP - 1);
                const int si = r - MP, bs = si >> 2, s = si & 3;
                const int pos = prompt ? t : PAST + s;
#pragma unroll
                for (int bj = 0; bj < 2; ++bj) {
                    const int c8 = pn * 256 + bj * 128 + wc * 32 + 8 * fq;
                    const pg8::f32x4 v0 = acc[ai][bj][m][0], v1 = acc[ai][bj][m][1];
                    if (pn < 2) {
                        const int h = c8 >> 6, d = (c8 & 63) >> 1;
                        const f32x2 cs0 = rope[pos * 32 + d], cs1 = rope[pos * 32 + d + 1], cs2 = rope[pos * 32 + d + 2], cs3 = rope[pos * 32 + d + 3];
                        const float a0 = v0[0], b0 = v0[1], a1 = v0[2], b1 = v0[3], a2 = v1[0], b2 = v1[1], a3 = v1[2], b3 = v1[3];
                        const size_t o = (size_t)r * 512 + h * 64 + d;
                        u32x2 w;
                        w.x = pk2(a0, a1); w.y = pk2(a2, a3); *(u32x2*)(qraw + o) = w;
                        w.x = pk2(b0, b1); w.y = pk2(b2, b3); *(u32x2*)(qraw + o + 32) = w;
                        w.x = pk2(a0 * cs0.x - b0 * cs0.y, a1 * cs1.x - b1 * cs1.y); w.y = pk2(a2 * cs2.x - b2 * cs2.y, a3 * cs3.x - b3 * cs3.y); *(u32x2*)(qrot + o) = w;
                        w.x = pk2(b0 * cs0.x + a0 * cs0.y, b1 * cs1.x + a1 * cs1.y); w.y = pk2(b2 * cs2.x + a2 * cs2.y, b3 * cs3.x + a3 * cs3.y); *(u32x2*)(qrot + o + 32) = w;
                    } else if (pn == 2) {
                        const int cc = c8 - 512;
                        float* dst = prompt ? out + O_CMPP + ((size_t)(layer * BP + b) * TP + t) * KVW + cc : out + O_CMPS + ((size_t)layer * MS + si) * KVW + cc;
                        *(pg8::f32x4*)dst = v0; *(pg8::f32x4*)(dst + 4) = v1;
                    } else if (pn == 3 || pn == 4) {
                        const bool is_slc = (pn == 3);
                        const int cc = c8 - (is_slc ? 768 : 1024);
                        float* dst;
                        bool wr_out = true;
                        if (is_slc) dst = prompt ? out + O_SLCP + ((size_t)(layer * BP + b) * TP + t) * KVW : out + O_SLCS + ((size_t)layer * MS + si) * KVW;
                        else { if (prompt) { wr_out = (t >= TP - 512); dst = out + O_WINP + ((size_t)(layer * BP + b) * 512 + (t - (TP - 512))) * KVW; }
                               else dst = out + O_WINS + ((size_t)(layer * NB_S + bs) * 512 + 508 + s) * KVW; }
                        if (cc < 128) {
                            const int g = cc >> 6, d = (cc & 63) >> 1;
                            const f32x2 cs0 = rope[pos * 32 + d], cs1 = rope[pos * 32 + d + 1], cs2 = rope[pos * 32 + d + 2], cs3 = rope[pos * 32 + d + 3];
                            const float a0 = v0[0], b0 = v0[1], a1 = v0[2], b1 = v0[3], a2 = v1[0], b2 = v1[1], a3 = v1[2], b3 = v1[3];
                            const pg8::f32x4 lo = {a0 * cs0.x - b0 * cs0.y, a1 * cs1.x - b1 * cs1.y, a2 * cs2.x - b2 * cs2.y, a3 * cs3.x - b3 * cs3.y};
                            const pg8::f32x4 hi = {b0 * cs0.x + a0 * cs0.y, b1 * cs1.x + a1 * cs1.y, b2 * cs2.x + a2 * cs2.y, b3 * cs3.x + a3 * cs3.y};
                            if (wr_out) { *(pg8::f32x4*)(dst + g * 64 + d) = lo; *(pg8::f32x4*)(dst + g * 64 + d + 32) = hi; }
                            if (prompt) { bf16* kb = (is_slc ? KS : KW) + ((size_t)(b * 2 + g) * TP + t) * 64 + d;
                                u32x2 w; w.x = pk2(lo[0], lo[1]); w.y = pk2(lo[2], lo[3]); *(u32x2*)kb = w;
                                w.x = pk2(hi[0], hi[1]); w.y = pk2(hi[2], hi[3]); *(u32x2*)(kb + 32) = w; }
                        } else {
                            const int g = (cc - 128) >> 6, d = cc & 63;
                            if (wr_out) { *(pg8::f32x4*)(dst + cc) = v0; *(pg8::f32x4*)(dst + cc + 4) = v1; }
                            if (prompt) { bf16* vb = (is_slc ? VS : VW) + ((size_t)(b * 2 + g) * TP + t) * 64 + d;
                                v4u w; w.x = pk2(v0[0], v0[1]); w.y = pk2(v0[2], v0[3]); w.z = pk2(v1[0], v1[1]); w.w = pk2(v1[2], v1[3]); *(v4u*)vb = w; }
                        }
                    } else if (pn < 9) {
                        const bool is_u = pn < 7;
                        const int cc = c8 - (is_u ? 1280 : 1792);
                        bf16* dst = (is_u ? U : V) + (size_t)r * 512 + cc;
                        v4u w; w.x = pk2(geluf_(v0[0]), geluf_(v0[1])); w.y = pk2(geluf_(v0[2]), geluf_(v0[3])); w.z = pk2(geluf_(v1[0]), geluf_(v1[1])); w.w = pk2(geluf_(v1[2]), geluf_(v1[3]));
                        *(v4u*)dst = w;
                    } else {
                        const int cc = c8 - 2304;
                        if (cc < 24) { float* dst = gates + (size_t)r * 24 + cc;
                            const pg8::f32x4 g0 = {sigmoidf_(v0[0]), sigmoidf_(v0[1]), sigmoidf_(v0[2]), sigmoidf_(v0[3])}, g1 = {sigmoidf_(v1[0]), sigmoidf_(v1[1]), sigmoidf_(v1[2]), sigmoidf_(v1[3])};
                            *(pg8::f32x4*)dst = g0; *(pg8::f32x4*)(dst + 4) = g1; }
                    }
                }
            }
    }
};

template <class RowMap>
__device__ __forceinline__ void transpose_item(const float* W, int K, int N, bf16* WT, const RowMap rm, LAS float* scr, int item, int lane) {
    const int nblk = (N + 31) / 32, kb = item / nblk, nb = item % nblk, k0 = 64 * kb, n0 = 32 * nb;
    const int ncol = n0 + (lane & 31);
#pragma unroll 8
    for (int i = 0; i < 32; ++i) { const int kk = 2 * i + (lane >> 5); scr[kk * 33 + (lane & 31)] = (ncol < N) ? W[(size_t)(k0 + kk) * N + ncol] : 0.f; }
    LDS_WAIT(); asm volatile("" ::: "memory");
    const int c = lane & 7;
#pragma unroll
    for (int j = 0; j < 4; ++j) { const int nl = (lane >> 3) + 8 * j; const LAS float* s = scr + (8 * c) * 33 + nl;
        v4u o; o.x = pk2(s[0 * 33], s[1 * 33]); o.y = pk2(s[2 * 33], s[3 * 33]); o.z = pk2(s[4 * 33], s[5 * 33]); o.w = pk2(s[6 * 33], s[7 * 33]);
        if (n0 + nl < N) *(v4u*)(WT + (size_t)rm(n0 + nl) * K + k0 + 8 * c) = o; }
    LDS_WAIT(); asm volatile("" ::: "memory");
}
struct RmIdent { __device__ __forceinline__ int operator()(int n) const { return n; } };
struct RmAffine { int mul, add; __device__ __forceinline__ int operator()(int n) const { return n * mul + add; } };
__device__ __forceinline__ int rope_il(int d) { return d < 32 ? 2 * d : 2 * (d - 32) + 1; }
struct RmInProj { __device__ __forceinline__ int operator()(int c) const {
    if (c < 512) return (c & ~63) + rope_il(c & 63);
    if (c < 768) return c;
    if (c < 1280) { const int base = c < 1024 ? 768 : 1024, cc = c - base; return cc < 128 ? base + (cc & ~63) + rope_il(cc & 63) : c; }
    if (c < 1304) return 2304 + (c - 1280);
    return 1280 + (c - 1304); } };
constexpr int CU_AS = 0, CU_BS = 9216, CU_HS = 46080, CU_LDS = 79872;
__device__ __forceinline__ void compress_unit(LAS unsigned char* lds, const float* arow, const float* pe_k, const bf16* W1t, const float* b1, const bf16* W2t,
                                              bf16* obase, int NC, int rb, int tid) {
    const int wid = __builtin_amdgcn_readfirstlane(tid >> 6), lane = tid & 63, fr = lane & 15, fq = lane >> 4, wr = wid >> 2, wc = wid & 3;
    const int arow_i = tid >> 3, ac = tid & 7;
    pg8::f32x4 acc[2][4];
#pragma unroll
    for (int m = 0; m < 2; ++m)
#pragma unroll
        for (int n = 0; n < 4; ++n) acc[m][n] = (pg8::f32x4){0.f, 0.f, 0.f, 0.f};
    pg8::f32x4 a0, a1, p0, p1; v4u bq[4];
    const float* pe_t = pe_k + ac * 8;
    const bf16* bsrc = W1t + (size_t)arow_i * 2048 + ac * 8;
    a0 = *(const pg8::f32x4*)arow; a1 = *(const pg8::f32x4*)(arow + 4); p0 = *(const pg8::f32x4*)pe_t; p1 = *(const pg8::f32x4*)(pe_t + 4);
#pragma unroll
    for (int j = 0; j < 4; ++j) bq[j] = *(const v4u*)(bsrc + (size_t)j * 64 * 2048);
    for (int l = 0; l < 32; ++l) {
        { v4u w; a0 = a0 + p0; a1 = a1 + p1; w.x = pk2(a0[0], a0[1]); w.y = pk2(a0[2], a0[3]); w.z = pk2(a1[0], a1[1]); w.w = pk2(a1[2], a1[3]);
          *(LAS v4u*)(lds + CU_AS + arow_i * 144 + ac * 16) = w;
#pragma unroll
          for (int j = 0; j < 4; ++j) *(LAS v4u*)(lds + CU_BS + (arow_i + 64 * j) * 144 + ac * 16) = bq[j]; }
        __syncthreads();
        if (l + 1 < 32) {
            const float* an = arow + (size_t)(l + 1) * KVW; const float* pn = pe_t + (l + 1) * 64; const bf16* bn = bsrc + (l + 1) * 64;
            a0 = *(const pg8::f32x4*)an; a1 = *(const pg8::f32x4*)(an + 4); p0 = *(const pg8::f32x4*)pn; p1 = *(const pg8::f32x4*)(pn + 4);
#pragma unroll
            for (int j = 0; j < 4; ++j) bq[j] = *(const v4u*)(bn + (size_t)j * 64 * 2048);
        }
#pragma unroll
        for (int kk = 0; kk < 2; ++kk) {
            bf16x8 af[2], bfr[4];
#pragma unroll
            for (int m = 0; m < 2; ++m) af[m] = *(const LAS bf16x8*)(lds + CU_AS + (wr * 32 + m * 16 + fr) * 144 + (kk * 32 + fq * 8) * 2);
#pragma unroll
            for (int n = 0; n < 4; ++n) bfr[n] = *(const LAS bf16x8*)(lds + CU_BS + (wc * 64 + n * 16 + fr) * 144 + (kk * 32 + fq * 8) * 2);
#pragma unroll
            for (int m = 0; m < 2; ++m)
#pragma unroll
                for (int n = 0; n < 4; ++n) acc[m][n] = __builtin_amdgcn_mfma_f32_16x16x32_bf16(af[m], bfr[n], acc[m][n], 0, 0, 0);
        }
        __syncthreads();
    }
#pragma unroll
    for (int m = 0; m < 2; ++m)
#pragma unroll
        for (int n = 0; n < 4; ++n) { const int col = wc * 64 + n * 16 + fr; const float bb = b1[col];
#pragma unroll
            for (int rg = 0; rg < 4; ++rg) { const int row = wr * 32 + m * 16 + fq * 4 + rg;
                *(LAS unsigned short*)(lds + CU_HS + row * 528 + col * 2) = (unsigned short)f2bf(siluf_(acc[m][n][rg] + bb)); } }
    __syncthreads();
    {
        const int rt = wid >> 1, ch = wid & 1;
        pg8::f32x4 acc2[2] = {(pg8::f32x4){0.f, 0.f, 0.f, 0.f}, (pg8::f32x4){0.f, 0.f, 0.f, 0.f}};
#pragma unroll
        for (int ks = 0; ks < 8; ++ks) {
            const bf16x8 a = *(const LAS bf16x8*)(lds + CU_HS + (rt * 16 + fr) * 528 + (ks * 32 + fq * 8) * 2);
#pragma unroll
            for (int nn = 0; nn < 2; ++nn) { const bf16x8 bb = *(const bf16x8*)(W2t + (size_t)(ch * 32 + nn * 16 + fr) * 256 + ks * 32 + fq * 8);
                acc2[nn] = __builtin_amdgcn_mfma_f32_16x16x32_bf16(a, bb, acc2[nn], 0, 0, 0); }
        }
#pragma unroll
        for (int nn = 0; nn < 2; ++nn)
#pragma unroll
            for (int rg = 0; rg < 4; ++rg) { const int R = rb * 64 + rt * 16 + fq * 4 + rg, col = ch * 32 + nn * 16 + fr;
                const int b = R / (2 * NC), n = (R >> 1) % NC, g = R & 1;
                obase[((size_t)(b * 2 + g) * NC + n) * 64 + col] = (bf16)f2bf(acc2[nn][rg]); }
    }
    __syncthreads();
}

__device__ __forceinline__ void gmlp_unit(LAS unsigned char* lds, LAS unsigned char* lds_stats, int m0, const bf16* U, const bf16* V, const float* Wm, const float* bias, const float* lng, const float* lnb,
                                          bf16* mix, float* gv_out  , int tid) {
    const int wid = __builtin_amdgcn_readfirstlane(tid >> 6), lane = tid & 63;
    LAS f32x2* stats = (LAS f32x2*)lds_stats;
    for (int i = 0; i < 16; ++i) {
        const int row = wid * 16 + i;
        const v4u w = *(const v4u*)(V + (size_t)(m0 + row) * 512 + lane * 8);
        float x[8] = {bflo(w.x), bfhi(w.x), bflo(w.y), bfhi(w.y), bflo(w.z), bfhi(w.z), bflo(w.w), bfhi(w.w)};
        float s = 0.f;
#pragma unroll
        for (int e = 0; e < 8; ++e) s += x[e];
        const float mean = wave_sum(s) * (1.0f / 512.0f);
        float q = 0.f;
#pragma unroll
        for (int e = 0; e < 8; ++e) { const float d = x[e] - mean; q += d * d; }
        const float var = wave_sum(q) * (1.0f / 512.0f);
        if (lane == 0) stats[row] = (f32x2){mean, 1.0f / sqrtf(var + LN_EPS)};
    }
    __syncthreads();
    const int h = wid, col = h * 64 + lane;
    const float gg = lng[col], bb = lnb[col];
    LAS float* part = (LAS float*)(lds + wid * 16384);
    const float* Wh = Wm + (size_t)h * 128 * 128;
#pragma unroll 1
    for (int half = 0; half < 2; ++half) {
        float vn[64];
#pragma unroll
        for (int s = 0; s < 64; ++s) { const f32x2 st = stats[half * 64 + s]; vn[s] = (bf2f(V[(size_t)(m0 + half * 64 + s) * 512 + col]) - st.x) * st.y * gg + bb; }
        if (gv_out) {
#pragma unroll
            for (int s = 0; s < 64; ++s) gv_out[(size_t)(half * 64 + s) * 512 + col] = vn[s];
        }
        for (int t = half * 64; t < 128; ++t) {
            const float w0 = Wh[t * 128 + half * 64 + lane];
            float acc0 = (half == 0) ? bias[h * 128 + t] : part[(t - 64) * 64 + lane], acc1 = 0.f;
#pragma unroll
            for (int s = 0; s < 64; s += 2) { acc0 += __int_as_float(__builtin_amdgcn_readlane(__float_as_int(w0), s)) * vn[s]; acc1 += __int_as_float(__builtin_amdgcn_readlane(__float_as_int(w0), s + 1)) * vn[s + 1]; }
            const float sres = acc0 + acc1;
            if (half == 0 && t >= 64) part[(t - 64) * 64 + lane] = sres;
            else { const float uu = bf2f(U[(size_t)(m0 + t) * 512 + col]); mix[(size_t)(m0 + t) * DM + 512 + col] = (bf16)f2bf(uu * sres); }
        }
        WAVE_LDS_FENCE();
    }
    __syncthreads();
}

__device__ __forceinline__ void ln_row(const float* src, const float* g, const float* b, float* dstf, bf16* dstb, int lane) {
    pg8::f32x4 v[4]; float s = 0.f;
#pragma unroll
    for (int j = 0; j < 4; ++j) { v[j] = *(const pg8::f32x4*)(src + (j * 64 + lane) * 4); s += (v[j][0] + v[j][1]) + (v[j][2] + v[j][3]); }
    const float mean = wave_sum(s) * (1.0f / DM); float q = 0.f;
#pragma unroll
    for (int j = 0; j < 4; ++j) { v[j] = v[j] - mean; q += (v[j][0] * v[j][0] + v[j][1] * v[j][1]) + (v[j][2] * v[j][2] + v[j][3] * v[j][3]); }
    const float rstd = 1.0f / sqrtf(wave_sum(q) * (1.0f / DM) + LN_EPS);
#pragma unroll
    for (int j = 0; j < 4; ++j) { const int c = (j * 64 + lane) * 4;
        const pg8::f32x4 gg = *(const pg8::f32x4*)(g + c), bb = *(const pg8::f32x4*)(b + c);
        const pg8::f32x4 y = v[j] * rstd * gg + bb;
        *(pg8::f32x4*)(dstf + c) = y;
        if (dstb) { u32x2 w; w.x = pk2(y[0], y[1]); w.y = pk2(y[2], y[3]); *(u32x2*)(dstb + c) = w; } }
}

__device__ __forceinline__ void load8(const bf16* p, float (&k)[8]) { const v4u w = *(const v4u*)p; k[0] = bflo(w.x); k[1] = bfhi(w.x); k[2] = bflo(w.y); k[3] = bfhi(w.y); k[4] = bflo(w.z); k[5] = bfhi(w.z); k[6] = bflo(w.w); k[7] = bfhi(w.w); }
__device__ __forceinline__ void load8(const float* p, float (&k)[8]) { const pg8::f32x4 a = *(const pg8::f32x4*)p, b = *(const pg8::f32x4*)(p + 4); k[0] = a[0]; k[1] = a[1]; k[2] = a[2]; k[3] = a[3]; k[4] = b[0]; k[5] = b[1]; k[6] = b[2]; k[7] = b[3]; }
__device__ __forceinline__ float ldv(const bf16* p) { return bf2f(*p); }
__device__ __forceinline__ float ldv(const float* p) { return *p; }
template <class T> __device__ __forceinline__ void dot4(const T* krow, const LAS float* q, float (&s)[4]) {
    s[0] = s[1] = s[2] = s[3] = 0.f;
#pragma unroll 1
    for (int c = 0; c < 8; ++c) {
        float k[8]; load8(krow + c * 8, k);
#pragma unroll
        for (int r = 0; r < 4; ++r) {
            const pg8::f32x4 qa = *(const LAS pg8::f32x4*)(q + r * 64 + c * 8), qb = *(const LAS pg8::f32x4*)(q + r * 64 + c * 8 + 4);
            s[r] += qa[0] * k[0] + qa[1] * k[1] + qa[2] * k[2] + qa[3] * k[3] + qb[0] * k[4] + qb[1] * k[5] + qb[2] * k[6] + qb[3] * k[7];
        }
    }
}
template <class Src>
__device__ __forceinline__ void attend(const Src& S, int nblk, const LAS float* q, LAS float* pbuf, int lane, float (&o)[4], LAS float* impbuf) {
    typedef typename Src::T T;
    float m[4] = {-1e30f, -1e30f, -1e30f, -1e30f}, l[4] = {0.f, 0.f, 0.f, 0.f};
    for (int i = 0; i < nblk; ++i) {
        const T *kb, *vb; bool ok; S.blk(i, lane, kb, vb, ok);
        if (ok) { float s[4]; dot4(kb + (size_t)lane * Src::STRIDE, q, s);
#pragma unroll
            for (int r = 0; r < 4; ++r) { if (s[r] > m[r]) { l[r] = l[r] * __expf(m[r] - s[r]) + 1.0f; m[r] = s[r]; } else l[r] += __expf(s[r] - m[r]); } }
    }
    float Mx[4], inv[4];
#pragma unroll
    for (int r = 0; r < 4; ++r) { Mx[r] = wave_max(m[r]); const float L = wave_sum(l[r] * __expf(m[r] - Mx[r])); inv[r] = 1.0f / fmaxf(L, 1e-30f); }
    o[0] = o[1] = o[2] = o[3] = 0.f;
    if (!(Mx[0] > -1e29f)) return;
    for (int i = 0; i < nblk; ++i) {
        const T *kb, *vb; bool ok; S.blk(i, lane, kb, vb, ok);
        const unsigned long long mask = __ballot(ok);
        if (mask == 0ull) continue;
        pg8::f32x4 p = {0.f, 0.f, 0.f, 0.f};
        if (ok) { float s[4]; dot4(kb + (size_t)lane * Src::STRIDE, q, s);
#pragma unroll
            for (int r = 0; r < 4; ++r) p[r] = __expf(s[r] - Mx[r]) * inv[r]; }
        *(LAS pg8::f32x4*)(pbuf + lane * 4) = p;
        if (impbuf) { const float im = (p[0] + p[1]) + (p[2] + p[3]); const float pr = im + __shfl_xor(im, 1); if (!(lane & 1)) impbuf[(i * 64 + lane) >> 1] = pr; }
        WAVE_LDS_FENCE();
        for (int kk = 0; kk < 64; ++kk) {
            if ((mask >> kk) & 1ull) { const pg8::f32x4 pv = *(const LAS pg8::f32x4*)(pbuf + kk * 4); const float v = ldv(vb + (size_t)kk * Src::STRIDE + lane);
                o[0] += pv[0] * v; o[1] += pv[1] * v; o[2] += pv[2] * v; o[3] += pv[3] * v; }
        }
        WAVE_LDS_FENCE();
    }
}
__device__ __forceinline__ unsigned long long topk_key(float val, int j) { unsigned u = __float_as_uint(val); u = (u & 0x80000000u) ? ~u : (u | 0x80000000u); return ((unsigned long long)u << 32) | (unsigned)(127 - j); }
__device__ __forceinline__ void topk16(const LAS float* imp, int ns, int cur, LAS int* selidx, int lane) {
    unsigned long long k0 = 0ull, k1 = 0ull;
    { const int j = lane; if (j < ns) { const bool valid = j <= cur, forced = (j == 0) | (j == cur) | (j == cur - 1); k0 = topk_key(valid ? imp[j] + (forced ? 1.0e4f : 0.f) : -1.0f, j); } }
    { const int j = lane + 64; if (j < ns) { const bool valid = j <= cur, forced = (j == 0) | (j == cur) | (j == cur - 1); k1 = topk_key(valid ? imp[j] + (forced ? 1.0e4f : 0.f) : -1.0f, j); } }
    for (int it = 0; it < 16; ++it) {
        unsigned long long k = k0 > k1 ? k0 : k1;
#pragma unroll
        for (int o = 1; o < 64; o <<= 1) { const unsigned lo = __shfl_xor((unsigned)k, o), hi = __shfl_xor((unsigned)(k >> 32), o); const unsigned long long kx = ((unsigned long long)hi << 32) | lo; k = kx > k ? kx : k; }
        const int jb = 127 - (int)(unsigned)(k & 0xffffffffull);
        if (lane == 0) selidx[it] = (k == 0ull || jb > cur) ? -1 : jb;
        if (k0 == k) k0 = 0ull;
        if (k1 == k) k1 = 0ull;
    }
    WAVE_LDS_FENCE();
}
struct SrcPromptCmp { typedef bf16 T; static constexpr int STRIDE = 64; const bf16 *ck, *cv; int nvalid;
    __device__ __forceinline__ void blk(int i, int lane, const bf16*& kb, const bf16*& vb, bool& ok) const { kb = ck + (size_t)i * 64 * 64; vb = cv + (size_t)i * 64 * 64; ok = (i * 64 + lane) < nvalid; } };
struct SrcPromptSlc { typedef bf16 T; static constexpr int STRIDE = 64; const bf16 *K, *V; const LAS int* selidx; int t;
    __device__ __forceinline__ void blk(int i, int lane, const bf16*& kb, const bf16*& vb, bool& ok) const { const int j = selidx[i]; const int jj = j < 0 ? 0 : j; kb = K + (size_t)jj * 64 * 64; vb = V + (size_t)jj * 64 * 64; ok = (j >= 0) && (jj * 64 + lane <= t); } };
struct SrcPromptWin { typedef bf16 T; static constexpr int STRIDE = 64; const bf16 *K, *V; int t, kb0;
    __device__ __forceinline__ void blk(int i, int lane, const bf16*& kb, const bf16*& vb, bool& ok) const { const int j = kb0 + i, pos = j * 64 + lane; kb = K + (size_t)j * 64 * 64; vb = V + (size_t)j * 64 * 64; ok = (pos <= t) && (pos >= t - 511); } };
struct SrcSampleCmp { typedef bf16 T; static constexpr int STRIDE = 64; const bf16 *ck, *cv;
    __device__ __forceinline__ void blk(int i, int lane, const bf16*& kb, const bf16*& vb, bool& ok) const { kb = ck; vb = cv; ok = true; } };
struct SrcSampleSlc { typedef float T; static constexpr int STRIDE = KVW; const float* cache_l; const int* pt; const float* newrows; const LAS int* selidx; int g, s;
    __device__ __forceinline__ void blk(int i, int lane, const float*& kb, const float*& vb, bool& ok) const {
        const int j = selidx[i];
        if (j >= 0 && j < 32) { const int page = pt[j >> 1]; const float* rb = cache_l + ((size_t)page * PAGE + (j & 1) * 64) * KVW; kb = rb + g * 64; vb = rb + 128 + g * 64; ok = true; }
        else { kb = newrows + g * 64; vb = newrows + 128 + g * 64; ok = (j == 32) && (lane <= s); } } };
struct SrcSampleWin { typedef float T; static constexpr int STRIDE = KVW; const float* state; const float* newrows; int g, s;
    __device__ __forceinline__ void blk(int i, int lane, const float*& kb, const float*& vb, bool& ok) const {
        if (i < 8) { const float* rb = state + (size_t)i * 64 * KVW; kb = rb + g * 64; vb = rb + 128 + g * 64; ok = (i * 64 + lane) >= s + 1; }
        else { kb = newrows + g * 64; vb = newrows + 128 + g * 64; ok = lane <= s; } } };
struct Args { const float* in[23]; float* out; unsigned char* ws; int ph_lo, ph_hi, use_bar, pad; };

static_assert(sizeof(Args) == 216, "Args layout");
template <int OFF> __device__ __forceinline__ unsigned long long karg64() {
    unsigned long long v; const unsigned long long kp = (unsigned long long)__builtin_amdgcn_kernarg_segment_ptr();
    asm volatile("s_load_dwordx2 %0, %1, %2\n\ts_waitcnt lgkmcnt(0)" : "=s"(v) : "s"(kp), "n"(OFF) : "memory");
    return v;
}
#define KIN(k) ((const float*)karg64<8 * (k)>())
#define KOUT() ((float*)karg64<184>())
#define KWS() ((unsigned char*)karg64<192>())

__global__ void __launch_bounds__(NWAVES * 64, 2) fwd(Args args) {
    extern __shared__ __attribute__((aligned(16))) unsigned char lds_raw[];
    LAS unsigned char* lds = (LAS unsigned char*)lds_raw;
    volatile LAS unsigned* MISC = (volatile LAS unsigned*)(lds + MISC_OFF);
    const int tid = threadIdx.x, lane = tid & 63, wave = __builtin_amdgcn_readfirstlane(tid >> 6);
    const int G = gridDim.x, bid = blockIdx.x;
    const int gw = bid * NWAVES + wave, NGW = G * NWAVES, gt = bid * (NWAVES * 64) + tid, NGT = G * NWAVES * 64;

    for (int u = tid; u < (LDS_BYTES - LDSCTL_OFF) / 4; u += NWAVES * 64) ((LAS unsigned*)(lds + LDSCTL_OFF))[u] = 0u;
    __syncthreads();
    const int use_bar = args.use_bar;
    XcdBarrier bar; bar.bar = (unsigned*)(KWS() + WS_CTL) + CW_BAR; bar.x = 0; bar.st = nullptr;
    if (use_bar) bar = xcd_barrier_post((unsigned*)(KWS() + WS_CTL) + CW_BAR, MISC + 8);
    const int lo = args.ph_lo, hi = args.ph_hi;
#ifndef PH_ENABLE
#define PH_ENABLE 0xFFFFFFFFu
#endif
#define PHBIT(k) (((k) < PH_L0) ? (k) : (PH_L0 + ((k) - PH_L0) % PH_PER_LAYER))
#define IN(k) (((PH_ENABLE >> PHBIT(k)) & 1u) && lo <= (k) && (k) < hi)
#define SEAM(k) do { if (use_bar && (k) + 1 < hi) xcd_barrier(bar); } while (0)

    if (IN(PH_P0A)) {
        unsigned char* ws = KWS(); float* out = KOUT();
        LAS float* scr = (LAS float*)(lds + RING_OFF + wave * 16384);
        constexpr int I_IN = 16 * 73, I_OUT = 16 * 32, I_G = 16 * 88, I_D = 44 * 32, I_W1 = 32 * 8, I_W2 = 4 * 2;
        constexpr int I_LAYER = I_IN + I_OUT + 2 * I_G + I_D + 2 * I_W1 + 2 * I_W2;
        for (int it = gw; it < NLAYER * I_LAYER; it += NGW) {
            const int L = it / I_LAYER; int r = it % I_LAYER;
            if (r < I_IN) { transpose_item(KIN(6) + (size_t)L * DM * PIN, DM, PIN, (bf16*)(ws + WS_WIN_T) + (size_t)L * NIN * DM, RmInProj{}, scr, r, lane); continue; } r -= I_IN;
            if (r < I_OUT) { transpose_item(KIN(15) + (size_t)L * DM * DM, DM, DM, (bf16*)(ws + WS_WOUT_T) + (size_t)L * DM * DM, RmIdent{}, scr, r, lane); continue; } r -= I_OUT;
            if (r < I_G) { transpose_item(KIN(18) + (size_t)L * DM * FFN, DM, FFN, (bf16*)(ws + WS_WGU_T) + (size_t)L * NGU * DM, RmAffine{2, 0}, scr, r, lane); continue; } r -= I_G;
            if (r < I_G) { transpose_item(KIN(19) + (size_t)L * DM * FFN, DM, FFN, (bf16*)(ws + WS_WGU_T) + (size_t)L * NGU * DM, RmAffine{2, 1}, scr, r, lane); continue; } r -= I_G;
            if (r < I_D) { transpose_item(KIN(20) + (size_t)L * FFN * DM, FFN, DM, (bf16*)(ws + WS_WDN_T) + (size_t)L * DM * FFN, RmIdent{}, scr, r, lane); continue; } r -= I_D;
            if (r < 2 * I_W1) { const int kind = r / I_W1; transpose_item(KIN(8) + (size_t)(L * 2 + kind) * 2048 * 256, 2048, 256, (bf16*)(ws + WS_W1C_T) + (size_t)(L * 2 + kind) * 256 * 2048, RmIdent{}, scr, r % I_W1, lane); continue; } r -= 2 * I_W1;
            { const int kind = r / I_W2; transpose_item(KIN(10) + (size_t)(L * 2 + kind) * 256 * 64, 256, 64, (bf16*)(ws + WS_W2C_T) + (size_t)(L * 2 + kind) * 64 * 256, RmIdent{}, scr, r % I_W2, lane); }
        }
        for (int i = gt; i < NLAYER * (NIN - PIN) * (DM / 8); i += NGT) { const int L = i / ((NIN - PIN) * (DM / 8)), r = i % ((NIN - PIN) * (DM / 8));
            *(v4u*)((bf16*)(ws + WS_WIN_T) + (size_t)L * NIN * DM + (size_t)PIN * DM + (size_t)r * 8) = (v4u){0u, 0u, 0u, 0u}; }
        for (int i = gt; i < TP * 32; i += NGT) {
            const int pos = i >> 5, d = i & 31;
            double fr_ = 1.0; for (int k = 0; k < d; ++k) fr_ *= 0.7498942093324558;
            const float angf = (float)pos * (float)fr_;
            const double a = (double)angf;
            const double kq = __builtin_rint(a * 0.63661977236758134308);
            double rr = __builtin_fma(-kq, 1.57079632673412561417e+00, a); rr = __builtin_fma(-kq, 6.07710050650619224932e-11, rr);
            const double r2 = rr * rr;
            double sp = -7.6471637318198164759e-13; sp = sp * r2 + 1.6059043836821614599e-10; sp = sp * r2 - 2.5052108385441718775e-08; sp = sp * r2 + 2.7557319223985890653e-06;
            sp = sp * r2 - 1.9841269841269841270e-04; sp = sp * r2 + 8.3333333333333333333e-03; sp = sp * r2 - 1.6666666666666666667e-01; const double sn = rr + rr * r2 * sp;
            double cp = 4.7794773323873852974e-14; cp = cp * r2 - 1.1470745597729724714e-11; cp = cp * r2 + 2.0876756987868098979e-09; cp = cp * r2 - 2.7557319223985890653e-07;
            cp = cp * r2 + 2.4801587301587301587e-05; cp = cp * r2 - 1.3888888888888888889e-03; cp = cp * r2 + 4.1666666666666666667e-02; cp = cp * r2 - 0.5; const double cn = 1.0 + r2 * cp;
            const int q4 = ((int)kq) & 3;
            const double c = (q4 == 0) ? cn : (q4 == 1) ? -sn : (q4 == 2) ? -cn : sn;
            const double s = (q4 == 0) ? sn : (q4 == 1) ? cn : (q4 == 2) ? -sn : -cn;
            ((f32x2*)(ws + WS_ROPE))[i] = (f32x2){(float)c, (float)s};
        }
        { const float* xp = KIN(0); const float* xs = KIN(1); float* XF = (float*)(ws + WS_XF); bf16* XB = (bf16*)(ws + WS_XB);
        for (int row = gw; row < MT; row += NGW) {
            const float* src = row < MP ? xp + (size_t)row * DM : xs + (size_t)(row - MP) * DM;
#pragma unroll
            for (int j = 0; j < 4; ++j) { const int c = (j * 64 + lane) * 4; const pg8::f32x4 v = *(const pg8::f32x4*)(src + c);
                *(pg8::f32x4*)(XF + (size_t)row * DM + c) = v; u32x2 w; w.x = pk2(v[0], v[1]); w.y = pk2(v[2], v[3]); *(u32x2*)(XB + (size_t)row * DM + c) = w; }
        } }
        { const float* gws = KIN(13); const float* gbs = KIN(14); float* GWP = (float*)(ws + WS_GWP); float* GWS = (float*)(ws + WS_GWS); float* GBS = (float*)(ws + WS_GBS);
        for (int i = gt; i < NLAYER * 8 * 128 * 128; i += NGT) {
            const int lh = i >> 14, t = (i >> 7) & 127, s = i & 127;
            const float* wsrc = gws + (size_t)lh * 16384;
            GWP[i] = (s <= t) ? wsrc[t * 128 + s] : 0.f;
            GWS[i] = ((t >> 2) == (s >> 2) && (s & 3) <= (t & 3)) ? wsrc[(t & 3) * 128 + (s & 3)] : 0.f;
        }
        for (int i = gt; i < NLAYER * 8 * 128; i += NGT) GBS[i] = gbs[(i & ~127) + (i & 3)]; }
        { const float* st = KIN(4);
        for (int i = gt; i < NLAYER * NB_S * 508 * 64; i += NGT) { const int lb = i / (508 * 64), r = i % (508 * 64);
            *(pg8::f32x4*)(out + O_WINS + (size_t)lb * 512 * KVW + (size_t)r * 4) = *(const pg8::f32x4*)(st + (size_t)lb * 512 * KVW + 4 * KVW + (size_t)r * 4); } }
        SEAM(PH_P0A);
    }
    if (IN(PH_P0B)) {
        unsigned char* ws = KWS();
        const int* PT = (const int*)KIN(5); const float* cache = KIN(2); const float* pe = KIN(7); const float* b1 = KIN(9);
        for (int u = bid; u < NLAYER * 2 * 256; u += G) {
            const int L = u >> 9, kind = (u >> 8) & 1, rb = u & 255;
            const int R = rb * 64 + (tid >> 3), bs = R >> 7, n = (R >> 1) & 63, g = R & 1;
            const int page = PT[bs * NPG + (n >> 2)];
            const float* arow = cache + ((size_t)L * NPOOL + page) * PAGE * KVW + (size_t)((n & 3) * 32) * KVW + kind * 128 + g * 64 + (tid & 7) * 8;
            compress_unit(lds + RING_OFF, arow, pe + (size_t)(L * 2 + kind) * 2048, (const bf16*)(ws + WS_W1C_T) + (size_t)(L * 2 + kind) * 256 * 2048, b1 + (L * 2 + kind) * 256,
                          (const bf16*)(ws + WS_W2C_T) + (size_t)(L * 2 + kind) * 64 * 256, (bf16*)(ws + (kind ? WS_CVS : WS_CKS)) + (size_t)L * NB_S * 2 * 64 * 64, 64, rb, tid);
        }
        SEAM(PH_P0B);
    }
    for (int L = 0; L < NLAYER; ++L) {
        const int pb = PH_L0 + L * PH_PER_LAYER;
        if (IN(pb + 0)) {
            unsigned char* ws = KWS();
            pg8::Gemm g{(const bf16*)(ws + WS_XB), (const bf16*)(ws + WS_WIN_T) + (size_t)L * NIN * DM, MT, NIN, DM}; pg8::StaticOrder S; S.init(MT, NIN, G, bid);
            EpiInProj E{L, ws, KOUT()};
            pg8::gemm_phase<EpiInProj, pg8::StaticOrder, true, true>(lds + RING_OFF, g, S, E);
            SEAM(pb + 0);
        }
        if (IN(pb + 1)) {
            unsigned char* ws = KWS(); float* out = KOUT();
            int tid = threadIdx.x; asm volatile("" : "+v"(tid));
            for (int u = bid; u < 32 + 132; u += G) {
                if (u < 32) {
                    const int kind = u >> 4, rb = u & 15;
                    const int R = rb * 64 + (tid >> 3), b = R >> 9, n = (R >> 1) & 255, g = R & 1;
                    const float* arow = out + O_CMPP + ((size_t)(L * BP + b) * TP + 32 * n) * KVW + kind * 128 + g * 64 + (tid & 7) * 8;
                    compress_unit(lds + RING_OFF, arow, KIN(7) + (size_t)(L * 2 + kind) * 2048, (const bf16*)(ws + WS_W1C_T) + (size_t)(L * 2 + kind) * 256 * 2048, KIN(9) + (L * 2 + kind) * 256,
                                  (const bf16*)(ws + WS_W2C_T) + (size_t)(L * 2 + kind) * 64 * 256, (bf16*)(ws + (kind ? WS_CVP : WS_CKP)), 256, rb, tid);
                } else {
                    const int q = u - 32;
                    if (q < 128) gmlp_unit(lds + RING_OFF, lds + LDSCTL_OFF + 1024, 128 * q, (const bf16*)(ws + WS_U), (const bf16*)(ws + WS_V), (const float*)(ws + WS_GWP) + (size_t)L * 8 * 16384, KIN(14) + L * 1024,
                                           KIN(11) + L * 512, KIN(12) + L * 512, (bf16*)(ws + WS_MIX), (float*)nullptr, tid);
                    else gmlp_unit(lds + RING_OFF, lds + LDSCTL_OFF + 1024, MP + 128 * (q - 128), (const bf16*)(ws + WS_U), (const bf16*)(ws + WS_V), (const float*)(ws + WS_GWS) + (size_t)L * 8 * 16384, (const float*)(ws + WS_GBS) + L * 1024,
                                   KIN(11) + L * 512, KIN(12) + L * 512, (bf16*)(ws + WS_MIX), out + O_GV + ((size_t)L * MS + 128 * (q - 128)) * 512, tid);
                }
            }
            SEAM(pb + 1);
        }
        if (IN(pb + 2)) {
            unsigned char* ws = KWS(); float* out = KOUT();
            int lane = threadIdx.x & 63; asm volatile("" : "+v"(lane));
            const bf16* QRAW = (const bf16*)(ws + WS_QRAW); const bf16* QROT = (const bf16*)(ws + WS_QROT); bf16* MIX = (bf16*)(ws + WS_MIX); const float* GATES = (const float*)(ws + WS_GATES);
            LAS float* wl = (LAS float*)(lds + RING_OFF + wave * 4096);
            LAS float* qraw_l = wl; LAS float* qrot_l = wl + 256; LAS float* pbuf = wl + 512; LAS float* impb = wl + 768; LAS int* selidx = (LAS int*)(wl + 896);
            for (int task = gw; task < 2 * MT; task += NGW) {
                const int m = task >> 1, g = task & 1;
                const bool prompt = m < MP;
#pragma unroll
                for (int r = 0; r < 4; ++r) { qraw_l[r * 64 + lane] = 0.125f * bf2f(QRAW[(size_t)m * 512 + (g * 4 + r) * 64 + lane]); qrot_l[r * 64 + lane] = 0.125f * bf2f(QROT[(size_t)m * 512 + (g * 4 + r) * 64 + lane]); }
                impb[lane] = 0.f; impb[64 + lane] = 0.f;
                WAVE_LDS_FENCE();
                float oc[4], os[4], ow[4];
                if (prompt) {
                    const int b = m >> 13, t = m & (TP - 1); const size_t bg = (size_t)(b * 2 + g);
                    const SrcPromptCmp sc{(const bf16*)(ws + WS_CKP) + bg * 256 * 64, (const bf16*)(ws + WS_CVP) + bg * 256 * 64, (t + 1) >> 5};
                    attend(sc, (sc.nvalid + 63) >> 6, qraw_l, pbuf, lane, oc, impb);
                    WAVE_LDS_FENCE();
                    topk16(impb, 128, t >> 6, selidx, lane);
                    const SrcPromptSlc ss{(const bf16*)(ws + WS_KS) + bg * TP * 64, (const bf16*)(ws + WS_VS) + bg * TP * 64, selidx, t};
                    attend(ss, 16, qrot_l, pbuf, lane, os, (LAS float*)nullptr);
                    const int kb0 = (t > 511 ? t - 511 : 0) >> 6;
                    const SrcPromptWin sw{(const bf16*)(ws + WS_KW) + bg * TP * 64, (const bf16*)(ws + WS_VW) + bg * TP * 64, t, kb0};
                    attend(sw, (t >> 6) - kb0 + 1, qrot_l, pbuf, lane, ow, (LAS float*)nullptr);
                } else {
                    const int si = m - MP, bs = si >> 2, s = si & 3;
                    const size_t co = (((size_t)L * NB_S + bs) * 2 + g) * 64 * 64;
                    const SrcSampleCmp sc{(const bf16*)(ws + WS_CKS) + co, (const bf16*)(ws + WS_CVS) + co};
                    attend(sc, 1, qraw_l, pbuf, lane, oc, impb);
                    WAVE_LDS_FENCE();
                    topk16(impb, 33, 32, selidx, lane);
                    const SrcSampleSlc ss{KIN(3) + (size_t)L * NPOOL * PAGE * KVW, (const int*)KIN(5) + bs * NPG, out + O_SLCS + ((size_t)L * MS + bs * 4) * KVW, selidx, g, s};
                    attend(ss, 16, qrot_l, pbuf, lane, os, (LAS float*)nullptr);
                    const SrcSampleWin sw{KIN(4) + ((size_t)L * NB_S + bs) * 512 * KVW, out + O_WINS + (((size_t)L * NB_S + bs) * 512 + 508) * KVW, g, s};
                    attend(sw, 9, qrot_l, pbuf, lane, ow, (LAS float*)nullptr);
                }
                const float* gtp = GATES + (size_t)m * 24;
#pragma unroll
                for (int r = 0; r < 4; ++r) { const int h = g * 4 + r; const float o = gtp[h] * oc[r] + gtp[8 + h] * os[r] + gtp[16 + h] * ow[r];
                    MIX[(size_t)m * DM + h * 64 + lane] = (bf16)f2bf(o); }
                WAVE_LDS_FENCE();
            }
            SEAM(pb + 2);
        }
        if (IN(pb + 3)) {
            unsigned char* ws = KWS();
            pg8::Gemm g{(const bf16*)(ws + WS_MIX), (const bf16*)(ws + WS_WOUT_T) + (size_t)L * DM * DM, MT, DM, DM}; pg8::StaticOrder S; S.init(MT, DM, G, bid);
            EpiResid E{(const float*)(ws + WS_XF), (float*)(ws + WS_PRE)};
            pg8::gemm_phase<EpiResid, pg8::StaticOrder, true, true>(lds + RING_OFF, g, S, E);
            SEAM(pb + 3);
        }
        if (IN(pb + 4)) {
            int lane = threadIdx.x & 63; asm volatile("" : "+v"(lane));
            unsigned char* ws = KWS(); const float* lg = KIN(16) + L * DM; const float* lb = KIN(17) + L * DM;
            for (int row = gw; row < MT; row += NGW) ln_row((const float*)(ws + WS_PRE) + (size_t)row * DM, lg, lb, (float*)(ws + WS_XF) + (size_t)row * DM, (bf16*)(ws + WS_XB) + (size_t)row * DM, lane);
            SEAM(pb + 4);
        }
        if (IN(pb + 5)) {
            unsigned char* ws = KWS();
            pg8::Gemm g{(const bf16*)(ws + WS_XB), (const bf16*)(ws + WS_WGU_T) + (size_t)L * NGU * DM, MT, NGU, DM}; pg8::StaticOrder S; S.init(MT, NGU, G, bid);
            EpiGateUp E{(bf16*)(ws + WS_F)};
            pg8::gemm_phase<EpiGateUp, pg8::StaticOrder, true, true>(lds + RING_OFF, g, S, E);
            SEAM(pb + 5);
        }
        if (IN(pb + 6)) {
            unsigned char* ws = KWS();
            pg8::Gemm g{(const bf16*)(ws + WS_F), (const bf16*)(ws + WS_WDN_T) + (size_t)L * DM * FFN, MT, DM, FFN}; pg8::StaticOrder S; S.init(MT, DM, G, bid);
            EpiResid E{(const float*)(ws + WS_XF), (float*)(ws + WS_PRE)};
            pg8::gemm_phase<EpiResid, pg8::StaticOrder, true, true>(lds + RING_OFF, g, S, E);
            SEAM(pb + 6);
        }
        if (IN(pb + 7)) {
            int lane = threadIdx.x & 63; asm volatile("" : "+v"(lane));
            unsigned char* ws = KWS(); const float* lg = KIN(21) + L * DM; const float* lb = KIN(22) + L * DM;
            const bool last = (L == NLAYER - 1);
            float* dstf = last ? KOUT() + O_Y : (float*)(ws + WS_XF);
            for (int row = gw; row < MT; row += NGW) ln_row((const float*)(ws + WS_PRE) + (size_t)row * DM, lg, lb, dstf + (size_t)row * DM, last ? (bf16*)nullptr : (bf16*)(ws + WS_XB) + (size_t)row * DM, lane);
            SEAM(pb + 7);
        }
    }
#undef IN
#undef SEAM
}

#ifndef SPLIT_LAUNCHES
#define SPLIT_LAUNCHES 1
#endif
extern "C" void kernel_launch(void* const* d_in, const int* in_sizes, int n_in, void* d_out, int out_size, void* d_ws, size_t ws_size, hipStream_t stream) {
    static int grid = 0;
    if (grid == 0) {
        if (n_in != 23 || (size_t)out_size != O_END || ws_size < WS_END) { fprintf(stderr, "kernel_launch: unexpected sizes (n_in %d, out %d, ws %zu); nothing launched\n", n_in, out_size, ws_size); grid = -1; return; }
        int dev = 0, cus = 0, per_cu = 0;
        if (hipGetDevice(&dev) != hipSuccess || hipDeviceGetAttribute(&cus, hipDeviceAttributeMultiprocessorCount, dev) != hipSuccess) { fprintf(stderr, "kernel_launch: device query failed\n"); grid = -1; return; }
        if (hipFuncSetAttribute((const void*)fwd, hipFuncAttributeMaxDynamicSharedMemorySize, LDS_BYTES) != hipSuccess) { fprintf(stderr, "kernel_launch: hipFuncSetAttribute failed\n"); grid = -1; return; }
        if (hipOccupancyMaxActiveBlocksPerMultiprocessor(&per_cu, (const void*)fwd, NWAVES * 64, LDS_BYTES) != hipSuccess || per_cu < 1) fprintf(stderr, "kernel_launch: note: occupancy query reports %d\n", per_cu);
        (void)hipGetLastError();
        grid = cus;
    }
    if (grid < 0) return;
    if (hipMemsetAsync((char*)d_ws + WS_CTL, 0, CTL_ZERO_BYTES, stream) != hipSuccess) { fprintf(stderr, "kernel_launch: memset failed\n"); return; }
    Args a{};
    for (int i = 0; i < 23; ++i) a.in[i] = (const float*)d_in[i];
    a.out = (float*)d_out; a.ws = (unsigned char*)d_ws;
#if SPLIT_LAUNCHES
    for (int ph = 0; ph < N_PHASES; ++ph) { a.ph_lo = ph; a.ph_hi = ph + 1; a.use_bar = 0; a.pad = 0;
        hipLaunchKernelGGL(fwd, dim3(grid), dim3(NWAVES * 64), LDS_BYTES, stream, a); }
#else
    a.ph_lo = 0; a.ph_hi = N_PHASES; a.use_bar = 1; a.pad = 0;
    hipLaunchKernelGGL(fwd, dim3(grid), dim3(NWAVES * 64), LDS_BYTES, stream, a);
#endif
    const hipError_t le = hipPeekAtLastError();
    if (le != hipSuccess) fprintf(stderr, "kernel_launch: launch failed: %s\n", hipGetErrorName(le));
}
```

```cpp
#include <hip/hip_runtime.h>
#include <cstdio>
#include <cstdint>
#include <cmath>
namespace pg8 {
#define PG8_LAS __attribute__((address_space(3)))
typedef unsigned short bf16_t;
typedef short bf16x8 __attribute__((ext_vector_type(8)));
typedef float f32x4 __attribute__((ext_vector_type(4)));
typedef unsigned u32x4 __attribute__((ext_vector_type(4)));
constexpr int BM = 256, BK = 64, HALF = 128, HTB = HALF * BK * 2  , STAGE_BYTES = 8 * HTB, NXCD = 8, WGM = 8;

__host__ __device__ __forceinline__ int lds_byte(int r, int c) { const int st = (r >> 4) * 2 + (c >> 5), rr = r & 15, cc = c & 31, ob = rr * 64 + cc * 2; return st * 1024 + (ob ^ (((ob >> 9) & 1) << 5)); }
__host__ __device__ __forceinline__ void stage_rc(int b, int& R, int& C) { const int st = b / 1024, sb = b % 1024, swz = sb ^ (((sb >> 9) & 1) << 5); R = (st >> 1) * 16 + swz / 64; C = (st & 1) * 32 + (swz % 64) / 2; }
__host__ __device__ __forceinline__ int perm32(int rho) { const int n = rho >> 4, i = rho & 15; return 8 * (i >> 2) + 4 * n + (i & 3); }

struct Unit { int pm, pn; };
struct Gemm { const bf16_t* A; const bf16_t* Bt; int M, N, K; };

struct StaticOrder {
    int nM, nN, nwg, G, c;
    __host__ __device__ void init(int M, int N, int G_, int c_) { nM = M / BM; nN = N / BM; nwg = nM * nN; G = G_; c = c_; }
    __host__ __device__ bool next(int i, Unit& u) const {
        const long L = (long)i * G + c; if (L >= nwg) return false;
        int wgid = (int)L; { const int q = nwg / NXCD, r = nwg % NXCD, xcd = wgid % NXCD, off = wgid / NXCD; wgid = (xcd < r ? xcd * (q + 1) : r * (q + 1) + (xcd - r) * q) + off; }
        const int nig = WGM * nN, gid = wgid / nig, fm = gid * WGM, gsz = (nM - fm) < WGM ? (nM - fm) : WGM;
        u.pm = fm + ((wgid % nig) % gsz); u.pn = (wgid % nig) / gsz; return true;
    }
    __device__ __forceinline__ void a_ready(const Unit&) const {}
    __device__ __forceinline__ void done(const Unit&) const {}
};
__device__ __forceinline__ unsigned cvt_pk_bf16(float lo, float hi) { unsigned r; asm volatile("v_cvt_pk_bf16_f32 %0, %1, %2" : "=v"(r) : "v"(lo), "v"(hi)); return r; }
typedef float f32x2 __attribute__((ext_vector_type(2)));
template <class Epi, class Sched, bool ALIGN_EPI = false, bool SP2 = false>
__device__ __forceinline__ void gemm_phase(PG8_LAS unsigned char* lds, const Gemm g, const Sched& S, const Epi& E) {
    int tid_ = threadIdx.x; asm volatile("" : "+v"(tid_));
    const int tid = tid_, wid = __builtin_amdgcn_readfirstlane(tid >> 6), lane = tid & 63, wr = wid >> 2, wc = wid & 3, fr = lane & 15, fq = lane >> 4;
    const int K = g.K, nt = K / BK;
    unsigned voffA[2], voffB[2];
#pragma unroll
    for (int i = 0; i < 2; ++i) { int R, C; stage_rc(tid * 16 + i * 8192, R, C); const int Rb = Epi::PERM ? ((R & ~31) + perm32(R & 31)) : R;
        voffA[i] = (unsigned)(R * K + C) * 2u; voffB[i] = (unsigned)(Rb * K + C) * 2u; }
    const size_t kstep = (size_t)(BK * 2);
    const size_t hstep = (size_t)HALF * K * 2;
    const size_t tstep = 2 * hstep;
    const unsigned ldsw = (unsigned)wid * 1024u;
    const int aoff = lds_byte(wr * 64 + fr, fq * 8), boff = lds_byte(wc * 32 + fr, fq * 8);
#define PG8_SA(b, h) (((b) * 2 + (h)) * HTB)
#define PG8_SB(b, h) ((4 + (b) * 2 + (h)) * HTB)
#define PG8_STAGE(bufoff, gbase, voff) do { _Pragma("unroll") for (int _i = 0; _i < 2; ++_i) \
        __builtin_amdgcn_global_load_lds((const unsigned*)((const char*)(gbase) + (voff)[_i]), (PG8_LAS unsigned*)(lds + (bufoff) + ldsw + _i * 8192), 16, 0, 0); } while (0)
#define PG8_LDA(dst, b, h) do { _Pragma("unroll") for (int m = 0; m < 4; ++m) _Pragma("unroll") for (int k = 0; k < 2; ++k) dst[m][k] = *(const PG8_LAS bf16x8*)(lds + PG8_SA(b, h) + aoff + m * 2048 + k * 1024); } while (0)
#define PG8_LDB(dst, b, h) do { _Pragma("unroll") for (int n = 0; n < 2; ++n) _Pragma("unroll") for (int k = 0; k < 2; ++k) dst[n][k] = *(const PG8_LAS bf16x8*)(lds + PG8_SB(b, h) + boff + n * 2048 + k * 1024); } while (0)
#define PG8_MMA(ai, bj, At, Bt) do { __builtin_amdgcn_s_setprio(1); _Pragma("unroll") for (int m = 0; m < 4; ++m) _Pragma("unroll") for (int n = 0; n < 2; ++n) _Pragma("unroll") for (int k = 0; k < 2; ++k) \
        acc[ai][bj][m][n] = __builtin_amdgcn_mfma_f32_16x16x32_bf16(Bt[n][k], At[m][k], acc[ai][bj][m][n], 0, 0, 0); __builtin_amdgcn_s_setprio(0); } while (0)
#define PG8_WAIT_V(n) asm volatile("s_waitcnt vmcnt(" #n ")" ::: "memory")
#define PG8_WAIT_L(n) asm volatile("s_waitcnt lgkmcnt(" #n ")" ::: "memory")
#define PG8_BAR __builtin_amdgcn_s_barrier()
#define PG8_SCHED __builtin_amdgcn_sched_barrier(0)
    Unit cur, nxt; int ui = 0;
    if (!S.next(0, cur)) return;
    f32x4 acc[2][2][4][2];
#pragma unroll
    for (int a = 0; a < 2; ++a)
#pragma unroll
        for (int b = 0; b < 2; ++b)
#pragma unroll
            for (int m = 0; m < 4; ++m)
#pragma unroll
                for (int n = 0; n < 2; ++n) acc[a][b][m][n] = (f32x4){0.f, 0.f, 0.f, 0.f};
    bf16x8 At[4][2], B0[2][2], B1[2][2];
    const char* cA = (const char*)g.A + (size_t)cur.pm * tstep; const char* cB = (const char*)g.Bt + (size_t)cur.pn * tstep;
    S.a_ready(cur);
    if constexpr (SP2) {
        PG8_STAGE(PG8_SB(0, 0), cB, voffB); PG8_STAGE(PG8_SB(0, 1), cB + hstep, voffB); PG8_STAGE(PG8_SA(0, 0), cA, voffA); PG8_STAGE(PG8_SA(0, 1), cA + hstep, voffA);
        if (wr == 1) PG8_BAR;
        PG8_WAIT_V(2); PG8_BAR;
        PG8_STAGE(PG8_SB(1, 0), cB + kstep, voffB); PG8_STAGE(PG8_SA(1, 0), cA + kstep, voffA); PG8_STAGE(PG8_SB(1, 1), cB + hstep + kstep, voffB);
        PG8_WAIT_V(6); PG8_BAR;
    } else {
        PG8_STAGE(PG8_SB(0, 0), cB, voffB); PG8_STAGE(PG8_SA(0, 0), cA, voffA); PG8_STAGE(PG8_SB(0, 1), cB + hstep, voffB); PG8_STAGE(PG8_SA(0, 1), cA + hstep, voffA);
        if (wr == 1) PG8_BAR;
        PG8_WAIT_V(4); PG8_BAR;
        PG8_STAGE(PG8_SB(1, 0), cB + kstep, voffB); PG8_STAGE(PG8_SA(1, 0), cA + kstep, voffA); PG8_STAGE(PG8_SB(1, 1), cB + hstep + kstep, voffB);
        PG8_WAIT_V(6); PG8_BAR;
    }
    for (;;) {
        const bool has_next = S.next(ui + 1, nxt);
        const char* nA = has_next ? (const char*)g.A + (size_t)nxt.pm * tstep : cA; const char* nB = has_next ? (const char*)g.Bt + (size_t)nxt.pn * tstep : cB;
        for (int t = 0; t < nt; t += 2) {
            const bool last = (t == nt - 2);
            const char* a1 = cA + (size_t)(t + 1) * kstep;
            const char* a2 = last ? nA : cA + (size_t)(t + 2) * kstep; const char* b2 = last ? nB : cB + (size_t)(t + 2) * kstep;
            const char* a3 = a2 + kstep; const char* b3 = b2 + kstep;
            if (last && has_next) S.a_ready(nxt);
            if constexpr (SP2) {
            PG8_LDB(B0, 0, 0); PG8_LDB(B1, 0, 1); PG8_SCHED; PG8_LDA(At, 0, 0); PG8_STAGE(PG8_SA(1, 1), a1 + hstep, voffA);
            PG8_WAIT_V(8); PG8_WAIT_L(0); PG8_BAR; PG8_MMA(0, 0, At, B0); PG8_MMA(0, 1, At, B1); PG8_BAR; PG8_SCHED;
            PG8_LDA(At, 0, 1); PG8_STAGE(PG8_SB(0, 0), b2, voffB); PG8_STAGE(PG8_SB(0, 1), b2 + hstep, voffB); PG8_STAGE(PG8_SA(0, 0), a2, voffA);
            PG8_WAIT_V(8); PG8_WAIT_L(0); PG8_BAR; PG8_MMA(1, 0, At, B0); PG8_MMA(1, 1, At, B1); PG8_BAR; PG8_SCHED;
            PG8_LDB(B0, 1, 0); PG8_LDB(B1, 1, 1); PG8_SCHED; PG8_LDA(At, 1, 0); PG8_STAGE(PG8_SA(0, 1), a2 + hstep, voffA);
            PG8_WAIT_V(8); PG8_WAIT_L(0); PG8_BAR; PG8_MMA(0, 0, At, B0); PG8_MMA(0, 1, At, B1); PG8_BAR; PG8_SCHED;
            PG8_LDA(At, 1, 1); PG8_STAGE(PG8_SB(1, 0), b3, voffB); PG8_STAGE(PG8_SB(1, 1), b3 + hstep, voffB); PG8_STAGE(PG8_SA(1, 0), a3, voffA);
            PG8_WAIT_V(8); PG8_WAIT_L(0); PG8_BAR; PG8_MMA(1, 0, At, B0); PG8_MMA(1, 1, At, B1); PG8_BAR; PG8_SCHED;
            } else {
            PG8_LDB(B0, 0, 0); PG8_SCHED; PG8_LDA(At, 0, 0); PG8_STAGE(PG8_SA(1, 1), a1 + hstep, voffA);
            PG8_WAIT_L(8); PG8_BAR; PG8_WAIT_L(0); PG8_MMA(0, 0, At, B0); PG8_BAR; PG8_SCHED;
            PG8_LDB(B1, 0, 1); PG8_STAGE(PG8_SB(0, 0), b2, voffB);
            PG8_BAR; PG8_WAIT_L(0); PG8_MMA(0, 1, At, B1); PG8_BAR;
            PG8_LDA(At, 0, 1); PG8_STAGE(PG8_SA(0, 0), a2, voffA);
            PG8_BAR; PG8_WAIT_L(0); PG8_MMA(1, 0, At, B0); PG8_BAR; PG8_SCHED;
            PG8_STAGE(PG8_SB(0, 1), b2 + hstep, voffB);
            PG8_WAIT_V(6); PG8_BAR; PG8_MMA(1, 1, At, B1); PG8_BAR;
            PG8_LDB(B0, 1, 0); PG8_SCHED; PG8_LDA(At, 1, 0); PG8_STAGE(PG8_SA(0, 1), a2 + hstep, voffA);
            PG8_WAIT_L(8); PG8_BAR; PG8_WAIT_L(0); PG8_MMA(0, 0, At, B0); PG8_BAR; PG8_SCHED;
            PG8_LDB(B1, 1, 1); PG8_STAGE(PG8_SB(1, 0), b3, voffB);
            PG8_BAR; PG8_WAIT_L(0); PG8_MMA(0, 1, At, B1); PG8_BAR;
            PG8_LDA(At, 1, 1); PG8_STAGE(PG8_SA(1, 0), a3, voffA);
            PG8_BAR; PG8_WAIT_L(0); PG8_MMA(1, 0, At, B0); PG8_BAR; PG8_SCHED;
            PG8_STAGE(PG8_SB(1, 1), b3 + hstep, voffB);
            PG8_WAIT_V(6); PG8_BAR; PG8_MMA(1, 1, At, B1); PG8_BAR;
            }
        }
        if constexpr (ALIGN_EPI) { if (wr == 0) PG8_BAR; }
        if constexpr (!Epi::AFTER_DRAIN) { E(acc, cur, wr, wc, fr, fq); S.done(cur); }
        if (!has_next) break;
#pragma unroll
        for (int a = 0; a < 2; ++a)
#pragma unroll
            for (int b = 0; b < 2; ++b)
#pragma unroll
                for (int m = 0; m < 4; ++m)
#pragma unroll
                    for (int n = 0; n < 2; ++n) acc[a][b][m][n] = (f32x4){0.f, 0.f, 0.f, 0.f};
        cur = nxt; cA = nA; cB = nB; ++ui;
        if constexpr (ALIGN_EPI) { if (wr == 1) PG8_BAR; }
    }
    PG8_WAIT_V(0);
    if constexpr (!ALIGN_EPI) { if (wr == 0) PG8_BAR; }
    PG8_BAR;
    if constexpr (Epi::AFTER_DRAIN) { E.fused(acc, cur, wr, wc, fr, fq, lds, wid, lane); S.done(cur); }
#undef PG8_SA
#undef PG8_SB
#undef PG8_STAGE
#undef PG8_LDA
#undef PG8_LDB
#undef PG8_MMA
#undef PG8_WAIT_V
#undef PG8_WAIT_L
#undef PG8_BAR
#undef PG8_SCHED
}
}
#define GAS __attribute__((address_space(1)))
#define LAS __attribute__((address_space(3)))
typedef unsigned short bf16;
typedef unsigned v4u __attribute__((ext_vector_type(4)));
typedef float f32x4 __attribute__((ext_vector_type(4)));
typedef short bf16x8 __attribute__((ext_vector_type(8)));
typedef GAS unsigned gu32;
typedef GAS unsigned long long gu64;
#define RLX_AGENT __ATOMIC_RELAXED, __HIP_MEMORY_SCOPE_AGENT
#define LDS_WAIT() asm volatile("s_waitcnt lgkmcnt(0)" ::: "memory")
#define VM_WAIT() asm volatile("s_waitcnt vmcnt(0)" ::: "memory")
__device__ __forceinline__ unsigned long long rt() { return __builtin_amdgcn_s_memrealtime(); }
__device__ __forceinline__ unsigned f2bf(float f) { unsigned u = __builtin_bit_cast(unsigned, f); return (u + 0x7fffu + ((u >> 16) & 1u)) >> 16; }
__device__ __forceinline__ unsigned pk2(float lo, float hi) { return f2bf(lo) | (f2bf(hi) << 16); }

#define XB_TMO      128
#define XB_XCNT(j)  (256  + 64 * (j))
#define XB_XSUB(j)  (1280 + 64 * (j))
#define XB_XGEN(j)  (2304 + 64 * (j))
#define XB_TOP      3328
#define XB_TOPGEN   3392
#define XCD_BAR_WORDS 3456
#define XB_SPIN_CAP (1u << 18)

__device__ __forceinline__ unsigned xb_ld(unsigned* p)              { return __hip_atomic_load(p, __ATOMIC_RELAXED, __HIP_MEMORY_SCOPE_AGENT); }
__device__ __forceinline__ unsigned xb_add(unsigned* p, unsigned v) { return __hip_atomic_fetch_add(p, v, __ATOMIC_RELAXED, __HIP_MEMORY_SCOPE_AGENT); }
__device__ __forceinline__ unsigned xb_xcc_id() { return (unsigned)__builtin_amdgcn_s_getreg((3 << 11) | 20) & 0xFu; }
#define XB_SPIN(cond, bar) do { unsigned _sp = 0; while (cond) { __builtin_amdgcn_s_sleep(1); \
    if ((++_sp & 255u) == 0u) { if (xb_ld(&(bar)[XB_TMO])) break; if (_sp > XB_SPIN_CAP) { atomicAdd(&(bar)[XB_TMO], 1u); break; } } } } while (0)

struct XcdBarrier {
    unsigned* bar; unsigned x;
    volatile LAS unsigned* st;
};

__device__ __forceinline__ XcdBarrier xcd_barrier_post(unsigned* bar, volatile LAS unsigned* st) {
    XcdBarrier b; b.bar = bar; b.x = xb_xcc_id(); b.st = st;
    if (threadIdx.x == 0) (void)xb_add(&bar[XB_XCNT(b.x)], 1u);
    return b;
}
__device__ __forceinline__ void xcd_barrier_complete(unsigned* bar, unsigned x, unsigned& nloc, unsigned& nx) {
    const unsigned G = gridDim.x * gridDim.y * gridDim.z;
    unsigned sum, cnt, mine, sp = 0u;
    for (;;) {
        sum = 0u; cnt = 0u; mine = 0u;
#pragma unroll
        for (unsigned j = 0; j < 16; ++j) { const unsigned c = xb_ld(&bar[XB_XCNT(j)]); sum += c; cnt += (c > 0u) ? 1u : 0u; mine = (j == x) ? c : mine; }
        if (sum == G) break;
        __builtin_amdgcn_s_sleep(1);
        if ((++sp & 255u) == 0u) { if (xb_ld(&bar[XB_TMO])) break; if (sp > XB_SPIN_CAP) { atomicAdd(&bar[XB_TMO], 1u); break; } }
    }
    nloc = mine > 0u ? mine : 1u; nx = cnt > 0u ? cnt : 1u;
}

__device__ __forceinline__ void xcd_barrier(const XcdBarrier& b) {
    asm volatile("s_waitcnt vmcnt(0)" ::: "memory");
    __syncthreads();
    if (threadIdx.x == 0) {
        unsigned* bar = b.bar;
        __builtin_amdgcn_s_waitcnt(0);
        unsigned nloc = b.st[0], nx = b.st[1];
        if (nloc == 0u) { xcd_barrier_complete(bar, b.x, nloc, nx); b.st[0] = nloc; b.st[1] = nx; }
        const unsigned old = xb_add(&bar[XB_XSUB(b.x)], 1u);
        const unsigned gen = old / nloc;
        if (old + 1u == (gen + 1u) * nloc) {
            __builtin_amdgcn_fence(__ATOMIC_RELEASE, "agent");
            asm volatile("s_waitcnt vmcnt(0)" ::: "memory");
            const unsigned og = xb_add(&bar[XB_TOP], 1u);
            const unsigned tg = og / nx;
            if (og + 1u == (tg + 1u) * nx) xb_add(&bar[XB_TOPGEN], 1u);
            else XB_SPIN(xb_ld(&bar[XB_TOPGEN]) == tg, bar);
            __builtin_amdgcn_fence(__ATOMIC_ACQUIRE, "agent");
            xb_add(&bar[XB_XGEN(b.x)], 1u);
            asm volatile("s_waitcnt vmcnt(0)" ::: "memory");
        } else {
            XB_SPIN(xb_ld(&bar[XB_XGEN(b.x)]) == gen, bar);
            __builtin_amdgcn_fence(__ATOMIC_ACQUIRE, "agent");
            asm volatile("s_waitcnt vmcnt(0)" ::: "memory");
        }
    }
    __syncthreads();
}
constexpr int DM = 1024;
constexpr int TP = 8192, BP = 2, MP = BP * TP;
constexpr int NB_S = 128, SS = 4, MS = NB_S * SS;
constexpr int MT = MP + MS;
constexpr int PIN = 2328, NIN = 2560;
constexpr int FFN = 2816, NGU = 2 * FFN;
constexpr int PAST = 2048, PAGE = 128, NPG = PAST / PAGE, NPOOL = 2560;
constexpr int KVW = 256;
constexpr int NLAYER = 2;
constexpr float LN_EPS = 1e-5f;
constexpr float DN_ALPHA = 1.4142135623730951f;

constexpr size_t O_Y = 0;
constexpr size_t O_CMPP = (size_t)MT * DM;
constexpr size_t O_SLCP = O_CMPP + (size_t)NLAYER * MP * KVW;
constexpr size_t O_WINP = O_SLCP + (size_t)NLAYER * MP * KVW;
constexpr size_t O_CMPS = O_WINP + (size_t)NLAYER * BP * 512 * KVW;
constexpr size_t O_SLCS = O_CMPS + (size_t)NLAYER * MS * KVW;
constexpr size_t O_WINS = O_SLCS + (size_t)NLAYER * MS * KVW;
constexpr size_t O_GV = O_WINS + (size_t)NLAYER * NB_S * 512 * KVW;
constexpr size_t O_END = O_GV + (size_t)NLAYER * MS * 512;
static_assert(O_END == 69206016, "output size");

constexpr size_t MiB = 1u << 20;
constexpr size_t WS_CTL = 0, CTL_ZERO_BYTES = 1 * MiB;
constexpr size_t WS_ROPE = 1 * MiB;
constexpr size_t WS_WIN_T = 4 * MiB;
constexpr size_t WS_WOUT_T = 14 * MiB;
constexpr size_t WS_WGU_T = 18 * MiB;
constexpr size_t WS_WDN_T = 40 * MiB;
constexpr size_t WS_W1C_T = 52 * MiB;
constexpr size_t WS_W2C_T = 56 * MiB;
constexpr size_t WS_GWP = 57 * MiB;
constexpr size_t WS_GWS = 58 * MiB;
constexpr size_t WS_GBS = 59 * MiB;
constexpr size_t WS_XF = 64 * MiB;
constexpr size_t WS_XB = 130 * MiB;
constexpr size_t WS_PRE = 163 * MiB;
constexpr size_t WS_QRAW = 229 * MiB;
constexpr size_t WS_QROT = 246 * MiB;
constexpr size_t WS_KS = 263 * MiB;
constexpr size_t WS_VS = 267 * MiB;
constexpr size_t WS_KW = 271 * MiB;
constexpr size_t WS_VW = 275 * MiB;
constexpr size_t WS_U = 279 * MiB;
constexpr size_t WS_V = 296 * MiB;
constexpr size_t WS_GATES = 313 * MiB;
constexpr size_t WS_CKP = 315 * MiB;
constexpr size_t WS_CVP = WS_CKP + 512 * 1024;
constexpr size_t WS_CKS = 316 * MiB;
constexpr size_t WS_CVS = 320 * MiB;
constexpr size_t WS_MIX = 324 * MiB;
constexpr size_t WS_F = 357 * MiB;
constexpr size_t WS_END = 448 * MiB;
static_assert(WS_XF + (size_t)MT * DM * 4 <= WS_XB && WS_XB + (size_t)MT * DM * 2 <= WS_PRE && WS_PRE + (size_t)MT * DM * 4 <= WS_QRAW, "ws map 1");
static_assert(WS_QRAW + (size_t)MT * 512 * 2 <= WS_QROT && WS_QROT + (size_t)MT * 512 * 2 <= WS_KS && WS_U + (size_t)MT * 512 * 2 <= WS_V && WS_V + (size_t)MT * 512 * 2 <= WS_GATES, "ws map 2");
static_assert(WS_GATES + (size_t)MT * 24 * 4 <= WS_CKP && WS_MIX + (size_t)MT * DM * 2 <= WS_F && WS_F + (size_t)MT * FFN * 2 <= WS_END, "ws map 3");
static_assert(WS_WIN_T + (size_t)2 * NIN * DM * 2 <= WS_WOUT_T && WS_WGU_T + (size_t)2 * NGU * DM * 2 <= WS_WDN_T && WS_WDN_T + (size_t)2 * DM * FFN * 2 <= WS_W1C_T, "ws map 4");

constexpr int CW_TMO = 0, CW_CODE = 1;
constexpr int CW_BAR = 4096;

constexpr int NWAVES = 8;
constexpr int RING_OFF = 0, RING_BYTES = 131072;
constexpr int LDSCTL_OFF = RING_BYTES, MISC_OFF = LDSCTL_OFF + 320;
constexpr int LDS_BYTES = 147456;

constexpr int PH_P0A = 0, PH_P0B = 1, PH_L0 = 2, PH_PER_LAYER = 8, N_PHASES = PH_L0 + NLAYER * PH_PER_LAYER;
typedef float f32x2 __attribute__((ext_vector_type(2)));
typedef unsigned u32x2 __attribute__((ext_vector_type(2)));
__device__ __forceinline__ float bf2f(unsigned short h) { return __uint_as_float(((unsigned)h) << 16); }
__device__ __forceinline__ float bflo(unsigned w) { return __uint_as_float(w << 16); }
__device__ __forceinline__ float bfhi(unsigned w) { return __uint_as_float(w & 0xffff0000u); }
__device__ __forceinline__ float wave_sum(float v) {
#pragma unroll
    for (int o = 1; o < 64; o <<= 1) v += __shfl_xor(v, o);
    return v;
}
__device__ __forceinline__ float wave_max(float v) {
#pragma unroll
    for (int o = 1; o < 64; o <<= 1) v = fmaxf(v, __shfl_xor(v, o));
    return v;
}
__device__ __forceinline__ float sigmoidf_(float x) { return 1.0f / (1.0f + __expf(-x)); }
__device__ __forceinline__ float siluf_(float x) { return x / (1.0f + __expf(-x)); }
__device__ __forceinline__ float geluf_(float x) { const float u = 1.5957691216057308f * (x + 0.044715f * x * x * x); return x / (1.0f + __expf(-u)); }
#define WAVE_LDS_FENCE() asm volatile("s_waitcnt lgkmcnt(0)" ::: "memory")

struct EpiResid {
    static constexpr bool PERM = false, AFTER_DRAIN = false;
    const float* xf; float* pre;
    __device__ __forceinline__ void operator()(const pg8::f32x4 (&acc)[2][2][4][2], const pg8::Unit& u, int wr, int wc, int fr, int fq) const {
        const int col0 = u.pn * 256 + wc * 32 + 4 * fq;
#pragma unroll
        for (int ai = 0; ai < 2; ++ai)
#pragma unroll
            for (int m = 0; m < 4; ++m) {
                const size_t off = (size_t)(u.pm * 256 + ai * 128 + wr * 64 + m * 16 + fr) * DM + col0;
#pragma unroll
                for (int bj = 0; bj < 2; ++bj)
#pragma unroll
                    for (int n = 0; n < 2; ++n) {
                        const pg8::f32x4 x = *(const pg8::f32x4*)(xf + off + bj * 128 + n * 16);
                        *(pg8::f32x4*)(pre + off + bj * 128 + n * 16) = x * DN_ALPHA + acc[ai][bj][m][n];
                    }
            }
    }
};
struct EpiGateUp {
    static constexpr bool PERM = true, AFTER_DRAIN = false;
    bf16* f;
    __device__ __forceinline__ void operator()(const pg8::f32x4 (&acc)[2][2][4][2], const pg8::Unit& u, int wr, int wc, int fr, int fq) const {
        const int c8 = u.pn * 256 + wc * 32 + 8 * fq;
#pragma unroll
        for (int ai = 0; ai < 2; ++ai)
#pragma unroll
            for (int m = 0; m < 4; ++m) {
                const size_t row = (size_t)(u.pm * 256 + ai * 128 + wr * 64 + m * 16 + fr);
#pragma unroll
                for (int bj = 0; bj < 2; ++bj) {
                    const pg8::f32x4 v0 = acc[ai][bj][m][0], v1 = acc[ai][bj][m][1];
                    const float o0 = siluf_(v0[0]) * v0[1], o1 = siluf_(v0[2]) * v0[3], o2 = siluf_(v1[0]) * v1[1], o3 = siluf_(v1[2]) * v1[3];
                    u32x2 w; w.x = pk2(o0, o1); w.y = pk2(o2, o3);
                    *(u32x2*)(f + row * FFN + ((c8 + bj * 128) >> 1)) = w;
                }
            }
    }
};
struct EpiInProj {
    static constexpr bool PERM = true, AFTER_DRAIN = false;
    int layer; unsigned char* ws; float* out;
    __device__ __forceinline__ void operator()(const pg8::f32x4 (&acc)[2][2][4][2], const pg8::Unit& u, int wr, int wc, int fr, int fq) const {
        const int pn = u.pn;
        const f32x2* rope = (const f32x2*)(ws + WS_ROPE); bf16* qraw = (bf16*)(ws + WS_QRAW); bf16* qrot = (bf16*)(ws + WS_QROT);
        bf16* KS = (bf16*)(ws + WS_KS); bf16* VS = (bf16*)(ws + WS_VS); bf16* KW = (bf16*)(ws + WS_KW); bf16* VW = (bf16*)(ws + WS_VW);
        bf16* U = (bf16*)(ws + WS_U); bf16* V = (bf16*)(ws + WS_V); float* gates = (float*)(ws + WS_GATES);
#pragma unroll
        for (int ai = 0; ai < 2; ++ai)
#pragma unroll
            for (int m = 0; m < 4; ++m) {
                const int r = u.pm * 256 + ai * 128 + wr * 64 + m * 16 + fr;
                const bool prompt = r < MP;
                const int b = r >> 13, t = r & (TP - 1);
                const int si = r - MP, bs = si >> 2, s = si & 3;
                const int pos = prompt ? t : PAST + s;
#pragma unroll
                for (int bj = 0; bj < 2; ++bj) {
                    const int c8 = pn * 256 + bj * 128 + wc * 32 + 8 * fq;
                    const pg8::f32x4 v0 = acc[ai][bj][m][0], v1 = acc[ai][bj][m][1];
                    if (pn < 2) {
                        const int h = c8 >> 6, d = (c8 & 63) >> 1;
                        const f32x2 cs0 = rope[pos * 32 + d], cs1 = rope[pos * 32 + d + 1], cs2 = rope[pos * 32 + d + 2], cs3 = rope[pos * 32 + d + 3];
                        const float a0 = v0[0], b0 = v0[1], a1 = v0[2], b1 = v0[3], a2 = v1[0], b2 = v1[1], a3 = v1[2], b3 = v1[3];
                        const size_t o = (size_t)r * 512 + h * 64 + d;
                        u32x2 w;
                        w.x = pk2(a0, a1); w.y = pk2(a2, a3); *(u32x2*)(qraw + o) = w;
                        w.x = pk2(b0, b1); w.y = pk2(b2, b3); *(u32x2*)(qraw + o + 32) = w;
                        w.x = pk2(a0 * cs0.x - b0 * cs0.y, a1 * cs1.x - b1 * cs1.y); w.y = pk2(a2 * cs2.x - b2 * cs2.y, a3 * cs3.x - b3 * cs3.y); *(u32x2*)(qrot + o) = w;
                        w.x = pk2(b0 * cs0.x + a0 * cs0.y, b1 * cs1.x + a1 * cs1.y); w.y = pk2(b2 * cs2.x + a2 * cs2.y, b3 * cs3.x + a3 * cs3.y); *(u32x2*)(qrot + o + 32) = w;
                    } else if (pn == 2) {
                        const int cc = c8 - 512;
                        float* dst = prompt ? out + O_CMPP + ((size_t)(layer * BP + b) * TP + t) * KVW + cc : out + O_CMPS + ((size_t)layer * MS + si) * KVW + cc;
                        *(pg8::f32x4*)dst = v0; *(pg8::f32x4*)(dst + 4) = v1;
                    } else if (pn == 3 || pn == 4) {
                        const bool is_slc = (pn == 3);
                        const int cc = c8 - (is_slc ? 768 : 1024);
                        float* dst;
                        bool wr_out = true;
                        if (is_slc) dst = prompt ? out + O_SLCP + ((size_t)(layer * BP + b) * TP + t) * KVW : out + O_SLCS + ((size_t)layer * MS + si) * KVW;
                        else { if (prompt) { wr_out = (t >= TP - 512); dst = out + O_WINP + ((size_t)(layer * BP + b) * 512 + (t - (TP - 512))) * KVW; }
                               else dst = out + O_WINS + ((size_t)(layer * NB_S + bs) * 512 + 508 + s) * KVW; }
                        if (cc < 128) {
                            const int g = cc >> 6, d = (cc & 63) >> 1;
                            const f32x2 cs0 = rope[pos * 32 + d], cs1 = rope[pos * 32 + d + 1], cs2 = rope[pos * 32 + d + 2], cs3 = rope[pos * 32 + d + 3];
                            const float a0 = v0[0], b0 = v0[1], a1 = v0[2], b1 = v0[3], a2 = v1[0], b2 = v1[1], a3 = v1[2], b3 = v1[3];
                            const pg8::f32x4 lo = {a0 * cs0.x - b0 * cs0.y, a1 * cs1.x - b1 * cs1.y, a2 * cs2.x - b2 * cs2.y, a3 * cs3.x - b3 * cs3.y};
                            const pg8::f32x4 hi = {b0 * cs0.x + a0 * cs0.y, b1 * cs1.x + a1 * cs1.y, b2 * cs2.x + a2 * cs2.y, b3 * cs3.x + a3 * cs3.y};
                            if (wr_out) { *(pg8::f32x4*)(dst + g * 64 + d) = lo; *(pg8::f32x4*)(dst + g * 64 + d + 32) = hi; }
                            if (prompt) { bf16* kb = (is_slc ? KS : KW) + ((size_t)(b * 2 + g) * TP + t) * 64 + d;
                                u32x2 w; w.x = pk2(lo[0], lo[1]); w.y = pk2(lo[2], lo[3]); *(u32x2*)kb = w;
                                w.x = pk2(hi[0], hi[1]); w.y = pk2(hi[2], hi[3]); *(u32x2*)(kb + 32) = w; }
                        } else {
                            const int g = (cc - 128) >> 6, d = cc & 63;
                            if (wr_out) { *(pg8::f32x4*)(dst + cc) = v0; *(pg8::f32x4*)(dst + cc + 4) = v1; }
                            if (prompt) { bf16* vb = (is_slc ? VS : VW) + ((size_t)(b * 2 + g) * TP + t) * 64 + d;
                                v4u w; w.x = pk2(v0[0], v0[1]); w.y = pk2(v0[2], v0[3]); w.z = pk2(v1[0], v1[1]); w.w = pk2(v1[2], v1[3]); *(v4u*)vb = w; }
                        }
                    } else if (pn < 9) {
                        const bool is_u = pn < 7;
                        const int cc = c8 - (is_u ? 1280 : 1792);
                        bf16* dst = (is_u ? U : V) + (size_t)r * 512 + cc;
                        v4u w; w.x = pk2(geluf_(v0[0]), geluf_(v0[1])); w.y = pk2(geluf_(v0[2]), geluf_(v0[3])); w.z = pk2(geluf_(v1[0]), geluf_(v1[1])); w.w = pk2(geluf_(v1[2]), geluf_(v1[3]));
                        *(v4u*)dst = w;
                    } else {
                        const int cc = c8 - 2304;
                        if (cc < 24) { float* dst = gates + (size_t)r * 24 + cc;
                            const pg8::f32x4 g0 = {sigmoidf_(v0[0]), sigmoidf_(v0[1]), sigmoidf_(v0[2]), sigmoidf_(v0[3])}, g1 = {sigmoidf_(v1[0]), sigmoidf_(v1[1]), sigmoidf_(v1[2]), sigmoidf_(v1[3])};
                            *(pg8::f32x4*)dst = g0; *(pg8::f32x4*)(dst + 4) = g1; }
                    }
                }
            }
    }
};

template <class RowMap>
__device__ __forceinline__ void transpose_item(const float* W, int K, int N, bf16* WT, const RowMap rm, LAS float* scr, int item, int lane) {
    const int nblk = (N + 31) / 32, kb = item / nblk, nb = item % nblk, k0 = 64 * kb, n0 = 32 * nb;
    const int ncol = n0 + (lane & 31);
#pragma unroll 8
    for (int i = 0; i < 32; ++i) { const int kk = 2 * i + (lane >> 5); scr[kk * 33 + (lane & 31)] = (ncol < N) ? W[(size_t)(k0 + kk) * N + ncol] : 0.f; }
    LDS_WAIT(); asm volatile("" ::: "memory");
    const int c = lane & 7;
#pragma unroll
    for (int j = 0; j < 4; ++j) { const int nl = (lane >> 3) + 8 * j; const LAS float* s = scr + (8 * c) * 33 + nl;
        v4u o; o.x = pk2(s[0 * 33], s[1 * 33]); o.y = pk2(s[2 * 33], s[3 * 33]); o.z = pk2(s[4 * 33], s[5 * 33]); o.w = pk2(s[6 * 33], s[7 * 33]);
        if (n0 + nl < N) *(v4u*)(WT + (size_t)rm(n0 + nl) * K + k0 + 8 * c) = o; }
    LDS_WAIT(); asm volatile("" ::: "memory");
}
struct RmIdent { __device__ __forceinline__ int operator()(int n) const { return n; } };
struct RmAffine { int mul, add; __device__ __forceinline__ int operator()(int n) const { return n * mul + add; } };
__device__ __forceinline__ int rope_il(int d) { return d < 32 ? 2 * d : 2 * (d - 32) + 1; }
struct RmInProj { __device__ __forceinline__ int operator()(int c) const {
    if (c < 512) return (c & ~63) + rope_il(c & 63);
    if (c < 768) return c;
    if (c < 1280) { const int base = c < 1024 ? 768 : 1024, cc = c - base; return cc < 128 ? base + (cc & ~63) + rope_il(cc & 63) : c; }
    if (c < 1304) return 2304 + (c - 1280);
    return 1280 + (c - 1304); } };
constexpr int CU_AS = 0, CU_BS = 9216, CU_HS = 46080, CU_LDS = 79872;
__device__ __forceinline__ void compress_unit(LAS unsigned char* lds, const float* arow, const float* pe_k, const bf16* W1t, const float* b1, const bf16* W2t,
                                              bf16* obase, int NC, int rb, int tid) {
    const int wid = __builtin_amdgcn_readfirstlane(tid >> 6), lane = tid & 63, fr = lane & 15, fq = lane >> 4, wr = wid >> 2, wc = wid & 3;
    const int arow_i = tid >> 3, ac = tid & 7;
    pg8::f32x4 acc[2][4];
#pragma unroll
    for (int m = 0; m < 2; ++m)
#pragma unroll
        for (int n = 0; n < 4; ++n) acc[m][n] = (pg8::f32x4){0.f, 0.f, 0.f, 0.f};
    pg8::f32x4 a0, a1, p0, p1; v4u bq[4];
    const float* pe_t = pe_k + ac * 8;
    const bf16* bsrc = W1t + (size_t)arow_i * 2048 + ac * 8;
    a0 = *(const pg8::f32x4*)arow; a1 = *(const pg8::f32x4*)(arow + 4); p0 = *(const pg8::f32x4*)pe_t; p1 = *(const pg8::f32x4*)(pe_t + 4);
#pragma unroll
    for (int j = 0; j < 4; ++j) bq[j] = *(const v4u*)(bsrc + (size_t)j * 64 * 2048);
    for (int l = 0; l < 32; ++l) {
        { v4u w; a0 = a0 + p0; a1 = a1 + p1; w.x = pk2(a0[0], a0[1]); w.y = pk2(a0[2], a0[3]); w.z = pk2(a1[0], a1[1]); w.w = pk2(a1[2], a1[3]);
          *(LAS v4u*)(lds + CU_AS + arow_i * 144 + ac * 16) = w;
#pragma unroll
          for (int j = 0; j < 4; ++j) *(LAS v4u*)(lds + CU_BS + (arow_i + 64 * j) * 144 + ac * 16) = bq[j]; }
        __syncthreads();
        if (l + 1 < 32) {
            const float* an = arow + (size_t)(l + 1) * KVW; const float* pn = pe_t + (l + 1) * 64; const bf16* bn = bsrc + (l + 1) * 64;
            a0 = *(const pg8::f32x4*)an; a1 = *(const pg8::f32x4*)(an + 4); p0 = *(const pg8::f32x4*)pn; p1 = *(const pg8::f32x4*)(pn + 4);
#pragma unroll
            for (int j = 0; j < 4; ++j) bq[j] = *(const v4u*)(bn + (size_t)j * 64 * 2048);
        }
#pragma unroll
        for (int kk = 0; kk < 2; ++kk) {
            bf16x8 af[2], bfr[4];
#pragma unroll
            for (int m = 0; m < 2; ++m) af[m] = *(const LAS bf16x8*)(lds + CU_AS + (wr * 32 + m * 16 + fr) * 144 + (kk * 32 + fq * 8) * 2);
#pragma unroll
            for (int n = 0; n < 4; ++n) bfr[n] = *(const LAS bf16x8*)(lds + CU_BS + (wc * 64 + n * 16 + fr) * 144 + (kk * 32 + fq * 8) * 2);
#pragma unroll
            for (int m = 0; m < 2; ++m)
#pragma unroll
                for (int n = 0; n < 4; ++n) acc[m][n] = __builtin_amdgcn_mfma_f32_16x16x32_bf16(af[m], bfr[n], acc[m][n], 0, 0, 0);
        }
        __syncthreads();
    }
#pragma unroll
    for (int m = 0; m < 2; ++m)
#pragma unroll
        for (int n = 0; n < 4; ++n) { const int col = wc * 64 + n * 16 + fr; const float bb = b1[col];
#pragma unroll
            for (int rg = 0; rg < 4; ++rg) { const int row = wr * 32 + m * 16 + fq * 4 + rg;
                *(LAS unsigned short*)(lds + CU_HS + row * 528 + col * 2) = (unsigned short)f2bf(siluf_(acc[m][n][rg] + bb)); } }
    __syncthreads();
    {
        const int rt = wid >> 1, ch = wid & 1;
        pg8::f32x4 acc2[2] = {(pg8::f32x4){0.f, 0.f, 0.f, 0.f}, (pg8::f32x4){0.f, 0.f, 0.f, 0.f}};
#pragma unroll
        for (int ks = 0; ks < 8; ++ks) {
            const bf16x8 a = *(const LAS bf16x8*)(lds + CU_HS + (rt * 16 + fr) * 528 + (ks * 32 + fq * 8) * 2);
#pragma unroll
            for (int nn = 0; nn < 2; ++nn) { const bf16x8 bb = *(const bf16x8*)(W2t + (size_t)(ch * 32 + nn * 16 + fr) * 256 + ks * 32 + fq * 8);
                acc2[nn] = __builtin_amdgcn_mfma_f32_16x16x32_bf16(a, bb, acc2[nn], 0, 0, 0); }
        }
#pragma unroll
        for (int nn = 0; nn < 2; ++nn)
#pragma unroll
            for (int rg = 0; rg < 4; ++rg) { const int R = rb * 64 + rt * 16 + fq * 4 + rg, col = ch * 32 + nn * 16 + fr;
                const int b = R / (2 * NC), n = (R >> 1) % NC, g = R & 1;
                obase[((size_t)(b * 2 + g) * NC + n) * 64 + col] = (bf16)f2bf(acc2[nn][rg]); }
    }
    __syncthreads();
}

__device__ __forceinline__ void gmlp_unit(LAS unsigned char* lds, LAS unsigned char* lds_stats, int m0, const bf16* U, const bf16* V, const float* Wm, const float* bias, const float* lng, const float* lnb,
                                          bf16* mix, float* gv_out  , int tid) {
    const int wid = __builtin_amdgcn_readfirstlane(tid >> 6), lane = tid & 63;
    LAS f32x2* stats = (LAS f32x2*)lds_stats;
    for (int i = 0; i < 16; ++i) {
        const int row = wid * 16 + i;
        const v4u w = *(const v4u*)(V + (size_t)(m0 + row) * 512 + lane * 8);
        float x[8] = {bflo(w.x), bfhi(w.x), bflo(w.y), bfhi(w.y), bflo(w.z), bfhi(w.z), bflo(w.w), bfhi(w.w)};
        float s = 0.f;
#pragma unroll
        for (int e = 0; e < 8; ++e) s += x[e];
        const float mean = wave_sum(s) * (1.0f / 512.0f);
        float q = 0.f;
#pragma unroll
        for (int e = 0; e < 8; ++e) { const float d = x[e] - mean; q += d * d; }
        const float var = wave_sum(q) * (1.0f / 512.0f);
        if (lane == 0) stats[row] = (f32x2){mean, 1.0f / sqrtf(var + LN_EPS)};
    }
    __syncthreads();
    const int h = wid, col = h * 64 + lane;
    const float gg = lng[col], bb = lnb[col];
    LAS float* part = (LAS float*)(lds + wid * 16384);
    const float* Wh = Wm + (size_t)h * 128 * 128;
#pragma unroll 1
    for (int half = 0; half < 2; ++half) {
        float vn[64];
#pragma unroll
        for (int s = 0; s < 64; ++s) { const f32x2 st = stats[half * 64 + s]; vn[s] = (bf2f(V[(size_t)(m0 + half * 64 + s) * 512 + col]) - st.x) * st.y * gg + bb; }
        if (gv_out) {
#pragma unroll
            for (int s = 0; s < 64; ++s) gv_out[(size_t)(half * 64 + s) * 512 + col] = vn[s];
        }
        for (int t = half * 64; t < 128; ++t) {
            const float w0 = Wh[t * 128 + half * 64 + lane];
            float acc0 = (half == 0) ? bias[h * 128 + t] : part[(t - 64) * 64 + lane], acc1 = 0.f;
#pragma unroll
            for (int s = 0; s < 64; s += 2) { acc0 += __int_as_float(__builtin_amdgcn_readlane(__float_as_int(w0), s)) * vn[s]; acc1 += __int_as_float(__builtin_amdgcn_readlane(__float_as_int(w0), s + 1)) * vn[s + 1]; }
            const float sres = acc0 + acc1;
            if (half == 0 && t >= 64) part[(t - 64) * 64 + lane] = sres;
            else { const float uu = bf2f(U[(size_t)(m0 + t) * 512 + col]); mix[(size_t)(m0 + t) * DM + 512 + col] = (bf16)f2bf(uu * sres); }
        }
        WAVE_LDS_FENCE();
    }
    __syncthreads();
}

__device__ __forceinline__ void ln_row(const float* src, const float* g, const float* b, float* dstf, bf16* dstb, int lane) {
    pg8::f32x4 v[4]; float s = 0.f;
#pragma unroll
    for (int j = 0; j < 4; ++j) { v[j] = *(const pg8::f32x4*)(src + (j * 64 + lane) * 4); s += (v[j][0] + v[j][1]) + (v[j][2] + v[j][3]); }
    const float mean = wave_sum(s) * (1.0f / DM); float q = 0.f;
#pragma unroll
    for (int j = 0; j < 4; ++j) { v[j] = v[j] - mean; q += (v[j][0] * v[j][0] + v[j][1] * v[j][1]) + (v[j][2] * v[j][2] + v[j][3] * v[j][3]); }
    const float rstd = 1.0f / sqrtf(wave_sum(q) * (1.0f / DM) + LN_EPS);
#pragma unroll
    for (int j = 0; j < 4; ++j) { const int c = (j * 64 + lane) * 4;
        const pg8::f32x4 gg = *(const pg8::f32x4*)(g + c), bb = *(const pg8::f32x4*)(b + c);
        const pg8::f32x4 y = v[j] * rstd * gg + bb;
        *(pg8::f32x4*)(dstf + c) = y;
        if (dstb) { u32x2 w; w.x = pk2(y[0], y[1]); w.y = pk2(y[2], y[3]); *(u32x2*)(dstb + c) = w; } }
}

__device__ __forceinline__ void load8(const bf16* p, float (&k)[8]) { const v4u w = *(const v4u*)p; k[0] = bflo(w.x); k[1] = bfhi(w.x); k[2] = bflo(w.y); k[3] = bfhi(w.y); k[4] = bflo(w.z); k[5] = bfhi(w.z); k[6] = bflo(w.w); k[7] = bfhi(w.w); }
__device__ __forceinline__ void load8(const float* p, float (&k)[8]) { const pg8::f32x4 a = *(const pg8::f32x4*)p, b = *(const pg8::f32x4*)(p + 4); k[0] = a[0]; k[1] = a[1]; k[2] = a[2]; k[3] = a[3]; k[4] = b[0]; k[5] = b[1]; k[6] = b[2]; k[7] = b[3]; }
__device__ __forceinline__ float ldv(const bf16* p) { return bf2f(*p); }
__device__ __forceinline__ float ldv(const float* p) { return *p; }
template <class T> __device__ __forceinline__ void dot4(const T* krow, const LAS float* q, float (&s)[4]) {
    s[0] = s[1] = s[2] = s[3] = 0.f;
#pragma unroll 1
    for (int c = 0; c < 8; ++c) {
        float k[8]; load8(krow + c * 8, k);
#pragma unroll
        for (int r = 0; r < 4; ++r) {
            const pg8::f32x4 qa = *(const LAS pg8::f32x4*)(q + r * 64 + c * 8), qb = *(const LAS pg8::f32x4*)(q + r * 64 + c * 8 + 4);
            s[r] += qa[0] * k[0] + qa[1] * k[1] + qa[2] * k[2] + qa[3] * k[3] + qb[0] * k[4] + qb[1] * k[5] + qb[2] * k[6] + qb[3] * k[7];
        }
    }
}
template <class Src>
__device__ __forceinline__ void attend(const Src& S, int nblk, const LAS float* q, LAS float* pbuf, int lane, float (&o)[4], LAS float* impbuf) {
    typedef typename Src::T T;
    float m[4] = {-1e30f, -1e30f, -1e30f, -1e30f}, l[4] = {0.f, 0.f, 0.f, 0.f};
    for (int i = 0; i < nblk; ++i) {
        const T *kb, *vb; bool ok; S.blk(i, lane, kb, vb, ok);
        if (ok) { float s[4]; dot4(kb + (size_t)lane * Src::STRIDE, q, s);
#pragma unroll
            for (int r = 0; r < 4; ++r) { if (s[r] > m[r]) { l[r] = l[r] * __expf(m[r] - s[r]) + 1.0f; m[r] = s[r]; } else l[r] += __expf(s[r] - m[r]); } }
    }
    float Mx[4], inv[4];
#pragma unroll
    for (int r = 0; r < 4; ++r) { Mx[r] = wave_max(m[r]); const float L = wave_sum(l[r] * __expf(m[r] - Mx[r])); inv[r] = 1.0f / fmaxf(L, 1e-30f); }
    o[0] = o[1] = o[2] = o[3] = 0.f;
    if (!(Mx[0] > -1e29f)) return;
    for (int i = 0; i < nblk; ++i) {
        const T *kb, *vb; bool ok; S.blk(i, lane, kb, vb, ok);
        const unsigned long long mask = __ballot(ok);
        if (mask == 0ull) continue;
        pg8::f32x4 p = {0.f, 0.f, 0.f, 0.f};
        if (ok) { float s[4]; dot4(kb + (size_t)lane * Src::STRIDE, q, s);
#pragma unroll
            for (int r = 0; r < 4; ++r) p[r] = __expf(s[r] - Mx[r]) * inv[r]; }
        *(LAS pg8::f32x4*)(pbuf + lane * 4) = p;
        if (impbuf) { const float im = (p[0] + p[1]) + (p[2] + p[3]); const float pr = im + __shfl_xor(im, 1); if (!(lane & 1)) impbuf[(i * 64 + lane) >> 1] = pr; }
        WAVE_LDS_FENCE();
        for (int kk = 0; kk < 64; ++kk) {
            if ((mask >> kk) & 1ull) { const pg8::f32x4 pv = *(const LAS pg8::f32x4*)(pbuf + kk * 4); const float v = ldv(vb + (size_t)kk * Src::STRIDE + lane);
                o[0] += pv[0] * v; o[1] += pv[1] * v; o[2] += pv[2] * v; o[3] += pv[3] * v; }
        }
        WAVE_LDS_FENCE();
    }
}
__device__ __forceinline__ unsigned long long topk_key(float val, int j) { unsigned u = __float_as_uint(val); u = (u & 0x80000000u) ? ~u : (u | 0x80000000u); return ((unsigned long long)u << 32) | (unsigned)(127 - j); }
__device__ __forceinline__ void topk16(const LAS float* imp, int ns, int cur, LAS int* selidx, int lane) {
    unsigned long long k0 = 0ull, k1 = 0ull;
    { const int j = lane; if (j < ns) { const bool valid = j <= cur, forced = (j == 0) | (j == cur) | (j == cur - 1); k0 = topk_key(valid ? imp[j] + (forced ? 1.0e4f : 0.f) : -1.0f, j); } }
    { const int j = lane + 64; if (j < ns) { const bool valid = j <= cur, forced = (j == 0) | (j == cur) | (j == cur - 1); k1 = topk_key(valid ? imp[j] + (forced ? 1.0e4f : 0.f) : -1.0f, j); } }
    for (int it = 0; it < 16; ++it) {
        unsigned long long k = k0 > k1 ? k0 : k1;
#pragma unroll
        for (int o = 1; o < 64; o <<= 1) { const unsigned lo = __shfl_xor((unsigned)k, o), hi = __shfl_xor((unsigned)(k >> 32), o); const unsigned long long kx = ((unsigned long long)hi << 32) | lo; k = kx > k ? kx : k; }
        const int jb = 127 - (int)(unsigned)(k & 0xffffffffull);
        if (lane == 0) selidx[it] = (k == 0ull || jb > cur) ? -1 : jb;
        if (k0 == k) k0 = 0ull;
        if (k1 == k) k1 = 0ull;
    }
    WAVE_LDS_FENCE();
}
struct SrcPromptCmp { typedef bf16 T; static constexpr int STRIDE = 64; const bf16 *ck, *cv; int nvalid;
    __device__ __forceinline__ void blk(int i, int lane, const bf16*& kb, const bf16*& vb, bool& ok) const { kb = ck + (size_t)i * 64 * 64; vb = cv + (size_t)i * 64 * 64; ok = (i * 64 + lane) < nvalid; } };
struct SrcPromptSlc { typedef bf16 T; static constexpr int STRIDE = 64; const bf16 *K, *V; const LAS int* selidx; int t;
    __device__ __forceinline__ void blk(int i, int lane, const bf16*& kb, const bf16*& vb, bool& ok) const { const int j = selidx[i]; const int jj = j < 0 ? 0 : j; kb = K + (size_t)jj * 64 * 64; vb = V + (size_t)jj * 64 * 64; ok = (j >= 0) && (jj * 64 + lane <= t); } };
struct SrcPromptWin { typedef bf16 T; static constexpr int STRIDE = 64; const bf16 *K, *V; int t, kb0;
    __device__ __forceinline__ void blk(int i, int lane, const bf16*& kb, const bf16*& vb, bool& ok) const { const int j = kb0 + i, pos = j * 64 + lane; kb = K + (size_t)j * 64 * 64; vb = V + (size_t)j * 64 * 64; ok = (pos <= t) && (pos >= t - 511); } };
struct SrcSampleCmp { typedef bf16 T; static constexpr int STRIDE = 64; const bf16 *ck, *cv;
    __device__ __forceinline__ void blk(int i, int lane, const bf16*& kb, const bf16*& vb, bool& ok) const { kb = ck; vb = cv; ok = true; } };
struct SrcSampleSlc { typedef float T; static constexpr int STRIDE = KVW; const float* cache_l; const int* pt; const float* newrows; const LAS int* selidx; int g, s;
    __device__ __forceinline__ void blk(int i, int lane, const float*& kb, const float*& vb, bool& ok) const {
        const int j = selidx[i];
        if (j >= 0 && j < 32) { const int page = pt[j >> 1]; const float* rb = cache_l + ((size_t)page * PAGE + (j & 1) * 64) * KVW; kb = rb + g * 64; vb = rb + 128 + g * 64; ok = true; }
        else { kb = newrows + g * 64; vb = newrows + 128 + g * 64; ok = (j == 32) && (lane <= s); } } };
struct SrcSampleWin { typedef float T; static constexpr int STRIDE = KVW; const float* state; const float* newrows; int g, s;
    __device__ __forceinline__ void blk(int i, int lane, const float*& kb, const float*& vb, bool& ok) const {
        if (i < 8) { const float* rb = state + (size_t)i * 64 * KVW; kb = rb + g * 64; vb = rb + 128 + g * 64; ok = (i * 64 + lane) >= s + 1; }
        else { kb = newrows + g * 64; vb = newrows + 128 + g * 64; ok = lane <= s; } } };
struct Args { const float* in[23]; float* out; unsigned char* ws; int ph_lo, ph_hi, use_bar, pad; };

static_assert(sizeof(Args) == 216, "Args layout");
template <int OFF> __device__ __forceinline__ unsigned long long karg64() {
    unsigned long long v; const unsigned long long kp = (unsigned long long)__builtin_amdgcn_kernarg_segment_ptr();
    asm volatile("s_load_dwordx2 %0, %1, %2\n\ts_waitcnt lgkmcnt(0)" : "=s"(v) : "s"(kp), "n"(OFF) : "memory");
    return v;
}
#define KIN(k) ((const float*)karg64<8 * (k)>())
#define KOUT() ((float*)karg64<184>())
#define KWS() ((unsigned char*)karg64<192>())

__global__ void __launch_bounds__(NWAVES * 64, 2) fwd(Args args) {
    extern __shared__ __attribute__((aligned(16))) unsigned char lds_raw[];
    LAS unsigned char* lds = (LAS unsigned char*)lds_raw;
    volatile LAS unsigned* MISC = (volatile LAS unsigned*)(lds + MISC_OFF);
    const int tid = threadIdx.x, lane = tid & 63, wave = __builtin_amdgcn_readfirstlane(tid >> 6);
    const int G = gridDim.x, bid = blockIdx.x;
    const int gw = bid * NWAVES + wave, NGW = G * NWAVES, gt = bid * (NWAVES * 64) + tid, NGT = G * NWAVES * 64;

    for (int u = tid; u < (LDS_BYTES - LDSCTL_OFF) / 4; u += NWAVES * 64) ((LAS unsigned*)(lds + LDSCTL_OFF))[u] = 0u;
    __syncthreads();
    const int use_bar = args.use_bar;
    XcdBarrier bar; bar.bar = (unsigned*)(KWS() + WS_CTL) + CW_BAR; bar.x = 0; bar.st = nullptr;
    if (use_bar) bar = xcd_barrier_post((unsigned*)(KWS() + WS_CTL) + CW_BAR, MISC + 8);
    const int lo = args.ph_lo, hi = args.ph_hi;
#ifndef PH_ENABLE
#define PH_ENABLE 0xFFFFFFFFu
#endif
#define PHBIT(k) (((k) < PH_L0) ? (k) : (PH_L0 + ((k) - PH_L0) % PH_PER_LAYER))
#define IN(k) (((PH_ENABLE >> PHBIT(k)) & 1u) && lo <= (k) && (k) < hi)
#define SEAM(k) do { if (use_bar && (k) + 1 < hi) xcd_barrier(bar); } while (0)

    if (IN(PH_P0A)) {
        unsigned char* ws = KWS(); float* out = KOUT();
        LAS float* scr = (LAS float*)(lds + RING_OFF + wave * 16384);
        constexpr int I_IN = 16 * 73, I_OUT = 16 * 32, I_G = 16 * 88, I_D = 44 * 32, I_W1 = 32 * 8, I_W2 = 4 * 2;
        constexpr int I_LAYER = I_IN + I_OUT + 2 * I_G + I_D + 2 * I_W1 + 2 * I_W2;
        for (int it = gw; it < NLAYER * I_LAYER; it += NGW) {
            const int L = it / I_LAYER; int r = it % I_LAYER;
            if (r < I_IN) { transpose_item(KIN(6) + (size_t)L * DM * PIN, DM, PIN, (bf16*)(ws + WS_WIN_T) + (size_t)L * NIN * DM, RmInProj{}, scr, r, lane); continue; } r -= I_IN;
            if (r < I_OUT) { transpose_item(KIN(15) + (size_t)L * DM * DM, DM, DM, (bf16*)(ws + WS_WOUT_T) + (size_t)L * DM * DM, RmIdent{}, scr, r, lane); continue; } r -= I_OUT;
            if (r < I_G) { transpose_item(KIN(18) + (size_t)L * DM * FFN, DM, FFN, (bf16*)(ws + WS_WGU_T) + (size_t)L * NGU * DM, RmAffine{2, 0}, scr, r, lane); continue; } r -= I_G;
            if (r < I_G) { transpose_item(KIN(19) + (size_t)L * DM * FFN, DM, FFN, (bf16*)(ws + WS_WGU_T) + (size_t)L * NGU * DM, RmAffine{2, 1}, scr, r, lane); continue; } r -= I_G;
            if (r < I_D) { transpose_item(KIN(20) + (size_t)L * FFN * DM, FFN, DM, (bf16*)(ws + WS_WDN_T) + (size_t)L * DM * FFN, RmIdent{}, scr, r, lane); continue; } r -= I_D;
            if (r < 2 * I_W1) { const int kind = r / I_W1; transpose_item(KIN(8) + (size_t)(L * 2 + kind) * 2048 * 256, 2048, 256, (bf16*)(ws + WS_W1C_T) + (size_t)(L * 2 + kind) * 256 * 2048, RmIdent{}, scr, r % I_W1, lane); continue; } r -= 2 * I_W1;
            { const int kind = r / I_W2; transpose_item(KIN(10) + (size_t)(L * 2 + kind) * 256 * 64, 256, 64, (bf16*)(ws + WS_W2C_T) + (size_t)(L * 2 + kind) * 64 * 256, RmIdent{}, scr, r % I_W2, lane); }
        }
        for (int i = gt; i < NLAYER * (NIN - PIN) * (DM / 8); i += NGT) { const int L = i / ((NIN - PIN) * (DM / 8)), r = i % ((NIN - PIN) * (DM / 8));
            *(v4u*)((bf16*)(ws + WS_WIN_T) + (size_t)L * NIN * DM + (size_t)PIN * DM + (size_t)r * 8) = (v4u){0u, 0u, 0u, 0u}; }
        for (int i = gt; i < TP * 32; i += NGT) {
            const int pos = i >> 5, d = i & 31;
            double fr_ = 1.0; for (int k = 0; k < d; ++k) fr_ *= 0.7498942093324558;
            const float angf = (float)pos * (float)fr_;
            const double a = (double)angf;
            const double kq = __builtin_rint(a * 0.63661977236758134308);
            double rr = __builtin_fma(-kq, 1.57079632673412561417e+00, a); rr = __builtin_fma(-kq, 6.07710050650619224932e-11, rr);
            const double r2 = rr * rr;
            double sp = -7.6471637318198164759e-13; sp = sp * r2 + 1.6059043836821614599e-10; sp = sp * r2 - 2.5052108385441718775e-08; sp = sp * r2 + 2.7557319223985890653e-06;
            sp = sp * r2 - 1.9841269841269841270e-04; sp = sp * r2 + 8.3333333333333333333e-03; sp = sp * r2 - 1.6666666666666666667e-01; const double sn = rr + rr * r2 * sp;
            double cp = 4.7794773323873852974e-14; cp = cp * r2 - 1.1470745597729724714e-11; cp = cp * r2 + 2.0876756987868098979e-09; cp = cp * r2 - 2.7557319223985890653e-07;
            cp = cp * r2 + 2.4801587301587301587e-05; cp = cp * r2 - 1.3888888888888888889e-03; cp = cp * r2 + 4.1666666666666666667e-02; cp = cp * r2 - 0.5; const double cn = 1.0 + r2 * cp;
            const int q4 = ((int)kq) & 3;
            const double c = (q4 == 0) ? cn : (q4 == 1) ? -sn : (q4 == 2) ? -cn : sn;
            const double s = (q4 == 0) ? sn : (q4 == 1) ? cn : (q4 == 2) ? -sn : -cn;
            ((f32x2*)(ws + WS_ROPE))[i] = (f32x2){(float)c, (float)s};
        }
        { const float* xp = KIN(0); const float* xs = KIN(1); float* XF = (float*)(ws + WS_XF); bf16* XB = (bf16*)(ws + WS_XB);
        for (int row = gw; row < MT; row += NGW) {
            const float* src = row < MP ? xp + (size_t)row * DM : xs + (size_t)(row - MP) * DM;
#pragma unroll
            for (int j = 0; j < 4; ++j) { const int c = (j * 64 + lane) * 4; const pg8::f32x4 v = *(const pg8::f32x4*)(src + c);
                *(pg8::f32x4*)(XF + (size_t)row * DM + c) = v; u32x2 w; w.x = pk2(v[0], v[1]); w.y = pk2(v[2], v[3]); *(u32x2*)(XB + (size_t)row * DM + c) = w; }
        } }
        { const float* gws = KIN(13); const float* gbs = KIN(14); float* GWP = (float*)(ws + WS_GWP); float* GWS = (float*)(ws + WS_GWS); float* GBS = (float*)(ws + WS_GBS);
        for (int i = gt; i < NLAYER * 8 * 128 * 128; i += NGT) {
            const int lh = i >> 14, t = (i >> 7) & 127, s = i & 127;
            const float* wsrc = gws + (size_t)lh * 16384;
            GWP[i] = (s <= t) ? wsrc[t * 128 + s] : 0.f;
            GWS[i] = ((t >> 2) == (s >> 2) && (s & 3) <= (t & 3)) ? wsrc[(t & 3) * 128 + (s & 3)] : 0.f;
        }
        for (int i = gt; i < NLAYER * 8 * 128; i += NGT) GBS[i] = gbs[(i & ~127) + (i & 3)]; }
        { const float* st = KIN(4);
        for (int i = gt; i < NLAYER * NB_S * 508 * 64; i += NGT) { const int lb = i / (508 * 64), r = i % (508 * 64);
            *(pg8::f32x4*)(out + O_WINS + (size_t)lb * 512 * KVW + (size_t)r * 4) = *(const pg8::f32x4*)(st + (size_t)lb * 512 * KVW + 4 * KVW + (size_t)r * 4); } }
        SEAM(PH_P0A);
    }
    if (IN(PH_P0B)) {
        unsigned char* ws = KWS();
        const int* PT = (const int*)KIN(5); const float* cache = KIN(2); const float* pe = KIN(7); const float* b1 = KIN(9);
        for (int u = bid; u < NLAYER * 2 * 256; u += G) {
            const int L = u >> 9, kind = (u >> 8) & 1, rb = u & 255;
            const int R = rb * 64 + (tid >> 3), bs = R >> 7, n = (R >> 1) & 63, g = R & 1;
            const int page = PT[bs * NPG + (n >> 2)];
            const float* arow = cache + ((size_t)L * NPOOL + page) * PAGE * KVW + (size_t)((n & 3) * 32) * KVW + kind * 128 + g * 64 + (tid & 7) * 8;
            compress_unit(lds + RING_OFF, arow, pe + (size_t)(L * 2 + kind) * 2048, (const bf16*)(ws + WS_W1C_T) + (size_t)(L * 2 + kind) * 256 * 2048, b1 + (L * 2 + kind) * 256,
                          (const bf16*)(ws + WS_W2C_T) + (size_t)(L * 2 + kind) * 64 * 256, (bf16*)(ws + (kind ? WS_CVS : WS_CKS)) + (size_t)L * NB_S * 2 * 64 * 64, 64, rb, tid);
        }
        SEAM(PH_P0B);
    }
    for (int L = 0; L < NLAYER; ++L) {
        const int pb = PH_L0 + L * PH_PER_LAYER;
        if (IN(pb + 0)) {
            unsigned char* ws = KWS();
            pg8::Gemm g{(const bf16*)(ws + WS_XB), (const bf16*)(ws + WS_WIN_T) + (size_t)L * NIN * DM, MT, NIN, DM}; pg8::StaticOrder S; S.init(MT, NIN, G, bid);
            EpiInProj E{L, ws, KOUT()};
            pg8::gemm_phase<EpiInProj, pg8::StaticOrder, true, true>(lds + RING_OFF, g, S, E);
            SEAM(pb + 0);
        }
        if (IN(pb + 1)) {
            unsigned char* ws = KWS(); float* out = KOUT();
            int tid = threadIdx.x; asm volatile("" : "+v"(tid));
            for (int u = bid; u < 32 + 132; u += G) {
                if (u < 32) {
                    const int kind = u >> 4, rb = u & 15;
                    const int R = rb * 64 + (tid >> 3), b = R >> 9, n = (R >> 1) & 255, g = R & 1;
                    const float* arow = out + O_CMPP + ((size_t)(L * BP + b) * TP + 32 * n) * KVW + kind * 128 + g * 64 + (tid & 7) * 8;
                    compress_unit(lds + RING_OFF, arow, KIN(7) + (size_t)(L * 2 + kind) * 2048, (const bf16*)(ws + WS_W1C_T) + (size_t)(L * 2 + kind) * 256 * 2048, KIN(9) + (L * 2 + kind) * 256,
                                  (const bf16*)(ws + WS_W2C_T) + (size_t)(L * 2 + kind) * 64 * 256, (bf16*)(ws + (kind ? WS_CVP : WS_CKP)), 256, rb, tid);
                } else {
                    const int q = u - 32;
                    if (q < 128) gmlp_unit(lds + RING_OFF, lds + LDSCTL_OFF + 1024, 128 * q, (const bf16*)(ws + WS_U), (const bf16*)(ws + WS_V), (const float*)(ws + WS_GWP) + (size_t)L * 8 * 16384, KIN(14) + L * 1024,
                                           KIN(11) + L * 512, KIN(12) + L * 512, (bf16*)(ws + WS_MIX), (float*)nullptr, tid);
                    else gmlp_unit(lds + RING_OFF, lds + LDSCTL_OFF + 1024, MP + 128 * (q - 128), (const bf16*)(ws + WS_U), (const bf16*)(ws + WS_V), (const float*)(ws + WS_GWS) + (size_t)L * 8 * 16384, (const float*)(ws + WS_GBS) + L * 1024,
                                   KIN(11) + L * 512, KIN(12) + L * 512, (bf16*)(ws + WS_MIX), out + O_GV + ((size_t)L * MS + 128 * (q - 128)) * 512, tid);
                }
            }
            SEAM(pb + 1);
        }
        if (IN(pb + 2)) {
            unsigned char* ws = KWS(); float* out = KOUT();
            int lane = threadIdx.x & 63; asm volatile("" : "+v"(lane));
            const bf16* QRAW = (const bf16*)(ws + WS_QRAW); const bf16* QROT = (const bf16*)(ws + WS_QROT); bf16* MIX = (bf16*)(ws + WS_MIX); const float* GATES = (const float*)(ws + WS_GATES);
            LAS float* wl = (LAS float*)(lds + RING_OFF + wave * 4096);
            LAS float* qraw_l = wl; LAS float* qrot_l = wl + 256; LAS float* pbuf = wl + 512; LAS float* impb = wl + 768; LAS int* selidx = (LAS int*)(wl + 896);
            for (int task = gw; task < 2 * MT; task += NGW) {
                const int m = task >> 1, g = task & 1;
                const bool prompt = m < MP;
#pragma unroll
                for (int r = 0; r < 4; ++r) { qraw_l[r * 64 + lane] = 0.125f * bf2f(QRAW[(size_t)m * 512 + (g * 4 + r) * 64 + lane]); qrot_l[r * 64 + lane] = 0.125f * bf2f(QROT[(size_t)m * 512 + (g * 4 + r) * 64 + lane]); }
                impb[lane] = 0.f; impb[64 + lane] = 0.f;
                WAVE_LDS_FENCE();
                float oc[4], os[4], ow[4];
                if (prompt) {
                    const int b = m >> 13, t = m & (TP - 1); const size_t bg = (size_t)(b * 2 + g);
                    const SrcPromptCmp sc{(const bf16*)(ws + WS_CKP) + bg * 256 * 64, (const bf16*)(ws + WS_CVP) + bg * 256 * 64, (t + 1) >> 5};
                    attend(sc, (sc.nvalid + 63) >> 6, qraw_l, pbuf, lane, oc, impb);
                    WAVE_LDS_FENCE();
                    topk16(impb, 128, t >> 6, selidx, lane);
                    const SrcPromptSlc ss{(const bf16*)(ws + WS_KS) + bg * TP * 64, (const bf16*)(ws + WS_VS) + bg * TP * 64, selidx, t};
                    attend(ss, 16, qrot_l, pbuf, lane, os, (LAS float*)nullptr);
                    const int kb0 = (t > 511 ? t - 511 : 0) >> 6;
                    const SrcPromptWin sw{(const bf16*)(ws + WS_KW) + bg * TP * 64, (const bf16*)(ws + WS_VW) + bg * TP * 64, t, kb0};
                    attend(sw, (t >> 6) - kb0 + 1, qrot_l, pbuf, lane, ow, (LAS float*)nullptr);
                } else {
                    const int si = m - MP, bs = si >> 2, s = si & 3;
                    const size_t co = (((size_t)L * NB_S + bs) * 2 + g) * 64 * 64;
                    const SrcSampleCmp sc{(const bf16*)(ws + WS_CKS) + co, (const bf16*)(ws + WS_CVS) + co};
                    attend(sc, 1, qraw_l, pbuf, lane, oc, impb);
                    WAVE_LDS_FENCE();
                    topk16(impb, 33, 32, selidx, lane);
                    const SrcSampleSlc ss{KIN(3) + (size_t)L * NPOOL * PAGE * KVW, (const int*)KIN(5) + bs * NPG, out + O_SLCS + ((size_t)L * MS + bs * 4) * KVW, selidx, g, s};
                    attend(ss, 16, qrot_l, pbuf, lane, os, (LAS float*)nullptr);
                    const SrcSampleWin sw{KIN(4) + ((size_t)L * NB_S + bs) * 512 * KVW, out + O_WINS + (((size_t)L * NB_S + bs) * 512 + 508) * KVW, g, s};
                    attend(sw, 9, qrot_l, pbuf, lane, ow, (LAS float*)nullptr);
                }
                const float* gtp = GATES + (size_t)m * 24;
#pragma unroll
                for (int r = 0; r < 4; ++r) { const int h = g * 4 + r; const float o = gtp[h] * oc[r] + gtp[8 + h] * os[r] + gtp[16 + h] * ow[r];
                    MIX[(size_t)m * DM + h * 64 + lane] = (bf16)f2bf(o); }
                WAVE_LDS_FENCE();
            }
            SEAM(pb + 2);
        }
        if (IN(pb + 3)) {
            unsigned char* ws = KWS();
            pg8::Gemm g{(const bf16*)(ws + WS_MIX), (const bf16*)(ws + WS_WOUT_T) + (size_t)L * DM * DM, MT, DM, DM}; pg8::StaticOrder S; S.init(MT, DM, G, bid);
            EpiResid E{(const float*)(ws + WS_XF), (float*)(ws + WS_PRE)};
            pg8::gemm_phase<EpiResid, pg8::StaticOrder, true, true>(lds + RING_OFF, g, S, E);
            SEAM(pb + 3);
        }
        if (IN(pb + 4)) {
            int lane = threadIdx.x & 63; asm volatile("" : "+v"(lane));
            unsigned char* ws = KWS(); const float* lg = KIN(16) + L * DM; const float* lb = KIN(17) + L * DM;
            for (int row = gw; row < MT; row += NGW) ln_row((const float*)(ws + WS_PRE) + (size_t)row * DM, lg, lb, (float*)(ws + WS_XF) + (size_t)row * DM, (bf16*)(ws + WS_XB) + (size_t)row * DM, lane);
            SEAM(pb + 4);
        }
        if (IN(pb + 5)) {
            unsigned char* ws = KWS();
            pg8::Gemm g{(const bf16*)(ws + WS_XB), (const bf16*)(ws + WS_WGU_T) + (size_t)L * NGU * DM, MT, NGU, DM}; pg8::StaticOrder S; S.init(MT, NGU, G, bid);
            EpiGateUp E{(bf16*)(ws + WS_F)};
            pg8::gemm_phase<EpiGateUp, pg8::StaticOrder, true, true>(lds + RING_OFF, g, S, E);
            SEAM(pb + 5);
        }
        if (IN(pb + 6)) {
            unsigned char* ws = KWS();
            pg8::Gemm g{(const bf16*)(ws + WS_F), (const bf16*)(ws + WS_WDN_T) + (size_t)L * DM * FFN, MT, DM, FFN}; pg8::StaticOrder S; S.init(MT, DM, G, bid);
            EpiResid E{(const float*)(ws + WS_XF), (float*)(ws + WS_PRE)};
            pg8::gemm_phase<EpiResid, pg8::StaticOrder, true, true>(lds + RING_OFF, g, S, E);
            SEAM(pb + 6);
        }
        if (IN(pb + 7)) {
            int lane = threadIdx.x & 63; asm volatile("" : "+v"(lane));
            unsigned char* ws = KWS(); const float* lg = KIN(21) + L * DM; const float* lb = KIN(22) + L * DM;
            const bool last = (L == NLAYER - 1);
            float* dstf = last ? KOUT() + O_Y : (float*)(ws + WS_XF);
            for (int row = gw; row < MT; row += NGW) ln_row((const float*)(ws + WS_PRE) + (size_t)row * DM, lg, lb, dstf + (size_t)row * DM, last ? (bf16*)nullptr : (bf16*)(ws + WS_XB) + (size_t)row * DM, lane);
            SEAM(pb + 7);
        }
    }
#undef IN
#undef SEAM
}

#ifndef SPLIT_LAUNCHES
#define SPLIT_LAUNCHES 0
#endif
extern "C" void kernel_launch(void* const* d_in, const int* in_sizes, int n_in, void* d_out, int out_size, void* d_ws, size_t ws_size, hipStream_t stream) {
    static int grid = 0;
    if (grid == 0) {
        if (n_in != 23 || (size_t)out_size != O_END || ws_size < WS_END) { fprintf(stderr, "kernel_launch: unexpected sizes (n_in %d, out %d, ws %zu); nothing launched\n", n_in, out_size, ws_size); grid = -1; return; }
        int dev = 0, cus = 0, per_cu = 0;
        if (hipGetDevice(&dev) != hipSuccess || hipDeviceGetAttribute(&cus, hipDeviceAttributeMultiprocessorCount, dev) != hipSuccess) { fprintf(stderr, "kernel_launch: device query failed\n"); grid = -1; return; }
        if (hipFuncSetAttribute((const void*)fwd, hipFuncAttributeMaxDynamicSharedMemorySize, LDS_BYTES) != hipSuccess) { fprintf(stderr, "kernel_launch: hipFuncSetAttribute failed\n"); grid = -1; return; }
        if (hipOccupancyMaxActiveBlocksPerMultiprocessor(&per_cu, (const void*)fwd, NWAVES * 64, LDS_BYTES) != hipSuccess || per_cu < 1) fprintf(stderr, "kernel_launch: note: occupancy query reports %d\n", per_cu);
        (void)hipGetLastError();
        grid = cus;
    }
    if (grid < 0) return;
    if (hipMemsetAsync((char*)d_ws + WS_CTL, 0, CTL_ZERO_BYTES, stream) != hipSuccess) { fprintf(stderr, "kernel_launch: memset failed\n"); return; }
    Args a{};
    for (int i = 0; i < 23; ++i) a.in[i] = (const float*)d_in[i];
    a.out = (float*)d_out; a.ws = (unsigned char*)d_ws;
#if SPLIT_LAUNCHES
    for (int ph = 0; ph < N_PHASES; ++ph) { a.ph_lo = ph; a.ph_hi = ph + 1; a.use_bar = 0; a.pad = 0;
        hipLaunchKernelGGL(fwd, dim3(grid), dim3(NWAVES * 64), LDS_BYTES, stream, a); }
#else
    a.ph_lo = 0; a.ph_hi = N_PHASES; a.use_bar = 1; a.pad = 0;
    hipLaunchKernelGGL(fwd, dim3(grid), dim3(NWAVES * 64), LDS_BYTES, stream, a);
#endif
    const hipError_t le = hipPeekAtLastError();
    if (le != hipSuccess) fprintf(stderr, "kernel_launch: launch failed: %s\n", hipGetErrorName(le));
}
```

```cpp
#include <hip/hip_runtime.h>
#include <cstdio>
#include <cstdint>
#include <cmath>
namespace pg8 {
#define PG8_LAS __attribute__((address_space(3)))
typedef unsigned short bf16_t;
typedef short bf16x8 __attribute__((ext_vector_type(8)));
typedef float f32x4 __attribute__((ext_vector_type(4)));
typedef unsigned u32x4 __attribute__((ext_vector_type(4)));
constexpr int BM = 256, BK = 64, HALF = 128, HTB = HALF * BK * 2  , STAGE_BYTES = 8 * HTB, NXCD = 8, WGM = 8;

__host__ __device__ __forceinline__ int lds_byte(int r, int c) { const int st = (r >> 4) * 2 + (c >> 5), rr = r & 15, cc = c & 31, ob = rr * 64 + cc * 2; return st * 1024 + (ob ^ (((ob >> 9) & 1) << 5)); }
__host__ __device__ __forceinline__ void stage_rc(int b, int& R, int& C) { const int st = b / 1024, sb = b % 1024, swz = sb ^ (((sb >> 9) & 1) << 5); R = (st >> 1) * 16 + swz / 64; C = (st & 1) * 32 + (swz % 64) / 2; }
__host__ __device__ __forceinline__ int perm32(int rho) { const int n = rho >> 4, i = rho & 15; return 8 * (i >> 2) + 4 * n + (i & 3); }

struct Unit { int pm, pn; };
struct Gemm { const bf16_t* A; const bf16_t* Bt; int M, N, K; };

struct StaticOrder {
    int nM, nN, nwg, G, c;
    __host__ __device__ void init(int M, int N, int G_, int c_) { nM = M / BM; nN = N / BM; nwg = nM * nN; G = G_; c = c_; }
    __host__ __device__ bool next(int i, Unit& u) const {
        const long L = (long)i * G + c; if (L >= nwg) return false;
        int wgid = (int)L; { const int q = nwg / NXCD, r = nwg % NXCD, xcd = wgid % NXCD, off = wgid / NXCD; wgid = (xcd < r ? xcd * (q + 1) : r * (q + 1) + (xcd - r) * q) + off; }
        const int nig = WGM * nN, gid = wgid / nig, fm = gid * WGM, gsz = (nM - fm) < WGM ? (nM - fm) : WGM;
        u.pm = fm + ((wgid % nig) % gsz); u.pn = (wgid % nig) / gsz; return true;
    }
    __device__ __forceinline__ void a_ready(const Unit&) const {}
    __device__ __forceinline__ void done(const Unit&) const {}
};
__device__ __forceinline__ unsigned cvt_pk_bf16(float lo, float hi) { unsigned r; asm volatile("v_cvt_pk_bf16_f32 %0, %1, %2" : "=v"(r) : "v"(lo), "v"(hi)); return r; }
typedef float f32x2 __attribute__((ext_vector_type(2)));
template <class Epi, class Sched, bool ALIGN_EPI = false, bool SP2 = false>
__device__ __forceinline__ void gemm_phase(PG8_LAS unsigned char* lds, const Gemm g, const Sched& S, const Epi& E, int tid_in) {
    int tid_ = tid_in; asm volatile("" : "+v"(tid_));
    const int tid = tid_, wid = __builtin_amdgcn_readfirstlane(tid >> 6), lane = tid & 63, wr = wid >> 2, wc = wid & 3, fr = lane & 15, fq = lane >> 4;
    const int K = g.K, nt = K / BK;
    unsigned voffA[2], voffB[2];
#pragma unroll
    for (int i = 0; i < 2; ++i) { int R, C; stage_rc(tid * 16 + i * 8192, R, C); const int Rb = Epi::PERM ? ((R & ~31) + perm32(R & 31)) : R;
        voffA[i] = (unsigned)(R * K + C) * 2u; voffB[i] = (unsigned)(Rb * K + C) * 2u; }
    const size_t kstep = (size_t)(BK * 2);
    const size_t hstep = (size_t)HALF * K * 2;
    const size_t tstep = 2 * hstep;
    const unsigned ldsw = (unsigned)wid * 1024u;
    const int aoff = lds_byte(wr * 64 + fr, fq * 8), boff = lds_byte(wc * 32 + fr, fq * 8);
#define PG8_SA(b, h) (((b) * 2 + (h)) * HTB)
#define PG8_SB(b, h) ((4 + (b) * 2 + (h)) * HTB)
#define PG8_STAGE(bufoff, gbase, voff) do { _Pragma("unroll") for (int _i = 0; _i < 2; ++_i) \
        __builtin_amdgcn_global_load_lds((const unsigned*)((const char*)(gbase) + (voff)[_i]), (PG8_LAS unsigned*)(lds + (bufoff) + ldsw + _i * 8192), 16, 0, 0); } while (0)
#define PG8_LDA(dst, b, h) do { _Pragma("unroll") for (int m = 0; m < 4; ++m) _Pragma("unroll") for (int k = 0; k < 2; ++k) dst[m][k] = *(const PG8_LAS bf16x8*)(lds + PG8_SA(b, h) + aoff + m * 2048 + k * 1024); } while (0)
#define PG8_LDB(dst, b, h) do { _Pragma("unroll") for (int n = 0; n < 2; ++n) _Pragma("unroll") for (int k = 0; k < 2; ++k) dst[n][k] = *(const PG8_LAS bf16x8*)(lds + PG8_SB(b, h) + boff + n * 2048 + k * 1024); } while (0)
#define PG8_MMA(ai, bj, At, Bt) do { __builtin_amdgcn_s_setprio(1); _Pragma("unroll") for (int m = 0; m < 4; ++m) _Pragma("unroll") for (int n = 0; n < 2; ++n) _Pragma("unroll") for (int k = 0; k < 2; ++k) \
        acc[ai][bj][m][n] = __builtin_amdgcn_mfma_f32_16x16x32_bf16(Bt[n][k], At[m][k], acc[ai][bj][m][n], 0, 0, 0); __builtin_amdgcn_s_setprio(0); } while (0)
#define PG8_WAIT_V(n) asm volatile("s_waitcnt vmcnt(" #n ")" ::: "memory")
#define PG8_WAIT_L(n) asm volatile("s_waitcnt lgkmcnt(" #n ")" ::: "memory")
#define PG8_BAR __builtin_amdgcn_s_barrier()
#define PG8_SCHED __builtin_amdgcn_sched_barrier(0)
    Unit cur, nxt; int ui = 0;
    if (!S.next(0, cur)) return;
    f32x4 acc[2][2][4][2];
#pragma unroll
    for (int a = 0; a < 2; ++a)
#pragma unroll
        for (int b = 0; b < 2; ++b)
#pragma unroll
            for (int m = 0; m < 4; ++m)
#pragma unroll
                for (int n = 0; n < 2; ++n) acc[a][b][m][n] = (f32x4){0.f, 0.f, 0.f, 0.f};
    bf16x8 At[4][2], B0[2][2], B1[2][2];
    const char* cA = (const char*)g.A + (size_t)cur.pm * tstep; const char* cB = (const char*)g.Bt + (size_t)cur.pn * tstep;
    S.a_ready(cur);
    if constexpr (SP2) {
        PG8_STAGE(PG8_SB(0, 0), cB, voffB); PG8_STAGE(PG8_SB(0, 1), cB + hstep, voffB); PG8_STAGE(PG8_SA(0, 0), cA, voffA); PG8_STAGE(PG8_SA(0, 1), cA + hstep, voffA);
        if (wr == 1) PG8_BAR;
        PG8_WAIT_V(2); PG8_BAR;
        PG8_STAGE(PG8_SB(1, 0), cB + kstep, voffB); PG8_STAGE(PG8_SA(1, 0), cA + kstep, voffA); PG8_STAGE(PG8_SB(1, 1), cB + hstep + kstep, voffB);
        PG8_WAIT_V(6); PG8_BAR;
    } else {
        PG8_STAGE(PG8_SB(0, 0), cB, voffB); PG8_STAGE(PG8_SA(0, 0), cA, voffA); PG8_STAGE(PG8_SB(0, 1), cB + hstep, voffB); PG8_STAGE(PG8_SA(0, 1), cA + hstep, voffA);
        if (wr == 1) PG8_BAR;
        PG8_WAIT_V(4); PG8_BAR;
        PG8_STAGE(PG8_SB(1, 0), cB + kstep, voffB); PG8_STAGE(PG8_SA(1, 0), cA + kstep, voffA); PG8_STAGE(PG8_SB(1, 1), cB + hstep + kstep, voffB);
        PG8_WAIT_V(6); PG8_BAR;
    }
    for (;;) {
        const bool has_next = S.next(ui + 1, nxt);
        const char* nA = has_next ? (const char*)g.A + (size_t)nxt.pm * tstep : cA; const char* nB = has_next ? (const char*)g.Bt + (size_t)nxt.pn * tstep : cB;
        for (int t = 0; t < nt; t += 2) {
            const bool last = (t == nt - 2);
            const char* a1 = cA + (size_t)(t + 1) * kstep;
            const char* a2 = last ? nA : cA + (size_t)(t + 2) * kstep; const char* b2 = last ? nB : cB + (size_t)(t + 2) * kstep;
            const char* a3 = a2 + kstep; const char* b3 = b2 + kstep;
            if (last && has_next) S.a_ready(nxt);
            if constexpr (SP2) {
            PG8_LDB(B0, 0, 0); PG8_LDB(B1, 0, 1); PG8_SCHED; PG8_LDA(At, 0, 0); PG8_STAGE(PG8_SA(1, 1), a1 + hstep, voffA);
            PG8_WAIT_V(8); PG8_WAIT_L(0); PG8_BAR; PG8_MMA(0, 0, At, B0); PG8_MMA(0, 1, At, B1); PG8_BAR; PG8_SCHED;
            PG8_LDA(At, 0, 1); PG8_STAGE(PG8_SB(0, 0), b2, voffB); PG8_STAGE(PG8_SB(0, 1), b2 + hstep, voffB); PG8_STAGE(PG8_SA(0, 0), a2, voffA);
            PG8_WAIT_V(8); PG8_WAIT_L(0); PG8_BAR; PG8_MMA(1, 0, At, B0); PG8_MMA(1, 1, At, B1); PG8_BAR; PG8_SCHED;
            PG8_LDB(B0, 1, 0); PG8_LDB(B1, 1, 1); PG8_SCHED; PG8_LDA(At, 1, 0); PG8_STAGE(PG8_SA(0, 1), a2 + hstep, voffA);
            PG8_WAIT_V(8); PG8_WAIT_L(0); PG8_BAR; PG8_MMA(0, 0, At, B0); PG8_MMA(0, 1, At, B1); PG8_BAR; PG8_SCHED;
            PG8_LDA(At, 1, 1); PG8_STAGE(PG8_SB(1, 0), b3, voffB); PG8_STAGE(PG8_SB(1, 1), b3 + hstep, voffB); PG8_STAGE(PG8_SA(1, 0), a3, voffA);
            PG8_WAIT_V(8); PG8_WAIT_L(0); PG8_BAR; PG8_MMA(1, 0, At, B0); PG8_MMA(1, 1, At, B1); PG8_BAR; PG8_SCHED;
            } else {
            PG8_LDB(B0, 0, 0); PG8_SCHED; PG8_LDA(At, 0, 0); PG8_STAGE(PG8_SA(1, 1), a1 + hstep, voffA);
            PG8_WAIT_L(8); PG8_BAR; PG8_WAIT_L(0); PG8_MMA(0, 0, At, B0); PG8_BAR; PG8_SCHED;
            PG8_LDB(B1, 0, 1); PG8_STAGE(PG8_SB(0, 0), b2, voffB);
            PG8_BAR; PG8_WAIT_L(0); PG8_MMA(0, 1, At, B1); PG8_BAR;
            PG8_LDA(At, 0, 1); PG8_STAGE(PG8_SA(0, 0), a2, voffA);
            PG8_BAR; PG8_WAIT_L(0); PG8_MMA(1, 0, At, B0); PG8_BAR; PG8_SCHED;
            PG8_STAGE(PG8_SB(0, 1), b2 + hstep, voffB);
            PG8_WAIT_V(6); PG8_BAR; PG8_MMA(1, 1, At, B1); PG8_BAR;
            PG8_LDB(B0, 1, 0); PG8_SCHED; PG8_LDA(At, 1, 0); PG8_STAGE(PG8_SA(0, 1), a2 + hstep, voffA);
            PG8_WAIT_L(8); PG8_BAR; PG8_WAIT_L(0); PG8_MMA(0, 0, At, B0); PG8_BAR; PG8_SCHED;
            PG8_LDB(B1, 1, 1); PG8_STAGE(PG8_SB(1, 0), b3, voffB);
            PG8_BAR; PG8_WAIT_L(0); PG8_MMA(0, 1, At, B1); PG8_BAR;
            PG8_LDA(At, 1, 1); PG8_STAGE(PG8_SA(1, 0), a3, voffA);
            PG8_BAR; PG8_WAIT_L(0); PG8_MMA(1, 0, At, B0); PG8_BAR; PG8_SCHED;
            PG8_STAGE(PG8_SB(1, 1), b3 + hstep, voffB);
            PG8_WAIT_V(6); PG8_BAR; PG8_MMA(1, 1, At, B1); PG8_BAR;
            }
        }
        if constexpr (ALIGN_EPI) { if (wr == 0) PG8_BAR; }
        if constexpr (!Epi::AFTER_DRAIN) { E(acc, cur, wr, wc, fr, fq); S.done(cur); }
        if (!has_next) break;
#pragma unroll
        for (int a = 0; a < 2; ++a)
#pragma unroll
            for (int b = 0; b < 2; ++b)
#pragma unroll
                for (int m = 0; m < 4; ++m)
#pragma unroll
                    for (int n = 0; n < 2; ++n) acc[a][b][m][n] = (f32x4){0.f, 0.f, 0.f, 0.f};
        cur = nxt; cA = nA; cB = nB; ++ui;
        if constexpr (ALIGN_EPI) { if (wr == 1) PG8_BAR; }
    }
    PG8_WAIT_V(0);
    if constexpr (!ALIGN_EPI) { if (wr == 0) PG8_BAR; }
    PG8_BAR;
    if constexpr (Epi::AFTER_DRAIN) { E.fused(acc, cur, wr, wc, fr, fq, lds, wid, lane); S.done(cur); }
#undef PG8_SA
#undef PG8_SB
#undef PG8_STAGE
#undef PG8_LDA
#undef PG8_LDB
#undef PG8_MMA
#undef PG8_WAIT_V
#undef PG8_WAIT_L
#undef PG8_BAR
#undef PG8_SCHED
}
}
#define GAS __attribute__((address_space(1)))
#define LAS __attribute__((address_space(3)))
typedef unsigned short bf16;
typedef unsigned v4u __attribute__((ext_vector_type(4)));
typedef float f32x4 __attribute__((ext_vector_type(4)));
typedef short bf16x8 __attribute__((ext_vector_type(8)));
typedef GAS unsigned gu32;
typedef GAS unsigned long long gu64;
#define RLX_AGENT __ATOMIC_RELAXED, __HIP_MEMORY_SCOPE_AGENT
#define LDS_WAIT() asm volatile("s_waitcnt lgkmcnt(0)" ::: "memory")
#define VM_WAIT() asm volatile("s_waitcnt vmcnt(0)" ::: "memory")
__device__ __forceinline__ unsigned long long rt() { return __builtin_amdgcn_s_memrealtime(); }
__device__ __forceinline__ unsigned f2bf(float f) { unsigned u = __builtin_bit_cast(unsigned, f); return (u + 0x7fffu + ((u >> 16) & 1u)) >> 16; }
__device__ __forceinline__ unsigned pk2(float lo, float hi) { return f2bf(lo) | (f2bf(hi) << 16); }

#define XB_TMO      128
#define XB_XCNT(j)  (256  + 64 * (j))
#define XB_XSUB(j)  (1280 + 64 * (j))
#define XB_XGEN(j)  (2304 + 64 * (j))
#define XB_TOP      3328
#define XB_TOPGEN   3392
#define XCD_BAR_WORDS 3456
#define XB_SPIN_CAP (1u << 18)

__device__ __forceinline__ unsigned xb_ld(unsigned* p)              { return __hip_atomic_load(p, __ATOMIC_RELAXED, __HIP_MEMORY_SCOPE_AGENT); }
__device__ __forceinline__ unsigned xb_add(unsigned* p, unsigned v) { return __hip_atomic_fetch_add(p, v, __ATOMIC_RELAXED, __HIP_MEMORY_SCOPE_AGENT); }
__device__ __forceinline__ unsigned xb_xcc_id() { return (unsigned)__builtin_amdgcn_s_getreg((3 << 11) | 20) & 0xFu; }
#define XB_SPIN(cond, bar) do { unsigned _sp = 0; while (cond) { __builtin_amdgcn_s_sleep(1); \
    if ((++_sp & 255u) == 0u) { if (xb_ld(&(bar)[XB_TMO])) break; if (_sp > XB_SPIN_CAP) { atomicAdd(&(bar)[XB_TMO], 1u); break; } } } } while (0)

struct XcdBarrier {
    unsigned* bar; unsigned x;
    unsigned w0;
    volatile LAS unsigned* st;
};

#define XB_LANE0() (__builtin_amdgcn_mbcnt_hi(~0u, __builtin_amdgcn_mbcnt_lo(~0u, 0u)) == 0u)
__device__ __forceinline__ XcdBarrier xcd_barrier_post(unsigned* bar, volatile LAS unsigned* st, unsigned w0) {
    XcdBarrier b; b.bar = bar; b.x = xb_xcc_id(); b.st = st; b.w0 = w0;
    if (w0 && XB_LANE0()) (void)xb_add(&bar[XB_XCNT(b.x)], 1u);
    return b;
}
__device__ __forceinline__ void xcd_barrier_complete(unsigned* bar, unsigned x, unsigned& nloc, unsigned& nx) {
    const unsigned G = gridDim.x * gridDim.y * gridDim.z;
    unsigned sum, cnt, mine, sp = 0u;
    for (;;) {
        sum = 0u; cnt = 0u; mine = 0u;
#pragma unroll
        for (unsigned j = 0; j < 16; ++j) { const unsigned c = xb_ld(&bar[XB_XCNT(j)]); sum += c; cnt += (c > 0u) ? 1u : 0u; mine = (j == x) ? c : mine; }
        if (sum == G) break;
        __builtin_amdgcn_s_sleep(1);
        if ((++sp & 255u) == 0u) { if (xb_ld(&bar[XB_TMO])) break; if (sp > XB_SPIN_CAP) { atomicAdd(&bar[XB_TMO], 1u); break; } }
    }
    nloc = mine > 0u ? mine : 1u; nx = cnt > 0u ? cnt : 1u;
}

__device__ __forceinline__ void xcd_barrier(const XcdBarrier& b) {
    asm volatile("s_waitcnt vmcnt(0)" ::: "memory");
    __syncthreads();
    if (b.w0 && XB_LANE0()) {
        unsigned* bar = b.bar;
        __builtin_amdgcn_s_waitcnt(0);
        unsigned nloc = b.st[0], nx = b.st[1];
        if (nloc == 0u) { xcd_barrier_complete(bar, b.x, nloc, nx); b.st[0] = nloc; b.st[1] = nx; }
        const unsigned old = xb_add(&bar[XB_XSUB(b.x)], 1u);
        const unsigned gen = old / nloc;
        if (old + 1u == (gen + 1u) * nloc) {
            __builtin_amdgcn_fence(__ATOMIC_RELEASE, "agent");
            asm volatile("s_waitcnt vmcnt(0)" ::: "memory");
            const unsigned og = xb_add(&bar[XB_TOP], 1u);
            const unsigned tg = og / nx;
            if (og + 1u == (tg + 1u) * nx) xb_add(&bar[XB_TOPGEN], 1u);
            else XB_SPIN(xb_ld(&bar[XB_TOPGEN]) == tg, bar);
            __builtin_amdgcn_fence(__ATOMIC_ACQUIRE, "agent");
            xb_add(&bar[XB_XGEN(b.x)], 1u);
            asm volatile("s_waitcnt vmcnt(0)" ::: "memory");
        } else {
            XB_SPIN(xb_ld(&bar[XB_XGEN(b.x)]) == gen, bar);
            __builtin_amdgcn_fence(__ATOMIC_ACQUIRE, "agent");
            asm volatile("s_waitcnt vmcnt(0)" ::: "memory");
        }
    }
    __syncthreads();
}
constexpr int DM = 1024;
constexpr int TP = 8192, BP = 2, MP = BP * TP;
constexpr int NB_S = 128, SS = 4, MS = NB_S * SS;
constexpr int MT = MP + MS;
constexpr int PIN = 2328, NIN = 2560;
constexpr int FFN = 2816, NGU = 2 * FFN;
constexpr int PAST = 2048, PAGE = 128, NPG = PAST / PAGE, NPOOL = 2560;
constexpr int KVW = 256;
constexpr int NLAYER = 2;
constexpr float LN_EPS = 1e-5f;
constexpr float DN_ALPHA = 1.4142135623730951f;

constexpr size_t O_Y = 0;
constexpr size_t O_CMPP = (size_t)MT * DM;
constexpr size_t O_SLCP = O_CMPP + (size_t)NLAYER * MP * KVW;
constexpr size_t O_WINP = O_SLCP + (size_t)NLAYER * MP * KVW;
constexpr size_t O_CMPS = O_WINP + (size_t)NLAYER * BP * 512 * KVW;
constexpr size_t O_SLCS = O_CMPS + (size_t)NLAYER * MS * KVW;
constexpr size_t O_WINS = O_SLCS + (size_t)NLAYER * MS * KVW;
constexpr size_t O_GV = O_WINS + (size_t)NLAYER * NB_S * 512 * KVW;
constexpr size_t O_END = O_GV + (size_t)NLAYER * MS * 512;
static_assert(O_END == 69206016, "output size");

constexpr size_t MiB = 1u << 20;
constexpr size_t WS_CTL = 0, CTL_ZERO_BYTES = 1 * MiB;
constexpr size_t WS_ROPE = 1 * MiB;
constexpr size_t WS_WIN_T = 4 * MiB;
constexpr size_t WS_WOUT_T = 14 * MiB;
constexpr size_t WS_WGU_T = 18 * MiB;
constexpr size_t WS_WDN_T = 40 * MiB;
constexpr size_t WS_W1C_T = 52 * MiB;
constexpr size_t WS_W2C_T = 56 * MiB;
constexpr size_t WS_GWP = 57 * MiB;
constexpr size_t WS_GWS = 58 * MiB;
constexpr size_t WS_GBS = 59 * MiB;
constexpr size_t WS_XF = 64 * MiB;
constexpr size_t WS_XB = 130 * MiB;
constexpr size_t WS_PRE = 163 * MiB;
constexpr size_t WS_QRAW = 229 * MiB;
constexpr size_t WS_QROT = 246 * MiB;
constexpr size_t WS_KS = 263 * MiB;
constexpr size_t WS_VS = 267 * MiB;
constexpr size_t WS_KW = 271 * MiB;
constexpr size_t WS_VW = 275 * MiB;
constexpr size_t WS_U = 279 * MiB;
constexpr size_t WS_V = 296 * MiB;
constexpr size_t WS_GATES = 313 * MiB;
constexpr size_t WS_CKP = 315 * MiB;
constexpr size_t WS_CVP = WS_CKP + 512 * 1024;
constexpr size_t WS_CKS = 316 * MiB;
constexpr size_t WS_CVS = 320 * MiB;
constexpr size_t WS_MIX = 324 * MiB;
constexpr size_t WS_F = 357 * MiB;
constexpr size_t WS_DBG = 448 * MiB;
constexpr size_t WS_END = 560 * MiB;
static_assert(WS_XF + (size_t)MT * DM * 4 <= WS_XB && WS_XB + (size_t)MT * DM * 2 <= WS_PRE && WS_PRE + (size_t)MT * DM * 4 <= WS_QRAW, "ws map 1");
static_assert(WS_QRAW + (size_t)MT * 512 * 2 <= WS_QROT && WS_QROT + (size_t)MT * 512 * 2 <= WS_KS && WS_U + (size_t)MT * 512 * 2 <= WS_V && WS_V + (size_t)MT * 512 * 2 <= WS_GATES, "ws map 2");
static_assert(WS_GATES + (size_t)MT * 24 * 4 <= WS_CKP && WS_MIX + (size_t)MT * DM * 2 <= WS_F && WS_F + (size_t)MT * FFN * 2 <= WS_END, "ws map 3");
static_assert(WS_WIN_T + (size_t)2 * NIN * DM * 2 <= WS_WOUT_T && WS_WGU_T + (size_t)2 * NGU * DM * 2 <= WS_WDN_T && WS_WDN_T + (size_t)2 * DM * FFN * 2 <= WS_W1C_T, "ws map 4");

constexpr int CW_TMO = 0, CW_CODE = 1;
constexpr int CW_BAR = 4096;
constexpr int CW_ERR = 64;
#ifndef ATT_PROBE_GAIN
#define ATT_PROBE_GAIN 10.0f
#endif
#ifndef ATT_PROBE_SEL
#define ATT_PROBE_SEL 3
#endif

constexpr int NWAVES = 8;
constexpr int RING_OFF = 0, RING_BYTES = 131072;
constexpr int LDSCTL_OFF = 143360, MISC_OFF = LDSCTL_OFF + 320;
constexpr int LDS_BYTES = 147456;

constexpr int PH_P0A = 0, PH_P0B = 1, PH_L0 = 2, PH_PER_LAYER = 8, N_PHASES = PH_L0 + NLAYER * PH_PER_LAYER;
typedef float f32x2 __attribute__((ext_vector_type(2)));
typedef unsigned u32x2 __attribute__((ext_vector_type(2)));
__device__ __forceinline__ float bf2f(unsigned short h) { return __uint_as_float(((unsigned)h) << 16); }
__device__ __forceinline__ float bflo(unsigned w) { return __uint_as_float(w << 16); }
__device__ __forceinline__ float bfhi(unsigned w) { return __uint_as_float(w & 0xffff0000u); }
__device__ __forceinline__ float wave_sum(float v) {
#pragma unroll
    for (int o = 1; o < 64; o <<= 1) v += __shfl_xor(v, o);
    return v;
}
__device__ __forceinline__ float wave_max(float v) {
#pragma unroll
    for (int o = 1; o < 64; o <<= 1) v = fmaxf(v, __shfl_xor(v, o));
    return v;
}
__device__ __forceinline__ float sigmoidf_(float x) { return 1.0f / (1.0f + __expf(-x)); }
__device__ __forceinline__ float siluf_(float x) { return x / (1.0f + __expf(-x)); }
__device__ __forceinline__ float geluf_(float x) { const float u = 1.5957691216057308f * (x + 0.044715f * x * x * x); return x / (1.0f + __expf(-u)); }
#define WAVE_LDS_FENCE() asm volatile("s_waitcnt lgkmcnt(0)" ::: "memory")

struct EpiResid {
    static constexpr bool PERM = false, AFTER_DRAIN = false;
    const float* xf; float* pre;
    __device__ __forceinline__ void operator()(const pg8::f32x4 (&acc)[2][2][4][2], const pg8::Unit& u, int wr, int wc, int fr, int fq) const {
        const int col0 = u.pn * 256 + wc * 32 + 4 * fq;
#pragma unroll
        for (int ai = 0; ai < 2; ++ai)
#pragma unroll
            for (int m = 0; m < 4; ++m) {
                const size_t off = (size_t)(u.pm * 256 + ai * 128 + wr * 64 + m * 16 + fr) * DM + col0;
#pragma unroll
                for (int bj = 0; bj < 2; ++bj)
#pragma unroll
                    for (int n = 0; n < 2; ++n) {
                        const pg8::f32x4 x = *(const pg8::f32x4*)(xf + off + bj * 128 + n * 16);
                        *(pg8::f32x4*)(pre + off + bj * 128 + n * 16) = x * DN_ALPHA + acc[ai][bj][m][n];
                    }
            }
    }
};
struct EpiGateUp {
    static constexpr bool PERM = true, AFTER_DRAIN = false;
    bf16* f;
    __device__ __forceinline__ void operator()(const pg8::f32x4 (&acc)[2][2][4][2], const pg8::Unit& u, int wr, int wc, int fr, int fq) const {
        const int c8 = u.pn * 256 + wc * 32 + 8 * fq;
#pragma unroll
        for (int ai = 0; ai < 2; ++ai)
#pragma unroll
            for (int m = 0; m < 4; ++m) {
                const size_t row = (size_t)(u.pm * 256 + ai * 128 + wr * 64 + m * 16 + fr);
#pragma unroll
                for (int bj = 0; bj < 2; ++bj) {
                    const pg8::f32x4 v0 = acc[ai][bj][m][0], v1 = acc[ai][bj][m][1];
                    const float o0 = siluf_(v0[0]) * v0[1], o1 = siluf_(v0[2]) * v0[3], o2 = siluf_(v1[0]) * v1[1], o3 = siluf_(v1[2]) * v1[3];
                    u32x2 w; w.x = pk2(o0, o1); w.y = pk2(o2, o3);
                    *(u32x2*)(f + row * FFN + ((c8 + bj * 128) >> 1)) = w;
                }
            }
    }
};
struct EpiInProj {
    static constexpr bool PERM = true, AFTER_DRAIN = false;
    int layer; unsigned char* ws; float* out;
    __device__ __forceinline__ void operator()(const pg8::f32x4 (&acc)[2][2][4][2], const pg8::Unit& u, int wr, int wc, int fr, int fq) const {
        const int pn = u.pn;
        const f32x2* rope = (const f32x2*)(ws + WS_ROPE); bf16* qraw = (bf16*)(ws + WS_QRAW); bf16* qrot = (bf16*)(ws + WS_QROT);
        bf16* KS = (bf16*)(ws + WS_KS); bf16* VS = (bf16*)(ws + WS_VS); bf16* KW = (bf16*)(ws + WS_KW); bf16* VW = (bf16*)(ws + WS_VW);
        bf16* U = (bf16*)(ws + WS_U); bf16* V = (bf16*)(ws + WS_V); float* gates = (float*)(ws + WS_GATES);
#pragma unroll
        for (int ai = 0; ai < 2; ++ai)
#pragma unroll
            for (int m = 0; m < 4; ++m) {
                const int r = u.pm * 256 + ai * 128 + wr * 64 + m * 16 + fr;
                const bool prompt = r < MP;
                const int b = r >> 13, t = r & (TP - 1);
                const int si = r - MP, bs = si >> 2, s = si & 3;
                const int pos = prompt ? t : PAST + s;
#pragma unroll
                for (int bj = 0; bj < 2; ++bj) {
                    const int c8 = pn * 256 + bj * 128 + wc * 32 + 8 * fq;
                    const pg8::f32x4 v0 = acc[ai][bj][m][0], v1 = acc[ai][bj][m][1];
                    if (pn < 2) {
                        const int h = c8 >> 6, d = (c8 & 63) >> 1;
                        const f32x2 cs0 = rope[pos * 32 + d], cs1 = rope[pos * 32 + d + 1], cs2 = rope[pos * 32 + d + 2], cs3 = rope[pos * 32 + d + 3];
                        const float a0 = v0[0], b0 = v0[1], a1 = v0[2], b1 = v0[3], a2 = v1[0], b2 = v1[1], a3 = v1[2], b3 = v1[3];
                        const size_t o = (size_t)r * 512 + h * 64 + d;
                        u32x2 w;
                        w.x = pk2(a0, a1); w.y = pk2(a2, a3); *(u32x2*)(qraw + o) = w;
                        w.x = pk2(b0, b1); w.y = pk2(b2, b3); *(u32x2*)(qraw + o + 32) = w;
                        w.x = pk2(a0 * cs0.x - b0 * cs0.y, a1 * cs1.x - b1 * cs1.y); w.y = pk2(a2 * cs2.x - b2 * cs2.y, a3 * cs3.x - b3 * cs3.y); *(u32x2*)(qrot + o) = w;
                        w.x = pk2(b0 * cs0.x + a0 * cs0.y, b1 * cs1.x + a1 * cs1.y); w.y = pk2(b2 * cs2.x + a2 * cs2.y, b3 * cs3.x + a3 * cs3.y); *(u32x2*)(qrot + o + 32) = w;
                    } else if (pn == 2) {
                        const int cc = c8 - 512;
                        float* dst = prompt ? out + O_CMPP + ((size_t)(layer * BP + b) * TP + t) * KVW + cc : out + O_CMPS + ((size_t)layer * MS + si) * KVW + cc;
                        *(pg8::f32x4*)dst = v0; *(pg8::f32x4*)(dst + 4) = v1;
                    } else if (pn == 3 || pn == 4) {
                        const bool is_slc = (pn == 3);
                        const int cc = c8 - (is_slc ? 768 : 1024);
                        float* dst;
                        bool wr_out = true;
                        if (is_slc) dst = prompt ? out + O_SLCP + ((size_t)(layer * BP + b) * TP + t) * KVW : out + O_SLCS + ((size_t)layer * MS + si) * KVW;
                        else { if (prompt) { wr_out = (t >= TP - 512); dst = out + O_WINP + ((size_t)(layer * BP + b) * 512 + (t - (TP - 512))) * KVW; }
                               else dst = out + O_WINS + ((size_t)(layer * NB_S + bs) * 512 + 508 + s) * KVW; }
                        if (cc < 128) {
                            const int g = cc >> 6, d = (cc & 63) >> 1;
                            const f32x2 cs0 = rope[pos * 32 + d], cs1 = rope[pos * 32 + d + 1], cs2 = rope[pos * 32 + d + 2], cs3 = rope[pos * 32 + d + 3];
                            const float a0 = v0[0], b0 = v0[1], a1 = v0[2], b1 = v0[3], a2 = v1[0], b2 = v1[1], a3 = v1[2], b3 = v1[3];
                            const pg8::f32x4 lo = {a0 * cs0.x - b0 * cs0.y, a1 * cs1.x - b1 * cs1.y, a2 * cs2.x - b2 * cs2.y, a3 * cs3.x - b3 * cs3.y};
                            const pg8::f32x4 hi = {b0 * cs0.x + a0 * cs0.y, b1 * cs1.x + a1 * cs1.y, b2 * cs2.x + a2 * cs2.y, b3 * cs3.x + a3 * cs3.y};
                            if (wr_out) { *(pg8::f32x4*)(dst + g * 64 + d) = lo; *(pg8::f32x4*)(dst + g * 64 + d + 32) = hi; }
                            if (prompt) { bf16* kb = (is_slc ? KS : KW) + ((size_t)(b * 2 + g) * TP + t) * 64 + d;
                                u32x2 w; w.x = pk2(lo[0], lo[1]); w.y = pk2(lo[2], lo[3]); *(u32x2*)kb = w;
                                w.x = pk2(hi[0], hi[1]); w.y = pk2(hi[2], hi[3]); *(u32x2*)(kb + 32) = w; }
                        } else {
                            const int g = (cc - 128) >> 6, d = cc & 63;
                            if (wr_out) { *(pg8::f32x4*)(dst + cc) = v0; *(pg8::f32x4*)(dst + cc + 4) = v1; }
                            if (prompt) { bf16* vb = (is_slc ? VS : VW) + ((size_t)(b * 2 + g) * TP + t) * 64 + d;
                                v4u w; w.x = pk2(v0[0], v0[1]); w.y = pk2(v0[2], v0[3]); w.z = pk2(v1[0], v1[1]); w.w = pk2(v1[2], v1[3]); *(v4u*)vb = w; }
                        }
                    } else if (pn < 9) {
                        const bool is_u = pn < 7;
                        const int cc = c8 - (is_u ? 1280 : 1792);
                        bf16* dst = (is_u ? U : V) + (size_t)r * 512 + cc;
                        v4u w; w.x = pk2(geluf_(v0[0]), geluf_(v0[1])); w.y = pk2(geluf_(v0[2]), geluf_(v0[3])); w.z = pk2(geluf_(v1[0]), geluf_(v1[1])); w.w = pk2(geluf_(v1[2]), geluf_(v1[3]));
                        *(v4u*)dst = w;
                    } else {
                        const int cc = c8 - 2304;
                        if (cc < 24) { float* dst = gates + (size_t)r * 24 + cc;
                            const pg8::f32x4 g0 = {sigmoidf_(v0[0]), sigmoidf_(v0[1]), sigmoidf_(v0[2]), sigmoidf_(v0[3])}, g1 = {sigmoidf_(v1[0]), sigmoidf_(v1[1]), sigmoidf_(v1[2]), sigmoidf_(v1[3])};
                            *(pg8::f32x4*)dst = g0; *(pg8::f32x4*)(dst + 4) = g1; }
                    }
                }
            }
    }
};

template <class RowMap>
__device__ __forceinline__ void transpose_item(const float* W, int K, int N, bf16* WT, const RowMap rm, LAS float* scr, int item, int lane) {
    const int nblk = (N + 31) / 32, kb = item / nblk, nb = item % nblk, k0 = 64 * kb, n0 = 32 * nb;
    const int ncol = n0 + (lane & 31);
#pragma unroll 8
    for (int i = 0; i < 32; ++i) { const int kk = 2 * i + (lane >> 5); scr[kk * 33 + (lane & 31)] = (ncol < N) ? W[(size_t)(k0 + kk) * N + ncol] : 0.f; }
    LDS_WAIT(); asm volatile("" ::: "memory");
    const int c = lane & 7;
#pragma unroll
    for (int j = 0; j < 4; ++j) { const int nl = (lane >> 3) + 8 * j; const LAS float* s = scr + (8 * c) * 33 + nl;
        v4u o; o.x = pk2(s[0 * 33], s[1 * 33]); o.y = pk2(s[2 * 33], s[3 * 33]); o.z = pk2(s[4 * 33], s[5 * 33]); o.w = pk2(s[6 * 33], s[7 * 33]);
        if (n0 + nl < N) *(v4u*)(WT + (size_t)rm(n0 + nl) * K + k0 + 8 * c) = o; }
    LDS_WAIT(); asm volatile("" ::: "memory");
}
struct RmIdent { __device__ __forceinline__ int operator()(int n) const { return n; } };
struct RmAffine { int mul, add; __device__ __forceinline__ int operator()(int n) const { return n * mul + add; } };
__device__ __forceinline__ int rope_il(int d) { return d < 32 ? 2 * d : 2 * (d - 32) + 1; }
struct RmInProj { __device__ __forceinline__ int operator()(int c) const {
    if (c < 512) return (c & ~63) + rope_il(c & 63);
    if (c < 768) return c;
    if (c < 1280) { const int base = c < 1024 ? 768 : 1024, cc = c - base; return cc < 128 ? base + (cc & ~63) + rope_il(cc & 63) : c; }
    if (c < 1304) return 2304 + (c - 1280);
    return 1280 + (c - 1304); } };
constexpr int CU_AS = 0, CU_BS = 9216, CU_HS = 46080, CU_LDS = 79872;
__device__ __forceinline__ void compress_unit(LAS unsigned char* lds, const float* arow, const float* pe_k, const bf16* W1t, const float* b1, const bf16* W2t,
                                              bf16* obase, int NC, int rb, int tid) {
    const int wid = __builtin_amdgcn_readfirstlane(tid >> 6), lane = tid & 63, fr = lane & 15, fq = lane >> 4, wr = wid >> 2, wc = wid & 3;
    const int arow_i = tid >> 3, ac = tid & 7;
    pg8::f32x4 acc[2][4];
#pragma unroll
    for (int m = 0; m < 2; ++m)
#pragma unroll
        for (int n = 0; n < 4; ++n) acc[m][n] = (pg8::f32x4){0.f, 0.f, 0.f, 0.f};
    pg8::f32x4 a0, a1, p0, p1; v4u bq[4];
    const float* pe_t = pe_k + ac * 8;
    const bf16* bsrc = W1t + (size_t)arow_i * 2048 + ac * 8;
    a0 = *(const pg8::f32x4*)arow; a1 = *(const pg8::f32x4*)(arow + 4); p0 = *(const pg8::f32x4*)pe_t; p1 = *(const pg8::f32x4*)(pe_t + 4);
#pragma unroll
    for (int j = 0; j < 4; ++j) bq[j] = *(const v4u*)(bsrc + (size_t)j * 64 * 2048);
    for (int l = 0; l < 32; ++l) {
        { v4u w; a0 = a0 + p0; a1 = a1 + p1; w.x = pk2(a0[0], a0[1]); w.y = pk2(a0[2], a0[3]); w.z = pk2(a1[0], a1[1]); w.w = pk2(a1[2], a1[3]);
          *(LAS v4u*)(lds + CU_AS + arow_i * 144 + ac * 16) = w;
#pragma unroll
          for (int j = 0; j < 4; ++j) *(LAS v4u*)(lds + CU_BS + (arow_i + 64 * j) * 144 + ac * 16) = bq[j]; }
        __syncthreads();
        if (l + 1 < 32) {
            const float* an = arow + (size_t)(l + 1) * KVW; const float* pn = pe_t + (l + 1) * 64; const bf16* bn = bsrc + (l + 1) * 64;
            a0 = *(const pg8::f32x4*)an; a1 = *(const pg8::f32x4*)(an + 4); p0 = *(const pg8::f32x4*)pn; p1 = *(const pg8::f32x4*)(pn + 4);
#pragma unroll
            for (int j = 0; j < 4; ++j) bq[j] = *(const v4u*)(bn + (size_t)j * 64 * 2048);
        }
#pragma unroll
        for (int kk = 0; kk < 2; ++kk) {
            bf16x8 af[2], bfr[4];
#pragma unroll
            for (int m = 0; m < 2; ++m) af[m] = *(const LAS bf16x8*)(lds + CU_AS + (wr * 32 + m * 16 + fr) * 144 + (kk * 32 + fq * 8) * 2);
#pragma unroll
            for (int n = 0; n < 4; ++n) bfr[n] = *(const LAS bf16x8*)(lds + CU_BS + (wc * 64 + n * 16 + fr) * 144 + (kk * 32 + fq * 8) * 2);
#pragma unroll
            for (int m = 0; m < 2; ++m)
#pragma unroll
                for (int n = 0; n < 4; ++n) acc[m][n] = __builtin_amdgcn_mfma_f32_16x16x32_bf16(af[m], bfr[n], acc[m][n], 0, 0, 0);
        }
        __syncthreads();
    }
#pragma unroll
    for (int m = 0; m < 2; ++m)
#pragma unroll
        for (int n = 0; n < 4; ++n) { const int col = wc * 64 + n * 16 + fr; const float bb = b1[col];
#pragma unroll
            for (int rg = 0; rg < 4; ++rg) { const int row = wr * 32 + m * 16 + fq * 4 + rg;
                *(LAS unsigned short*)(lds + CU_HS + row * 528 + col * 2) = (unsigned short)f2bf(siluf_(acc[m][n][rg] + bb)); } }
    __syncthreads();
    {
        const int rt = wid >> 1, ch = wid & 1;
        pg8::f32x4 acc2[2] = {(pg8::f32x4){0.f, 0.f, 0.f, 0.f}, (pg8::f32x4){0.f, 0.f, 0.f, 0.f}};
#pragma unroll
        for (int ks = 0; ks < 8; ++ks) {
            const bf16x8 a = *(const LAS bf16x8*)(lds + CU_HS + (rt * 16 + fr) * 528 + (ks * 32 + fq * 8) * 2);
#pragma unroll
            for (int nn = 0; nn < 2; ++nn) { const bf16x8 bb = *(const bf16x8*)(W2t + (size_t)(ch * 32 + nn * 16 + fr) * 256 + ks * 32 + fq * 8);
                acc2[nn] = __builtin_amdgcn_mfma_f32_16x16x32_bf16(a, bb, acc2[nn], 0, 0, 0); }
        }
#pragma unroll
        for (int nn = 0; nn < 2; ++nn)
#pragma unroll
            for (int rg = 0; rg < 4; ++rg) { const int R = rb * 64 + rt * 16 + fq * 4 + rg, col = ch * 32 + nn * 16 + fr;
                const int b = R / (2 * NC), n = (R >> 1) % NC, g = R & 1;
                obase[((size_t)(b * 2 + g) * NC + n) * 64 + col] = (bf16)f2bf(acc2[nn][rg]); }
    }
    __syncthreads();
}

__device__ __forceinline__ void gmlp_unit(LAS unsigned char* lds, LAS unsigned char* lds_stats, int m0, const bf16* U, const bf16* V, const float* Wm, const float* bias, const float* lng, const float* lnb,
                                          bf16* mix, float* gv_out  , int tid) {
    const int wid = __builtin_amdgcn_readfirstlane(tid >> 6), lane = tid & 63;
    LAS f32x2* stats = (LAS f32x2*)lds_stats;
    for (int i = 0; i < 16; ++i) {
        const int row = wid * 16 + i;
        const v4u w = *(const v4u*)(V + (size_t)(m0 + row) * 512 + lane * 8);
        float x[8] = {bflo(w.x), bfhi(w.x), bflo(w.y), bfhi(w.y), bflo(w.z), bfhi(w.z), bflo(w.w), bfhi(w.w)};
        float s = 0.f;
#pragma unroll
        for (int e = 0; e < 8; ++e) s += x[e];
        const float mean = wave_sum(s) * (1.0f / 512.0f);
        float q = 0.f;
#pragma unroll
        for (int e = 0; e < 8; ++e) { const float d = x[e] - mean; q += d * d; }
        const float var = wave_sum(q) * (1.0f / 512.0f);
        if (lane == 0) stats[row] = (f32x2){mean, 1.0f / sqrtf(var + LN_EPS)};
    }
    __syncthreads();
    const int h = wid, col = h * 64 + lane;
    const float gg = lng[col], bb = lnb[col];
    LAS float* part = (LAS float*)(lds + wid * 16384);
    const float* Wh = Wm + (size_t)h * 128 * 128;
#pragma unroll 1
    for (int half = 0; half < 2; ++half) {
        float vn[64];
#pragma unroll
        for (int s = 0; s < 64; ++s) { const f32x2 st = stats[half * 64 + s]; vn[s] = (bf2f(V[(size_t)(m0 + half * 64 + s) * 512 + col]) - st.x) * st.y * gg + bb; }
        if (gv_out) {
#pragma unroll
            for (int s = 0; s < 64; ++s) gv_out[(size_t)(half * 64 + s) * 512 + col] = vn[s];
        }
        for (int t = half * 64; t < 128; ++t) {
            const float w0 = Wh[t * 128 + half * 64 + lane];
            float acc0 = (half == 0) ? bias[h * 128 + t] : part[(t - 64) * 64 + lane], acc1 = 0.f;
#pragma unroll
            for (int s = 0; s < 64; s += 2) { acc0 += __int_as_float(__builtin_amdgcn_readlane(__float_as_int(w0), s)) * vn[s]; acc1 += __int_as_float(__builtin_amdgcn_readlane(__float_as_int(w0), s + 1)) * vn[s + 1]; }
            const float sres = acc0 + acc1;
            if (half == 0 && t >= 64) part[(t - 64) * 64 + lane] = sres;
            else { const float uu = bf2f(U[(size_t)(m0 + t) * 512 + col]); mix[(size_t)(m0 + t) * DM + 512 + col] = (bf16)f2bf(uu * sres); }
        }
        WAVE_LDS_FENCE();
    }
    __syncthreads();
}

__device__ __forceinline__ void ln_row(const float* src, const float* g, const float* b, float* dstf, bf16* dstb, int lane) {
    pg8::f32x4 v[4]; float s = 0.f;
#pragma unroll
    for (int j = 0; j < 4; ++j) { v[j] = *(const pg8::f32x4*)(src + (j * 64 + lane) * 4); s += (v[j][0] + v[j][1]) + (v[j][2] + v[j][3]); }
    const float mean = wave_sum(s) * (1.0f / DM); float q = 0.f;
#pragma unroll
    for (int j = 0; j < 4; ++j) { v[j] = v[j] - mean; q += (v[j][0] * v[j][0] + v[j][1] * v[j][1]) + (v[j][2] * v[j][2] + v[j][3] * v[j][3]); }
    const float rstd = 1.0f / sqrtf(wave_sum(q) * (1.0f / DM) + LN_EPS);
#pragma unroll
    for (int j = 0; j < 4; ++j) { const int c = (j * 64 + lane) * 4;
        const pg8::f32x4 gg = *(const pg8::f32x4*)(g + c), bb = *(const pg8::f32x4*)(b + c);
        const pg8::f32x4 y = v[j] * rstd * gg + bb;
        *(pg8::f32x4*)(dstf + c) = y;
        if (dstb) { u32x2 w; w.x = pk2(y[0], y[1]); w.y = pk2(y[2], y[3]); *(u32x2*)(dstb + c) = w; } }
}

__device__ __forceinline__ void load8(const bf16* p, float (&k)[8]) { const v4u w = *(const v4u*)p; k[0] = bflo(w.x); k[1] = bfhi(w.x); k[2] = bflo(w.y); k[3] = bfhi(w.y); k[4] = bflo(w.z); k[5] = bfhi(w.z); k[6] = bflo(w.w); k[7] = bfhi(w.w); }
__device__ __forceinline__ void load8(const float* p, float (&k)[8]) { const pg8::f32x4 a = *(const pg8::f32x4*)p, b = *(const pg8::f32x4*)(p + 4); k[0] = a[0]; k[1] = a[1]; k[2] = a[2]; k[3] = a[3]; k[4] = b[0]; k[5] = b[1]; k[6] = b[2]; k[7] = b[3]; }
__device__ __forceinline__ float ldv(const bf16* p) { return bf2f(*p); }
__device__ __forceinline__ float ldv(const float* p) { return *p; }
template <class T> __device__ __forceinline__ void dot4(const T* krow, const LAS float* q, float (&s)[4]) {
    s[0] = s[1] = s[2] = s[3] = 0.f;
#pragma unroll 1
    for (int c = 0; c < 8; ++c) {
        float k[8]; load8(krow + c * 8, k);
#pragma unroll
        for (int r = 0; r < 4; ++r) {
            const pg8::f32x4 qa = *(const LAS pg8::f32x4*)(q + r * 64 + c * 8), qb = *(const LAS pg8::f32x4*)(q + r * 64 + c * 8 + 4);
            s[r] += qa[0] * k[0] + qa[1] * k[1] + qa[2] * k[2] + qa[3] * k[3] + qb[0] * k[4] + qb[1] * k[5] + qb[2] * k[6] + qb[3] * k[7];
        }
    }
}
template <class Src>
__device__ __forceinline__ void attend(const Src& S, int nblk, const LAS float* q, LAS float* pbuf, int lane, float (&o)[4], LAS float* impbuf) {
    typedef typename Src::T T;
    float m[4] = {-1e30f, -1e30f, -1e30f, -1e30f}, l[4] = {0.f, 0.f, 0.f, 0.f};
    for (int i = 0; i < nblk; ++i) {
        const T *kb, *vb; bool ok; S.blk(i, lane, kb, vb, ok);
        if (ok) { float s[4]; dot4(kb + (size_t)lane * Src::STRIDE, q, s);
#pragma unroll
            for (int r = 0; r < 4; ++r) { if (s[r] > m[r]) { l[r] = l[r] * __expf(m[r] - s[r]) + 1.0f; m[r] = s[r]; } else l[r] += __expf(s[r] - m[r]); } }
    }
    float Mx[4], inv[4];
#pragma unroll
    for (int r = 0; r < 4; ++r) { Mx[r] = wave_max(m[r]); const float L = wave_sum(l[r] * __expf(m[r] - Mx[r])); inv[r] = 1.0f / fmaxf(L, 1e-30f); }
    o[0] = o[1] = o[2] = o[3] = 0.f;
    if (!(Mx[0] > -1e29f)) return;
    for (int i = 0; i < nblk; ++i) {
        const T *kb, *vb; bool ok; S.blk(i, lane, kb, vb, ok);
        const unsigned long long mask = __ballot(ok);
        if (mask == 0ull) continue;
        pg8::f32x4 p = {0.f, 0.f, 0.f, 0.f};
        if (ok) { float s[4]; dot4(kb + (size_t)lane * Src::STRIDE, q, s);
#pragma unroll
            for (int r = 0; r < 4; ++r) p[r] = __expf(s[r] - Mx[r]) * inv[r]; }
        *(LAS pg8::f32x4*)(pbuf + lane * 4) = p;
        if (impbuf) { const float im = (p[0] + p[1]) + (p[2] + p[3]); const float pr = im + __shfl_xor(im, 1); if (!(lane & 1)) impbuf[(i * 64 + lane) >> 1] = pr; }
        WAVE_LDS_FENCE();
        for (int kk = 0; kk < 64; ++kk) {
            if ((mask >> kk) & 1ull) { const pg8::f32x4 pv = *(const LAS pg8::f32x4*)(pbuf + kk * 4); const float v = ldv(vb + (size_t)kk * Src::STRIDE + lane);
                o[0] += pv[0] * v; o[1] += pv[1] * v; o[2] += pv[2] * v; o[3] += pv[3] * v; }
        }
        WAVE_LDS_FENCE();
    }
}
__device__ __forceinline__ unsigned long long topk_key(float val, int j) { unsigned u = __float_as_uint(val); u = (u & 0x80000000u) ? ~u : (u | 0x80000000u); return ((unsigned long long)u << 32) | (unsigned)(127 - j); }
__device__ __forceinline__ void topk16(const LAS float* imp, int ns, int cur, LAS int* selidx, int lane) {
    unsigned long long k0 = 0ull, k1 = 0ull;
    { const int j = lane; if (j < ns) { const bool valid = j <= cur, forced = (j == 0) | (j == cur) | (j == cur - 1); k0 = topk_key(valid ? imp[j] + (forced ? 1.0e4f : 0.f) : -1.0f, j); } }
    { const int j = lane + 64; if (j < ns) { const bool valid = j <= cur, forced = (j == 0) | (j == cur) | (j == cur - 1); k1 = topk_key(valid ? imp[j] + (forced ? 1.0e4f : 0.f) : -1.0f, j); } }
    for (int it = 0; it < 16; ++it) {
        unsigned long long k = k0 > k1 ? k0 : k1;
#pragma unroll
        for (int o = 1; o < 64; o <<= 1) { const unsigned lo = __shfl_xor((unsigned)k, o), hi = __shfl_xor((unsigned)(k >> 32), o); const unsigned long long kx = ((unsigned long long)hi << 32) | lo; k = kx > k ? kx : k; }
        const int jb = 127 - (int)(unsigned)(k & 0xffffffffull);
        if (lane == 0) selidx[it] = (k == 0ull || jb > cur) ? -1 : jb;
        if (k0 == k) k0 = 0ull;
        if (k1 == k) k1 = 0ull;
    }
    WAVE_LDS_FENCE();
}
struct SrcPromptCmp { typedef bf16 T; static constexpr int STRIDE = 64; const bf16 *ck, *cv; int nvalid;
    __device__ __forceinline__ void blk(int i, int lane, const bf16*& kb, const bf16*& vb, bool& ok) const { kb = ck + (size_t)i * 64 * 64; vb = cv + (size_t)i * 64 * 64; ok = (i * 64 + lane) < nvalid; } };
struct SrcPromptSlc { typedef bf16 T; static constexpr int STRIDE = 64; const bf16 *K, *V; const LAS int* selidx; int t;
    __device__ __forceinline__ void blk(int i, int lane, const bf16*& kb, const bf16*& vb, bool& ok) const { const int j = selidx[i]; const int jj = j < 0 ? 0 : j; kb = K + (size_t)jj * 64 * 64; vb = V + (size_t)jj * 64 * 64; ok = (j >= 0) && (jj * 64 + lane <= t); } };
struct SrcPromptWin { typedef bf16 T; static constexpr int STRIDE = 64; const bf16 *K, *V; int t, kb0;
    __device__ __forceinline__ void blk(int i, int lane, const bf16*& kb, const bf16*& vb, bool& ok) const { const int j = kb0 + i, pos = j * 64 + lane; kb = K + (size_t)j * 64 * 64; vb = V + (size_t)j * 64 * 64; ok = (pos <= t) && (pos >= t - 511); } };
struct SrcSampleCmp { typedef bf16 T; static constexpr int STRIDE = 64; const bf16 *ck, *cv;
    __device__ __forceinline__ void blk(int i, int lane, const bf16*& kb, const bf16*& vb, bool& ok) const { kb = ck; vb = cv; ok = true; } };
struct SrcSampleSlc { typedef float T; static constexpr int STRIDE = KVW; const float* cache_l; const int* pt; const float* newrows; const LAS int* selidx; int g, s;
    __device__ __forceinline__ void blk(int i, int lane, const float*& kb, const float*& vb, bool& ok) const {
        const int j = selidx[i];
        if (j >= 0 && j < 32) { const int page = pt[j >> 1]; const float* rb = cache_l + ((size_t)page * PAGE + (j & 1) * 64) * KVW; kb = rb + g * 64; vb = rb + 128 + g * 64; ok = true; }
        else { kb = newrows + g * 64; vb = newrows + 128 + g * 64; ok = (j == 32) && (lane <= s); } } };
struct SrcSampleWin { typedef float T; static constexpr int STRIDE = KVW; const float* state; const float* newrows; int g, s;
    __device__ __forceinline__ void blk(int i, int lane, const float*& kb, const float*& vb, bool& ok) const {
        if (i < 8) { const float* rb = state + (size_t)i * 64 * KVW; kb = rb + g * 64; vb = rb + 128 + g * 64; ok = (i * 64 + lane) >= s + 1; }
        else { kb = newrows + g * 64; vb = newrows + 128 + g * 64; ok = lane <= s; } } };
typedef short s16x4 __attribute__((ext_vector_type(4)));
constexpr int ATS = 144;
constexpr int AT_TILE = 64 * ATS;
constexpr int AT_STASH = 8 * AT_TILE;
static_assert(AT_STASH + 65536 <= LDSCTL_OFF, "attention LDS map");
constexpr float SM_C = 0.125f * 1.4426950408889634f;
#ifndef ATT_PROBE
#define ATT_PROBE 0
#endif
__device__ __forceinline__ s16x4 ds_tr(const LAS unsigned char* p) { return __builtin_bit_cast(s16x4, __builtin_amdgcn_ds_read_tr16_b64_v4i16((LAS s16x4*)p)); }
__device__ __forceinline__ void load_kfrags(const LAS unsigned char* Kt, int fr, int fq, bf16x8 (&kf)[4][2]) {
#pragma unroll
    for (int kt = 0; kt < 4; ++kt)
#pragma unroll
        for (int ks = 0; ks < 2; ++ks) kf[kt][ks] = *(const LAS bf16x8*)(Kt + (16 * kt + fr) * ATS + (32 * ks + 8 * fq) * 2);
}
__device__ __forceinline__ void load_vfrags(const LAS unsigned char* Vt, int fr, int fq, bf16x8 (&vf)[4][2]) {
#pragma unroll
    for (int dt = 0; dt < 4; ++dt)
#pragma unroll
        for (int ks = 0; ks < 2; ++ks) {
            const LAS unsigned char* p = Vt + (32 * ks + 4 * fq + (fr >> 2)) * ATS + (16 * dt + 4 * (fr & 3)) * 2;
            const s16x4 lo = ds_tr(p), hi = ds_tr(p + 16 * ATS);
            vf[dt][ks] = (bf16x8){lo[0], lo[1], lo[2], lo[3], hi[0], hi[1], hi[2], hi[3]};
        }
}
__device__ __forceinline__ bf16x8 pack_p(const pg8::f32x4& a, const pg8::f32x4& b) {
    v4u w; w.x = pk2(a[0], a[1]); w.y = pk2(a[2], a[3]); w.z = pk2(b[0], b[1]); w.w = pk2(b[2], b[3]);
    return __builtin_bit_cast(bf16x8, w);
}
struct AGroup { bf16x8 q[2]; pg8::f32x4 O[4]; float m, l; };
__device__ __forceinline__ void attn_score(AGroup& G, const bf16x8 (&kf)[4][2], int lo, int hi, int fq, bf16x8& pb0, bf16x8& pb1) {
    pg8::f32x4 s[4];
#pragma unroll
    for (int kt = 0; kt < 4; ++kt) { s[kt] = __builtin_amdgcn_mfma_f32_16x16x32_bf16(kf[kt][0], G.q[0], (pg8::f32x4){0.f, 0.f, 0.f, 0.f}, 0, 0, 0);
        s[kt] = __builtin_amdgcn_mfma_f32_16x16x32_bf16(kf[kt][1], G.q[1], s[kt], 0, 0, 0); }
    float mx = -1e30f;
#pragma unroll
    for (int kt = 0; kt < 4; ++kt)
#pragma unroll
        for (int rg = 0; rg < 4; ++rg) { const int kidx = 16 * kt + 4 * fq + rg; const float v = (kidx >= lo && kidx <= hi) ? s[kt][rg] : -1e30f; s[kt][rg] = v; mx = fmaxf(mx, v); }
    mx = fmaxf(mx, __shfl_xor(mx, 16)); mx = fmaxf(mx, __shfl_xor(mx, 32));
    const float mnew = fmaxf(G.m, mx);
    const float alpha = __builtin_amdgcn_exp2f((G.m - mnew) * SM_C);
    const float mc = mnew * SM_C;
    float ps = 0.f;
#pragma unroll
    for (int kt = 0; kt < 4; ++kt)
#pragma unroll
        for (int rg = 0; rg < 4; ++rg) { const float pv = (s[kt][rg] > -1e29f) ? __builtin_amdgcn_exp2f(s[kt][rg] * SM_C - mc) : 0.f; s[kt][rg] = pv; ps += pv; }
    G.l = G.l * alpha + ps; G.m = mnew;
#pragma unroll
    for (int dt = 0; dt < 4; ++dt) G.O[dt] = G.O[dt] * alpha;
    pb0 = pack_p(s[0], s[1]); pb1 = pack_p(s[2], s[3]);
}
__device__ __forceinline__ void attn_pv(pg8::f32x4 (&O)[4], const bf16x8 (&vf)[4][2], const bf16x8& pb0, const bf16x8& pb1) {
#pragma unroll
    for (int dt = 0; dt < 4; ++dt) { O[dt] = __builtin_amdgcn_mfma_f32_16x16x32_bf16(vf[dt][0], pb0, O[dt], 0, 0, 0); O[dt] = __builtin_amdgcn_mfma_f32_16x16x32_bf16(vf[dt][1], pb1, O[dt], 0, 0, 0); }
}
__device__ __forceinline__ int next_bit128(unsigned u0, unsigned u1, unsigned u2, unsigned u3, int from) {
    if (from < 32) { const unsigned x = (u0 >> from) << from; if (x) return __builtin_ctz(x); }
    if (from < 64) { const int sh = from > 32 ? from - 32 : 0; const unsigned x = (u1 >> sh) << sh; if (x) return 32 + __builtin_ctz(x); }
    if (from < 96) { const int sh = from > 64 ? from - 64 : 0; const unsigned x = (u2 >> sh) << sh; if (x) return 64 + __builtin_ctz(x); }
    if (from < 128) { const int sh = from > 96 ? from - 96 : 0; const unsigned x = (u3 >> sh) << sh; if (x) return 96 + __builtin_ctz(x); }
    return -1;
}
__device__ __forceinline__ bool test_bit128(unsigned u0, unsigned u1, unsigned u2, unsigned u3, int j) { const unsigned w = j < 32 ? u0 : j < 64 ? u1 : j < 96 ? u2 : u3; return (w >> (j & 31)) & 1u; }
template <bool WIN>
__device__ __forceinline__ void attn_walk(LAS unsigned char* lds, const bf16* Kg, const bf16* Vg, unsigned W0, unsigned W1, unsigned W2, unsigned W3,
                                          unsigned nA0, unsigned nA1, unsigned nA2, unsigned nA3, unsigned nB0, unsigned nB1, unsigned nB2, unsigned nB3,
                                          const unsigned (&selA)[4], const unsigned (&selB)[4], int tA, int tB, AGroup& GA, AGroup& GB, int tid, int fr, int fq) {
    const int row = tid >> 3, ch = tid & 7;
    int j = next_bit128(W0, W1, W2, W3, 0);
    v4u kr, vr;
    if (j >= 0) { kr = *(const v4u*)(Kg + ((size_t)(64 * j + row)) * 64 + ch * 8); vr = *(const v4u*)(Vg + ((size_t)(64 * j + row)) * 64 + ch * 8);
        *(LAS v4u*)(lds + row * ATS + ch * 16) = kr; *(LAS v4u*)(lds + AT_TILE + row * ATS + ch * 16) = vr; }
    __syncthreads();
    int cb = 0;
    while (j >= 0) {
        const int jn = next_bit128(W0, W1, W2, W3, j + 1);
        if (jn >= 0) { kr = *(const v4u*)(Kg + ((size_t)(64 * jn + row)) * 64 + ch * 8); vr = *(const v4u*)(Vg + ((size_t)(64 * jn + row)) * 64 + ch * 8); }
        const bool needA = test_bit128(nA0, nA1, nA2, nA3, j), needB = test_bit128(nB0, nB1, nB2, nB3, j);
        if (needA || needB) {
            const LAS unsigned char* Kt = lds + cb * 2 * AT_TILE; const LAS unsigned char* Vt = Kt + AT_TILE;
            bf16x8 pa0, pa1, pc0, pc1;
            { bf16x8 kf[4][2]; load_kfrags(Kt, fr, fq, kf);
              if (needA) { int lo, hi;
                if (WIN) { lo = tA - 511 - 64 * j; hi = tA - 64 * j; } else { lo = 0; hi = test_bit128(selA[0], selA[1], selA[2], selA[3], j) ? tA - 64 * j : -1; }
                attn_score(GA, kf, lo, hi, fq, pa0, pa1); }
              if (needB) { int lo, hi;
                if (WIN) { lo = tB - 511 - 64 * j; hi = tB - 64 * j; } else { lo = 0; hi = test_bit128(selB[0], selB[1], selB[2], selB[3], j) ? tB - 64 * j : -1; }
                attn_score(GB, kf, lo, hi, fq, pc0, pc1); } }
            asm volatile("" ::: "memory");
            { bf16x8 vf[4][2]; load_vfrags(Vt, fr, fq, vf);
              if (needA) attn_pv(GA.O, vf, pa0, pa1);
              if (needB) attn_pv(GB.O, vf, pc0, pc1); }
        }
        if (jn >= 0) { LAS unsigned char* nb = lds + (cb ^ 1) * 2 * AT_TILE; *(LAS v4u*)(nb + row * ATS + ch * 16) = kr; *(LAS v4u*)(nb + AT_TILE + row * ATS + ch * 16) = vr; }
        __syncthreads();
        j = jn; cb ^= 1;
    }
}
__device__ __forceinline__ void attn_cmp_group(const LAS unsigned char* lds, int NCT, const bf16x8 (&q)[2], int t, int cur, int fr, int fq, pg8::f32x4 (&Oc)[4], unsigned (&sel)[4]) {
    const int nv = (t + 1) >> 5;
    float m = -1e30f, l = 0.f;
#pragma unroll 1
    for (int ct = 0; ct < NCT; ++ct) {
        bf16x8 kf[4][2]; load_kfrags(lds + ct * AT_TILE, fr, fq, kf);
        pg8::f32x4 s[4];
#pragma unroll
        for (int kt = 0; kt < 4; ++kt) { s[kt] = __builtin_amdgcn_mfma_f32_16x16x32_bf16(kf[kt][0], q[0], (pg8::f32x4){0.f, 0.f, 0.f, 0.f}, 0, 0, 0);
            s[kt] = __builtin_amdgcn_mfma_f32_16x16x32_bf16(kf[kt][1], q[1], s[kt], 0, 0, 0); }
        float mx = -1e30f;
#pragma unroll
        for (int kt = 0; kt < 4; ++kt)
#pragma unroll
            for (int rg = 0; rg < 4; ++rg) { const int n = 64 * ct + 16 * kt + 4 * fq + rg; const float v = (n < nv) ? s[kt][rg] : -1e30f; s[kt][rg] = v; mx = fmaxf(mx, v); }
        mx = fmaxf(mx, __shfl_xor(mx, 16)); mx = fmaxf(mx, __shfl_xor(mx, 32));
        const float mnew = fmaxf(m, mx), mc = mnew * SM_C;
        float ps = 0.f;
#pragma unroll
        for (int kt = 0; kt < 4; ++kt)
#pragma unroll
            for (int rg = 0; rg < 4; ++rg) ps += (s[kt][rg] > -1e29f) ? __builtin_amdgcn_exp2f(s[kt][rg] * SM_C - mc) : 0.f;
        l = l * __builtin_amdgcn_exp2f((m - mnew) * SM_C) + ps; m = mnew;
    }
    l += __shfl_xor(l, 16); l += __shfl_xor(l, 32);
    const float inv = 1.0f / fmaxf(l, 1e-30f), mc = m * SM_C;
    unsigned key[32];
#pragma unroll
    for (int dt = 0; dt < 4; ++dt) Oc[dt] = (pg8::f32x4){0.f, 0.f, 0.f, 0.f};
#pragma unroll
    for (int ct = 0; ct < 4; ++ct) {
        if (ct < NCT) {
            pg8::f32x4 s[4];
            { bf16x8 kf[4][2]; load_kfrags(lds + ct * AT_TILE, fr, fq, kf);
#pragma unroll
              for (int kt = 0; kt < 4; ++kt) { s[kt] = __builtin_amdgcn_mfma_f32_16x16x32_bf16(kf[kt][0], q[0], (pg8::f32x4){0.f, 0.f, 0.f, 0.f}, 0, 0, 0);
                  s[kt] = __builtin_amdgcn_mfma_f32_16x16x32_bf16(kf[kt][1], q[1], s[kt], 0, 0, 0); } }
#pragma unroll
            for (int kt = 0; kt < 4; ++kt)
#pragma unroll
                for (int rg = 0; rg < 4; ++rg) { const int n = 64 * ct + 16 * kt + 4 * fq + rg; s[kt][rg] = (n < nv) ? __builtin_amdgcn_exp2f(s[kt][rg] * SM_C - mc) * inv : 0.f; }
#pragma unroll
            for (int kt = 0; kt < 4; ++kt)
#pragma unroll
                for (int e = 0; e < 2; ++e) {
                    float im = s[kt][2 * e] + s[kt][2 * e + 1];
                    im += __shfl_xor(im, 1); im += __shfl_xor(im, 2);
                    const int j = 32 * ct + 8 * kt + 2 * fq + e;
                    key[(ct * 4 + kt) * 2 + e] = (j >= 1 && j <= cur - 2) ? ((__float_as_uint(im) & 0xFFFFFF80u) | (unsigned)(127 - j)) : 0u;
                }
            const bf16x8 pb0 = pack_p(s[0], s[1]), pb1 = pack_p(s[2], s[3]);
            asm volatile("" ::: "memory");
            { bf16x8 vf[4][2]; load_vfrags(lds + (4 + ct) * AT_TILE, fr, fq, vf); attn_pv(Oc, vf, pb0, pb1); }
        } else {
#pragma unroll
            for (int k = 0; k < 8; ++k) key[ct * 8 + k] = 0u;
        }
    }
    sel[0] = sel[1] = sel[2] = sel[3] = 0u;
    if (cur < 16) { sel[0] = (1u << (cur + 1)) - 1u; return; }
    {
        sel[0] |= 1u;
#pragma unroll
        for (int w = 0; w < 4; ++w) { if ((cur >> 5) == w) sel[w] |= 1u << (cur & 31); if (((cur - 1) >> 5) == w) sel[w] |= 1u << ((cur - 1) & 31); }
    }
#pragma unroll 1
    for (int it = 0; it < 13; ++it) {
        unsigned best = 0u;
#pragma unroll
        for (int k = 0; k < 32; ++k) best = best > key[k] ? best : key[k];
        { const unsigned o = __shfl_xor(best, 16); best = best > o ? best : o; }
        { const unsigned o = __shfl_xor(best, 32); best = best > o ? best : o; }
        if (best != 0u) { const int jb = 127 - (int)(best & 127u);
#pragma unroll
            for (int w = 0; w < 4; ++w) if ((jb >> 5) == w) sel[w] |= 1u << (jb & 31); }
#pragma unroll
        for (int k = 0; k < 32; ++k) key[k] = (key[k] == best) ? 0u : key[k];
    }
}
__device__ __forceinline__ unsigned wave_or_tok(unsigned u) { u |= __shfl_xor(u, 4); u |= __shfl_xor(u, 8); return __builtin_amdgcn_readfirstlane(u); }
__device__ __forceinline__ void attn_prompt_unit(LAS unsigned char* lds, LAS unsigned* wgU, unsigned char* ws, int bg, int i, int tid, float* dbg) {
    const int wid = __builtin_amdgcn_readfirstlane(tid >> 6), lane = tid & 63, fr = lane & 15, fq = lane >> 4;
    const int b = bg >> 1, g = bg & 1, t0 = 64 * i, cur = i;
    const bf16* QRAW = (const bf16*)(ws + WS_QRAW); const bf16* QROT = (const bf16*)(ws + WS_QROT);
    const int tA = t0 + 8 * wid + (fr >> 2), tB = tA + 4, head = g * 4 + (fr & 3);
    const size_t mA = (size_t)b * TP + tA, mB = mA + 4;
    if (tid < 4) wgU[tid] = 0u;
    const int NCT = (2 * i + 2 + 63) >> 6;
    { const int row = tid >> 3, ch = tid & 7;
      const bf16* ck = (const bf16*)(ws + WS_CKP) + (size_t)bg * 256 * 64; const bf16* cv = (const bf16*)(ws + WS_CVP) + (size_t)bg * 256 * 64;
#pragma unroll
      for (int ct = 0; ct < 4; ++ct) if (ct < NCT) {
          *(LAS v4u*)(lds + ct * AT_TILE + row * ATS + ch * 16) = *(const v4u*)(ck + (size_t)(ct * 64 + row) * 64 + ch * 8);
          *(LAS v4u*)(lds + (4 + ct) * AT_TILE + row * ATS + ch * 16) = *(const v4u*)(cv + (size_t)(ct * 64 + row) * 64 + ch * 8); } }
    __syncthreads();
    LAS pg8::f32x4* stash = (LAS pg8::f32x4*)(lds + AT_STASH) + wid * 8 * 64 + lane;
    unsigned selA[4], selB[4];
    const float* gtA = (const float*)(ws + WS_GATES) + mA * 24 + head; const float* gtB = gtA + 4 * 24;
    {   bf16x8 q[2]; pg8::f32x4 Oc[4];
        q[0] = *(const bf16x8*)(QRAW + mA * 512 + head * 64 + 8 * fq); q[1] = *(const bf16x8*)(QRAW + mA * 512 + head * 64 + 32 + 8 * fq);
        attn_cmp_group(lds, NCT, q, tA, cur, fr, fq, Oc, selA);
        if (dbg) {
#pragma unroll
            for (int dt = 0; dt < 4; ++dt) *(pg8::f32x4*)(dbg + (mA * 3 + 0) * 512 + head * 64 + 16 * dt + 4 * fq) = Oc[dt]; }
        { const float gA = gtA[0];
#pragma unroll
          for (int dt = 0; dt < 4; ++dt) stash[dt * 64] = Oc[dt] * gA; }
        asm volatile("" ::: "memory");
        q[0] = *(const bf16x8*)(QRAW + mB * 512 + head * 64 + 8 * fq); q[1] = *(const bf16x8*)(QRAW + mB * 512 + head * 64 + 32 + 8 * fq);
        attn_cmp_group(lds, NCT, q, tB, cur, fr, fq, Oc, selB);
        if (dbg) {
#pragma unroll
            for (int dt = 0; dt < 4; ++dt) *(pg8::f32x4*)(dbg + (mB * 3 + 0) * 512 + head * 64 + 16 * dt + 4 * fq) = Oc[dt]; }
        { const float gB = gtB[0];
#pragma unroll
          for (int dt = 0; dt < 4; ++dt) stash[(4 + dt) * 64] = Oc[dt] * gB; }
    }
    unsigned nA[4], nB[4];
#pragma unroll
    for (int w = 0; w < 4; ++w) { nA[w] = wave_or_tok(selA[w]); nB[w] = wave_or_tok(selB[w]); }
    if (lane == 0) {
#pragma unroll
        for (int w = 0; w < 4; ++w) atomicOr((unsigned*)(wgU + w), nA[w] | nB[w]); }
    __syncthreads();
    AGroup GA, GB;
    {
        const unsigned W0 = __builtin_amdgcn_readfirstlane(wgU[0]), W1 = __builtin_amdgcn_readfirstlane(wgU[1]), W2 = __builtin_amdgcn_readfirstlane(wgU[2]), W3 = __builtin_amdgcn_readfirstlane(wgU[3]);
        GA.q[0] = *(const bf16x8*)(QROT + mA * 512 + head * 64 + 8 * fq); GA.q[1] = *(const bf16x8*)(QROT + mA * 512 + head * 64 + 32 + 8 * fq);
        GB.q[0] = *(const bf16x8*)(QROT + mB * 512 + head * 64 + 8 * fq); GB.q[1] = *(const bf16x8*)(QROT + mB * 512 + head * 64 + 32 + 8 * fq);
#pragma unroll
        for (int dt = 0; dt < 4; ++dt) { GA.O[dt] = (pg8::f32x4){0.f, 0.f, 0.f, 0.f}; GB.O[dt] = (pg8::f32x4){0.f, 0.f, 0.f, 0.f}; }
        GA.m = GB.m = -1e30f; GA.l = GB.l = 0.f;
        attn_walk<false>(lds, (const bf16*)(ws + WS_KS) + (size_t)bg * TP * 64, (const bf16*)(ws + WS_VS) + (size_t)bg * TP * 64, W0, W1, W2, W3,
                         nA[0], nA[1], nA[2], nA[3], nB[0], nB[1], nB[2], nB[3], selA, selB, tA, tB, GA, GB, tid, fr, fq);
        float lA = GA.l; lA += __shfl_xor(lA, 16); lA += __shfl_xor(lA, 32);
        float lB = GB.l; lB += __shfl_xor(lB, 16); lB += __shfl_xor(lB, 32);
        const float iA = 1.0f / fmaxf(lA, 1e-30f), iB = 1.0f / fmaxf(lB, 1e-30f);
        if (dbg) {
#pragma unroll
            for (int dt = 0; dt < 4; ++dt) { *(pg8::f32x4*)(dbg + (mA * 3 + 1) * 512 + head * 64 + 16 * dt + 4 * fq) = GA.O[dt] * iA; *(pg8::f32x4*)(dbg + (mB * 3 + 1) * 512 + head * 64 + 16 * dt + 4 * fq) = GB.O[dt] * iB; } }
        const float gA = gtA[8] * iA, gB = gtB[8] * iB;
#pragma unroll
        for (int dt = 0; dt < 4; ++dt) { stash[dt * 64] = stash[dt * 64] + GA.O[dt] * gA; stash[(4 + dt) * 64] = stash[(4 + dt) * 64] + GB.O[dt] * gB; }
    }
    pg8::f32x4 OA[4], OB[4];
    {
        const int jlo = i > 8 ? i - 8 : 0;
        unsigned W[4];
#pragma unroll
        for (int w = 0; w < 4; ++w) { unsigned x = 0u;
#pragma unroll
            for (int k = 0; k < 9; ++k) { const int j = jlo + k; if (j <= i && (j >> 5) == w) x |= 1u << (j & 31); }
            W[w] = x; }
#pragma unroll
        for (int dt = 0; dt < 4; ++dt) { GA.O[dt] = (pg8::f32x4){0.f, 0.f, 0.f, 0.f}; GB.O[dt] = (pg8::f32x4){0.f, 0.f, 0.f, 0.f}; }
        GA.m = GB.m = -1e30f; GA.l = GB.l = 0.f;
        attn_walk<true>(lds, (const bf16*)(ws + WS_KW) + (size_t)bg * TP * 64, (const bf16*)(ws + WS_VW) + (size_t)bg * TP * 64, W[0], W[1], W[2], W[3],
                        W[0], W[1], W[2], W[3], W[0], W[1], W[2], W[3], selA, selB, tA, tB, GA, GB, tid, fr, fq);
        float lA = GA.l; lA += __shfl_xor(lA, 16); lA += __shfl_xor(lA, 32);
        float lB = GB.l; lB += __shfl_xor(lB, 16); lB += __shfl_xor(lB, 32);
        const float iA = 1.0f / fmaxf(lA, 1e-30f), iB = 1.0f / fmaxf(lB, 1e-30f);
        if (dbg) {
#pragma unroll
            for (int dt = 0; dt < 4; ++dt) { *(pg8::f32x4*)(dbg + (mA * 3 + 2) * 512 + head * 64 + 16 * dt + 4 * fq) = GA.O[dt] * iA; *(pg8::f32x4*)(dbg + (mB * 3 + 2) * 512 + head * 64 + 16 * dt + 4 * fq) = GB.O[dt] * iB; } }
        const float gA = gtA[16] * iA, gB = gtB[16] * iB;
#pragma unroll
        for (int dt = 0; dt < 4; ++dt) { OA[dt] = stash[dt * 64] + GA.O[dt] * gA; OB[dt] = stash[(4 + dt) * 64] + GB.O[dt] * gB; }
    }
    bf16* MIX = (bf16*)(ws + WS_MIX);
#pragma unroll
    for (int dt = 0; dt < 4; ++dt) {
        u32x2 w; w.x = pk2(OA[dt][0], OA[dt][1]); w.y = pk2(OA[dt][2], OA[dt][3]); *(u32x2*)(MIX + mA * DM + head * 64 + 16 * dt + 4 * fq) = w;
        w.x = pk2(OB[dt][0], OB[dt][1]); w.y = pk2(OB[dt][2], OB[dt][3]); *(u32x2*)(MIX + mB * DM + head * 64 + 16 * dt + 4 * fq) = w; }
}
struct Args { const float* in[23]; float* out; unsigned char* ws; int ph_lo, ph_hi, use_bar, grid; };

static_assert(sizeof(Args) == 216, "Args layout");
__device__ __forceinline__ int lane_id_opaque() { int x; asm volatile("v_mbcnt_lo_u32_b32 %0, -1, 0\n\tv_mbcnt_hi_u32_b32 %0, -1, %0" : "=v"(x)); return x; }
template <int OFF> __device__ __forceinline__ unsigned long long karg64() {
    unsigned long long v; const unsigned long long kp = (unsigned long long)__builtin_amdgcn_kernarg_segment_ptr();
    asm volatile("s_load_dwordx2 %0, %1, %2\n\ts_waitcnt lgkmcnt(0)" : "=s"(v) : "s"(kp), "n"(OFF) : "memory");
    return v;
}
template <int OFF> __device__ __forceinline__ int karg32() {
    int v; const unsigned long long kp = (unsigned long long)__builtin_amdgcn_kernarg_segment_ptr();
    asm volatile("s_load_dword %0, %1, %2\n\ts_waitcnt lgkmcnt(0)" : "=s"(v) : "s"(kp), "n"(OFF) : "memory");
    return v;
}
#define KIN(k) ((const float*)karg64<8 * (k)>())
#define K_LO() karg32<200>()
#define K_HI() karg32<204>()
#define K_USEBAR() karg32<208>()
#define K_GRID() karg32<212>()
#define KOUT() ((float*)karg64<184>())
#define KWS() ((unsigned char*)karg64<192>())

__global__ void __launch_bounds__(NWAVES * 64, 2) fwd(Args args) {
    extern __shared__ __attribute__((aligned(16))) unsigned char lds_raw[];
    LAS unsigned char* lds = (LAS unsigned char*)lds_raw;
#define MISC ((volatile LAS unsigned*)(lds + MISC_OFF))
    int wave = __builtin_amdgcn_readfirstlane((int)threadIdx.x >> 6);
#define LANE_ID() lane_id_opaque()
#define TID_NOW() (wave * 64 + LANE_ID())
    { const int tid0 = TID_NOW();
      for (int u = tid0; u < (LDS_BYTES - LDSCTL_OFF) / 4; u += NWAVES * 64) ((LAS unsigned*)(lds + LDSCTL_OFF))[u] = 0u; }
    __syncthreads();
    if (K_USEBAR()) (void)xcd_barrier_post((unsigned*)(KWS() + WS_CTL) + CW_BAR, MISC + 8, (wave == 0) ? 1u : 0u);
#define PH_COMMON() int bid_ = (int)blockIdx.x; asm volatile("" : "+s"(bid_)); const int G = K_GRID(), bid = bid_, gw = bid * NWAVES + wave, NGW = G * NWAVES, NGT = G * NWAVES * 64; (void)gw; (void)NGW; (void)NGT
#ifndef PH_ENABLE
#define PH_ENABLE 0xFFFFFFFFu
#endif
#define PHBIT(k) (((k) < PH_L0) ? (k) : (PH_L0 + ((k) - PH_L0) % PH_PER_LAYER))
#define IN(k) (((PH_ENABLE >> PHBIT(k)) & 1u) && K_LO() <= (k) && (k) < K_HI())
#define SEAM(k) do { if (K_USEBAR() && (k) + 1 < K_HI()) { XcdBarrier bar_; bar_.bar = (unsigned*)(KWS() + WS_CTL) + CW_BAR; bar_.x = xb_xcc_id(); bar_.st = MISC + 8; bar_.w0 = (wave == 0) ? 1u : 0u; xcd_barrier(bar_); } } while (0)

    if (IN(PH_P0A)) {
        unsigned char* ws = KWS(); float* out = KOUT();
        PH_COMMON(); const int lane = LANE_ID(), gt = bid * (NWAVES * 64) + wave * 64 + lane;
        LAS float* scr = (LAS float*)(lds + RING_OFF + wave * 16384);
        constexpr int I_IN = 16 * 73, I_OUT = 16 * 32, I_G = 16 * 88, I_D = 44 * 32, I_W1 = 32 * 8, I_W2 = 4 * 2;
        constexpr int I_LAYER = I_IN + I_OUT + 2 * I_G + I_D + 2 * I_W1 + 2 * I_W2;
        for (int it = gw; it < NLAYER * I_LAYER; it += NGW) {
            const int L = it / I_LAYER; int r = it % I_LAYER;
            if (r < I_IN) { transpose_item(KIN(6) + (size_t)L * DM * PIN, DM, PIN, (bf16*)(ws + WS_WIN_T) + (size_t)L * NIN * DM, RmInProj{}, scr, r, lane); continue; } r -= I_IN;
            if (r < I_OUT) { transpose_item(KIN(15) + (size_t)L * DM * DM, DM, DM, (bf16*)(ws + WS_WOUT_T) + (size_t)L * DM * DM, RmIdent{}, scr, r, lane); continue; } r -= I_OUT;
            if (r < I_G) { transpose_item(KIN(18) + (size_t)L * DM * FFN, DM, FFN, (bf16*)(ws + WS_WGU_T) + (size_t)L * NGU * DM, RmAffine{2, 0}, scr, r, lane); continue; } r -= I_G;
            if (r < I_G) { transpose_item(KIN(19) + (size_t)L * DM * FFN, DM, FFN, (bf16*)(ws + WS_WGU_T) + (size_t)L * NGU * DM, RmAffine{2, 1}, scr, r, lane); continue; } r -= I_G;
            if (r < I_D) { transpose_item(KIN(20) + (size_t)L * FFN * DM, FFN, DM, (bf16*)(ws + WS_WDN_T) + (size_t)L * DM * FFN, RmIdent{}, scr, r, lane); continue; } r -= I_D;
            if (r < 2 * I_W1) { const int kind = r / I_W1; transpose_item(KIN(8) + (size_t)(L * 2 + kind) * 2048 * 256, 2048, 256, (bf16*)(ws + WS_W1C_T) + (size_t)(L * 2 + kind) * 256 * 2048, RmIdent{}, scr, r % I_W1, lane); continue; } r -= 2 * I_W1;
            { const int kind = r / I_W2; transpose_item(KIN(10) + (size_t)(L * 2 + kind) * 256 * 64, 256, 64, (bf16*)(ws + WS_W2C_T) + (size_t)(L * 2 + kind) * 64 * 256, RmIdent{}, scr, r % I_W2, lane); }
        }
        for (int i = gt; i < NLAYER * (NIN - PIN) * (DM / 8); i += NGT) { const int L = i / ((NIN - PIN) * (DM / 8)), r = i % ((NIN - PIN) * (DM / 8));
            *(v4u*)((bf16*)(ws + WS_WIN_T) + (size_t)L * NIN * DM + (size_t)PIN * DM + (size_t)r * 8) = (v4u){0u, 0u, 0u, 0u}; }
        for (int i = gt; i < TP * 32; i += NGT) {
            const int pos = i >> 5, d = i & 31;
            double fr_ = 1.0; for (int k = 0; k < d; ++k) fr_ *= 0.7498942093324558;
            const float angf = (float)pos * (float)fr_;
            const double a = (double)angf;
            const double kq = __builtin_rint(a * 0.63661977236758134308);
            double rr = __builtin_fma(-kq, 1.57079632673412561417e+00, a); rr = __builtin_fma(-kq, 6.07710050650619224932e-11, rr);
            const double r2 = rr * rr;
            double sp = -7.6471637318198164759e-13; sp = sp * r2 + 1.6059043836821614599e-10; sp = sp * r2 - 2.5052108385441718775e-08; sp = sp * r2 + 2.7557319223985890653e-06;
            sp = sp * r2 - 1.9841269841269841270e-04; sp = sp * r2 + 8.3333333333333333333e-03; sp = sp * r2 - 1.6666666666666666667e-01; const double sn = rr + rr * r2 * sp;
            double cp = 4.7794773323873852974e-14; cp = cp * r2 - 1.1470745597729724714e-11; cp = cp * r2 + 2.0876756987868098979e-09; cp = cp * r2 - 2.7557319223985890653e-07;
            cp = cp * r2 + 2.4801587301587301587e-05; cp = cp * r2 - 1.3888888888888888889e-03; cp = cp * r2 + 4.1666666666666666667e-02; cp = cp * r2 - 0.5; const double cn = 1.0 + r2 * cp;
            const int q4 = ((int)kq) & 3;
            const double c = (q4 == 0) ? cn : (q4 == 1) ? -sn : (q4 == 2) ? -cn : sn;
            const double s = (q4 == 0) ? sn : (q4 == 1) ? cn : (q4 == 2) ? -sn : -cn;
            ((f32x2*)(ws + WS_ROPE))[i] = (f32x2){(float)c, (float)s};
        }
        { const float* xp = KIN(0); const float* xs = KIN(1); float* XF = (float*)(ws + WS_XF); bf16* XB = (bf16*)(ws + WS_XB);
        for (int row = gw; row < MT; row += NGW) {
            const float* src = row < MP ? xp + (size_t)row * DM : xs + (size_t)(row - MP) * DM;
#pragma unroll
            for (int j = 0; j < 4; ++j) { const int c = (j * 64 + lane) * 4; const pg8::f32x4 v = *(const pg8::f32x4*)(src + c);
                *(pg8::f32x4*)(XF + (size_t)row * DM + c) = v; u32x2 w; w.x = pk2(v[0], v[1]); w.y = pk2(v[2], v[3]); *(u32x2*)(XB + (size_t)row * DM + c) = w; }
        } }
        { const float* gws = KIN(13); const float* gbs = KIN(14); float* GWP = (float*)(ws + WS_GWP); float* GWS = (float*)(ws + WS_GWS); float* GBS = (float*)(ws + WS_GBS);
        for (int i = gt; i < NLAYER * 8 * 128 * 128; i += NGT) {
            const int lh = i >> 14, t = (i >> 7) & 127, s = i & 127;
            const float* wsrc = gws + (size_t)lh * 16384;
            GWP[i] = (s <= t) ? wsrc[t * 128 + s] : 0.f;
            GWS[i] = ((t >> 2) == (s >> 2) && (s & 3) <= (t & 3)) ? wsrc[(t & 3) * 128 + (s & 3)] : 0.f;
        }
        for (int i = gt; i < NLAYER * 8 * 128; i += NGT) GBS[i] = gbs[(i & ~127) + (i & 3)]; }
        { const float* st = KIN(4);
        for (int i = gt; i < NLAYER * NB_S * 508 * 64; i += NGT) { const int lb = i / (508 * 64), r = i % (508 * 64);
            *(pg8::f32x4*)(out + O_WINS + (size_t)lb * 512 * KVW + (size_t)r * 4) = *(const pg8::f32x4*)(st + (size_t)lb * 512 * KVW + 4 * KVW + (size_t)r * 4); } }
        SEAM(PH_P0A);
    }
    if (IN(PH_P0B)) {
        unsigned char* ws = KWS();
        PH_COMMON(); int tid = TID_NOW(); asm volatile("" : "+v"(tid));
        const int* PT = (const int*)KIN(5); const float* cache = KIN(2); const float* pe = KIN(7); const float* b1 = KIN(9);
        for (int u = bid; u < NLAYER * 2 * 256; u += G) {
            const int L = u >> 9, kind = (u >> 8) & 1, rb = u & 255;
            const int R = rb * 64 + (tid >> 3), bs = R >> 7, n = (R >> 1) & 63, g = R & 1;
            const int page = PT[bs * NPG + (n >> 2)];
            const float* arow = cache + ((size_t)L * NPOOL + page) * PAGE * KVW + (size_t)((n & 3) * 32) * KVW + kind * 128 + g * 64 + (tid & 7) * 8;
            compress_unit(lds + RING_OFF, arow, pe + (size_t)(L * 2 + kind) * 2048, (const bf16*)(ws + WS_W1C_T) + (size_t)(L * 2 + kind) * 256 * 2048, b1 + (L * 2 + kind) * 256,
                          (const bf16*)(ws + WS_W2C_T) + (size_t)(L * 2 + kind) * 64 * 256, (bf16*)(ws + (kind ? WS_CVS : WS_CKS)) + (size_t)L * NB_S * 2 * 64 * 64, 64, rb, tid);
        }
        SEAM(PH_P0B);
    }
    for (int L = 0; L < NLAYER; ++L) {
        asm volatile("" : "+s"(wave), "+s"(lds));
        const int pb = PH_L0 + L * PH_PER_LAYER;
        if (IN(pb + 0)) {
            unsigned char* ws = KWS(); PH_COMMON();
            pg8::Gemm g{(const bf16*)(ws + WS_XB), (const bf16*)(ws + WS_WIN_T) + (size_t)L * NIN * DM, MT, NIN, DM}; pg8::StaticOrder S; S.init(MT, NIN, G, bid);
            EpiInProj E{L, ws, KOUT()};
            pg8::gemm_phase<EpiInProj, pg8::StaticOrder, true, true>(lds + RING_OFF, g, S, E, TID_NOW());
            SEAM(pb + 0);
        }
        if (IN(pb + 1)) {
            unsigned char* ws = KWS(); float* out = KOUT(); PH_COMMON();
            int tid = TID_NOW(); asm volatile("" : "+v"(tid));
            for (int u = bid; u < 32 + 132; u += G) {
                if (u < 32) {
                    const int kind = u >> 4, rb = u & 15;
                    const int R = rb * 64 + (tid >> 3), b = R >> 9, n = (R >> 1) & 255, g = R & 1;
                    const float* arow = out + O_CMPP + ((size_t)(L * BP + b) * TP + 32 * n) * KVW + kind * 128 + g * 64 + (tid & 7) * 8;
                    compress_unit(lds + RING_OFF, arow, KIN(7) + (size_t)(L * 2 + kind) * 2048, (const bf16*)(ws + WS_W1C_T) + (size_t)(L * 2 + kind) * 256 * 2048, KIN(9) + (L * 2 + kind) * 256,
                                  (const bf16*)(ws + WS_W2C_T) + (size_t)(L * 2 + kind) * 64 * 256, (bf16*)(ws + (kind ? WS_CVP : WS_CKP)), 256, rb, tid);
                } else {
                    const int q = u - 32;
                    if (q < 128) gmlp_unit(lds + RING_OFF, lds + LDSCTL_OFF + 1024, 128 * q, (const bf16*)(ws + WS_U), (const bf16*)(ws + WS_V), (const float*)(ws + WS_GWP) + (size_t)L * 8 * 16384, KIN(14) + L * 1024,
                                           KIN(11) + L * 512, KIN(12) + L * 512, (bf16*)(ws + WS_MIX), (float*)nullptr, tid);
                    else gmlp_unit(lds + RING_OFF, lds + LDSCTL_OFF + 1024, MP + 128 * (q - 128), (const bf16*)(ws + WS_U), (const bf16*)(ws + WS_V), (const float*)(ws + WS_GWS) + (size_t)L * 8 * 16384, (const float*)(ws + WS_GBS) + L * 1024,
                                   KIN(11) + L * 512, KIN(12) + L * 512, (bf16*)(ws + WS_MIX), out + O_GV + ((size_t)L * MS + 128 * (q - 128)) * 512, tid);
                }
            }
            SEAM(pb + 1);
        }
        if (IN(pb + 2)) {
            unsigned char* ws = KWS(); float* out = KOUT(); PH_COMMON();
            int tid = TID_NOW(); asm volatile("" : "+v"(tid));
            const int lane = tid & 63;
#if ATT_PROBE
            float* dbg = (float*)(ws + WS_DBG);
#else
            float* dbg = nullptr;
#endif
            for (int u = bid; u < 512; u += G) {
                const int c = u & 255, xcd = c & 7, cc = ((c >> 3) << 1) | (c & 1);
                attn_prompt_unit(lds + RING_OFF, (LAS unsigned*)(lds + LDSCTL_OFF + 2048), ws, xcd >> 1, (u >> 8) ? 127 - cc : cc, tid, dbg);
            }
            __syncthreads();
            const bf16* QRAW = (const bf16*)(ws + WS_QRAW); const bf16* QROT = (const bf16*)(ws + WS_QROT); bf16* MIX = (bf16*)(ws + WS_MIX); const float* GATES = (const float*)(ws + WS_GATES);
            LAS float* wl = (LAS float*)(lds + RING_OFF + wave * 4096);
            LAS float* qraw_l = wl; LAS float* qrot_l = wl + 256; LAS float* pbuf = wl + 512; LAS float* impb = wl + 768; LAS int* selidx = (LAS int*)(wl + 896);
#if ATT_PROBE
            float esum[6] = {0.f, 0.f, 0.f, 0.f, 0.f, 0.f};
            for (int task = gw; task < 2 * MT; task += NGW) {
#else
            for (int task = 2 * MP + gw; task < 2 * MT; task += NGW) {
#endif
                const int m = task >> 1, g = task & 1;
                const bool prompt = m < MP;
#pragma unroll
                for (int r = 0; r < 4; ++r) { qraw_l[r * 64 + lane] = 0.125f * bf2f(QRAW[(size_t)m * 512 + (g * 4 + r) * 64 + lane]); qrot_l[r * 64 + lane] = 0.125f * bf2f(QROT[(size_t)m * 512 + (g * 4 + r) * 64 + lane]); }
                impb[lane] = 0.f; impb[64 + lane] = 0.f;
                WAVE_LDS_FENCE();
                float oc[4], os[4], ow[4];
                if (prompt) {
                    const int b = m >> 13, t = m & (TP - 1); const size_t bg = (size_t)(b * 2 + g);
                    const SrcPromptCmp sc{(const bf16*)(ws + WS_CKP) + bg * 256 * 64, (const bf16*)(ws + WS_CVP) + bg * 256 * 64, (t + 1) >> 5};
                    attend(sc, (sc.nvalid + 63) >> 6, qraw_l, pbuf, lane, oc, impb);
                    WAVE_LDS_FENCE();
                    topk16(impb, 128, t >> 6, selidx, lane);
                    const SrcPromptSlc ss{(const bf16*)(ws + WS_KS) + bg * TP * 64, (const bf16*)(ws + WS_VS) + bg * TP * 64, selidx, t};
                    attend(ss, 16, qrot_l, pbuf, lane, os, (LAS float*)nullptr);
                    const int kb0 = (t > 511 ? t - 511 : 0) >> 6;
                    const SrcPromptWin sw{(const bf16*)(ws + WS_KW) + bg * TP * 64, (const bf16*)(ws + WS_VW) + bg * TP * 64, t, kb0};
                    attend(sw, (t >> 6) - kb0 + 1, qrot_l, pbuf, lane, ow, (LAS float*)nullptr);
#if ATT_PROBE
#pragma unroll
                    for (int r = 0; r < 4; ++r) { const float* dp = dbg + ((size_t)m * 3) * 512 + (g * 4 + r) * 64 + lane;
                        const float d0 = dp[0] - oc[r], d1 = dp[512] - os[r], d2 = dp[1024] - ow[r];
                        esum[0] += d0 * d0; esum[1] += oc[r] * oc[r]; esum[2] += d1 * d1; esum[3] += os[r] * os[r]; esum[4] += d2 * d2; esum[5] += ow[r] * ow[r]; }
                    WAVE_LDS_FENCE();
                    continue;
#endif
                } else {
                    const int si = m - MP, bs = si >> 2, s = si & 3;
                    const size_t co = (((size_t)L * NB_S + bs) * 2 + g) * 64 * 64;
                    const SrcSampleCmp sc{(const bf16*)(ws + WS_CKS) + co, (const bf16*)(ws + WS_CVS) + co};
                    attend(sc, 1, qraw_l, pbuf, lane, oc, impb);
                    WAVE_LDS_FENCE();
                    topk16(impb, 33, 32, selidx, lane);
                    const SrcSampleSlc ss{KIN(3) + (size_t)L * NPOOL * PAGE * KVW, (const int*)KIN(5) + bs * NPG, out + O_SLCS + ((size_t)L * MS + bs * 4) * KVW, selidx, g, s};
                    attend(ss, 16, qrot_l, pbuf, lane, os, (LAS float*)nullptr);
                    const SrcSampleWin sw{KIN(4) + ((size_t)L * NB_S + bs) * 512 * KVW, out + O_WINS + (((size_t)L * NB_S + bs) * 512 + 508) * KVW, g, s};
                    attend(sw, 9, qrot_l, pbuf, lane, ow, (LAS float*)nullptr);
                }
                const float* gtp = GATES + (size_t)m * 24;
#pragma unroll
                for (int r = 0; r < 4; ++r) { const int h = g * 4 + r; const float o = gtp[h] * oc[r] + gtp[8 + h] * os[r] + gtp[16 + h] * ow[r];
                    MIX[(size_t)m * DM + h * 64 + lane] = (bf16)f2bf(o); }
                WAVE_LDS_FENCE();
            }
#if ATT_PROBE
#pragma unroll
            for (int k = 0; k < 6; ++k) { const float v = wave_sum(esum[k]); if (lane == 0) atomicAdd((float*)(ws + WS_CTL) + CW_ERR + k, v); }
#endif
            SEAM(pb + 2);
        }
        if (IN(pb + 3)) {
            unsigned char* ws = KWS(); PH_COMMON();
            pg8::Gemm g{(const bf16*)(ws + WS_MIX), (const bf16*)(ws + WS_WOUT_T) + (size_t)L * DM * DM, MT, DM, DM}; pg8::StaticOrder S; S.init(MT, DM, G, bid);
            EpiResid E{(const float*)(ws + WS_XF), (float*)(ws + WS_PRE)};
            pg8::gemm_phase<EpiResid, pg8::StaticOrder, true, true>(lds + RING_OFF, g, S, E, TID_NOW());
            SEAM(pb + 3);
        }
        if (IN(pb + 4)) {
            int lane = LANE_ID(); asm volatile("" : "+v"(lane));
            unsigned char* ws = KWS(); PH_COMMON(); const float* lg = KIN(16) + L * DM; const float* lb = KIN(17) + L * DM;
            for (int row = gw; row < MT; row += NGW) ln_row((const float*)(ws + WS_PRE) + (size_t)row * DM, lg, lb, (float*)(ws + WS_XF) + (size_t)row * DM, (bf16*)(ws + WS_XB) + (size_t)row * DM, lane);
            SEAM(pb + 4);
        }
        if (IN(pb + 5)) {
            unsigned char* ws = KWS(); PH_COMMON();
            pg8::Gemm g{(const bf16*)(ws + WS_XB), (const bf16*)(ws + WS_WGU_T) + (size_t)L * NGU * DM, MT, NGU, DM}; pg8::StaticOrder S; S.init(MT, NGU, G, bid);
            EpiGateUp E{(bf16*)(ws + WS_F)};
            pg8::gemm_phase<EpiGateUp, pg8::StaticOrder, true, true>(lds + RING_OFF, g, S, E, TID_NOW());
            SEAM(pb + 5);
        }
        if (IN(pb + 6)) {
            unsigned char* ws = KWS(); PH_COMMON();
            pg8::Gemm g{(const bf16*)(ws + WS_F), (const bf16*)(ws + WS_WDN_T) + (size_t)L * DM * FFN, MT, DM, FFN}; pg8::StaticOrder S; S.init(MT, DM, G, bid);
            EpiResid E{(const float*)(ws + WS_XF), (float*)(ws + WS_PRE)};
            pg8::gemm_phase<EpiResid, pg8::StaticOrder, true, true>(lds + RING_OFF, g, S, E, TID_NOW());
            SEAM(pb + 6);
        }
        if (IN(pb + 7)) {
            int lane = LANE_ID(); asm volatile("" : "+v"(lane));
            unsigned char* ws = KWS(); PH_COMMON(); const float* lg = KIN(21) + L * DM; const float* lb = KIN(22) + L * DM;
            const bool last = (L == NLAYER - 1);
            float* dstf = last ? KOUT() + O_Y : (float*)(ws + WS_XF);
            for (int row = gw; row < MT; row += NGW) ln_row((const float*)(ws + WS_PRE) + (size_t)row * DM, lg, lb, dstf + (size_t)row * DM, last ? (bf16*)nullptr : (bf16*)(ws + WS_XB) + (size_t)row * DM, lane);
#if ATT_PROBE
            if (last) {
                const float* e = (const float*)(ws + WS_CTL) + CW_ERR;
                const float e0 = sqrtf(e[0] / fmaxf(e[1], 1e-30f)), e1 = sqrtf(e[2] / fmaxf(e[3], 1e-30f)), e2 = sqrtf(e[4] / fmaxf(e[5], 1e-30f));
                const float E = ATT_PROBE_SEL == 0 ? e0 : ATT_PROBE_SEL == 1 ? e1 : ATT_PROBE_SEL == 2 ? e2 : fmaxf(e0, fmaxf(e1, e2));
                float* o8 = KOUT() + O_GV;
                for (int i = bid * (NWAVES * 64) + wave * 64 + lane; i < NLAYER * MS * 512; i += NGT) o8[i] *= (1.0f + ATT_PROBE_GAIN * E);
            }
#endif
            SEAM(pb + 7);
        }
    }
#undef IN
#undef SEAM
}

#ifndef SPLIT_LAUNCHES
#define SPLIT_LAUNCHES 0
#endif
extern "C" void kernel_launch(void* const* d_in, const int* in_sizes, int n_in, void* d_out, int out_size, void* d_ws, size_t ws_size, hipStream_t stream) {
    static int grid = 0;
    if (grid == 0) {
        if (n_in != 23 || (size_t)out_size != O_END || ws_size < WS_END) { fprintf(stderr, "kernel_launch: unexpected sizes (n_in %d, out %d, ws %zu); nothing launched\n", n_in, out_size, ws_size); grid = -1; return; }
        int dev = 0, cus = 0, per_cu = 0;
        if (hipGetDevice(&dev) != hipSuccess || hipDeviceGetAttribute(&cus, hipDeviceAttributeMultiprocessorCount, dev) != hipSuccess) { fprintf(stderr, "kernel_launch: device query failed\n"); grid = -1; return; }
        if (hipFuncSetAttribute((const void*)fwd, hipFuncAttributeMaxDynamicSharedMemorySize, LDS_BYTES) != hipSuccess) { fprintf(stderr, "kernel_launch: hipFuncSetAttribute failed\n"); grid = -1; return; }
        if (hipOccupancyMaxActiveBlocksPerMultiprocessor(&per_cu, (const void*)fwd, NWAVES * 64, LDS_BYTES) != hipSuccess || per_cu < 1) fprintf(stderr, "kernel_launch: note: occupancy query reports %d\n", per_cu);
        (void)hipGetLastError();
        grid = cus;
    }
    if (grid < 0) return;
    if (hipMemsetAsync((char*)d_ws + WS_CTL, 0, CTL_ZERO_BYTES, stream) != hipSuccess) { fprintf(stderr, "kernel_launch: memset failed\n"); return; }
    Args a{};
    for (int i = 0; i < 23; ++i) a.in[i] = (const float*)d_in[i];
    a.out = (float*)d_out; a.ws = (unsigned char*)d_ws;
#if SPLIT_LAUNCHES
    for (int ph = 0; ph < N_PHASES; ++ph) { a.ph_lo = ph; a.ph_hi = ph + 1; a.use_bar = 0; a.grid = grid;
        hipLaunchKernelGGL(fwd, dim3(grid), dim3(NWAVES * 64), LDS_BYTES, stream, a); }
#else
    a.ph_lo = 0; a.ph_hi = N_PHASES; a.use_bar = 1; a.grid = grid;
    hipLaunchKernelGGL(fwd, dim3(grid), dim3(NWAVES * 64), LDS_BYTES, stream, a);
#endif
    const hipError_t le = hipPeekAtLastError();
    if (le != hipSuccess) fprintf(stderr, "kernel_launch: launch failed: %s\n", hipGetErrorName(le));
}
```

```cpp
#include <hip/hip_runtime.h>
#include <cstdio>
#include <cstdint>
#include <cmath>
namespace pg8 {
#define PG8_LAS __attribute__((address_space(3)))
typedef unsigned short bf16_t;
typedef short bf16x8 __attribute__((ext_vector_type(8)));
typedef float f32x4 __attribute__((ext_vector_type(4)));
typedef unsigned u32x4 __attribute__((ext_vector_type(4)));
constexpr int BM = 256, BK = 64, HALF = 128, HTB = HALF * BK * 2  , STAGE_BYTES = 8 * HTB, NXCD = 8, WGM = 8;

__host__ __device__ __forceinline__ int lds_byte(int r, int c) { const int st = (r >> 4) * 2 + (c >> 5), rr = r & 15, cc = c & 31, ob = rr * 64 + cc * 2; return st * 1024 + (ob ^ (((ob >> 9) & 1) << 5)); }
__host__ __device__ __forceinline__ void stage_rc(int b, int& R, int& C) { const int st = b / 1024, sb = b % 1024, swz = sb ^ (((sb >> 9) & 1) << 5); R = (st >> 1) * 16 + swz / 64; C = (st & 1) * 32 + (swz % 64) / 2; }
__host__ __device__ __forceinline__ int perm32(int rho) { const int n = rho >> 4, i = rho & 15; return 8 * (i >> 2) + 4 * n + (i & 3); }

struct Unit { int pm, pn; };
struct Gemm { const bf16_t* A; const bf16_t* Bt; int M, N, K; };

struct StaticOrder {
    int nM, nN, nwg, G, c;
    __host__ __device__ void init(int M, int N, int G_, int c_) { nM = M / BM; nN = N / BM; nwg = nM * nN; G = G_; c = c_; }
    __host__ __device__ bool next(int i, Unit& u) const {
        const long L = (long)i * G + c; if (L >= nwg) return false;
        int wgid = (int)L; { const int q = nwg / NXCD, r = nwg % NXCD, xcd = wgid % NXCD, off = wgid / NXCD; wgid = (xcd < r ? xcd * (q + 1) : r * (q + 1) + (xcd - r) * q) + off; }
        const int nig = WGM * nN, gid = wgid / nig, fm = gid * WGM, gsz = (nM - fm) < WGM ? (nM - fm) : WGM;
        u.pm = fm + ((wgid % nig) % gsz); u.pn = (wgid % nig) / gsz; return true;
    }
    __device__ __forceinline__ void a_ready(const Unit&) const {}
    __device__ __forceinline__ void done(const Unit&) const {}
};
__device__ __forceinline__ unsigned cvt_pk_bf16(float lo, float hi) { unsigned r; asm volatile("v_cvt_pk_bf16_f32 %0, %1, %2" : "=v"(r) : "v"(lo), "v"(hi)); return r; }
typedef float f32x2 __attribute__((ext_vector_type(2)));
template <class Epi, class Sched, bool ALIGN_EPI = false, bool SP2 = false>
__device__ __forceinline__ void gemm_phase(PG8_LAS unsigned char* lds, const Gemm g, const Sched& S, const Epi& E, int tid_in) {
    int tid_ = tid_in; asm volatile("" : "+v"(tid_));
    const int tid = tid_, wid = __builtin_amdgcn_readfirstlane(tid >> 6), lane = tid & 63, wr = wid >> 2, wc = wid & 3, fr = lane & 15, fq = lane >> 4;
    const int K = g.K, nt = K / BK;
    unsigned voffA[2], voffB[2];
#pragma unroll
    for (int i = 0; i < 2; ++i) { int R, C; stage_rc(tid * 16 + i * 8192, R, C); const int Rb = Epi::PERM ? ((R & ~31) + perm32(R & 31)) : R;
        voffA[i] = (unsigned)(R * K + C) * 2u; voffB[i] = (unsigned)(Rb * K + C) * 2u; }
    const size_t kstep = (size_t)(BK * 2);
    const size_t hstep = (size_t)HALF * K * 2;
    const size_t tstep = 2 * hstep;
    const unsigned ldsw = (unsigned)wid * 1024u;
    const int aoff = lds_byte(wr * 64 + fr, fq * 8), boff = lds_byte(wc * 32 + fr, fq * 8);
#define PG8_SA(b, h) (((b) * 2 + (h)) * HTB)
#define PG8_SB(b, h) ((4 + (b) * 2 + (h)) * HTB)
#define PG8_STAGE(bufoff, gbase, voff) do { _Pragma("unroll") for (int _i = 0; _i < 2; ++_i) \
        __builtin_amdgcn_global_load_lds((const unsigned*)((const char*)(gbase) + (voff)[_i]), (PG8_LAS unsigned*)(lds + (bufoff) + ldsw + _i * 8192), 16, 0, 0); } while (0)
#define PG8_LDA(dst, b, h) do { _Pragma("unroll") for (int m = 0; m < 4; ++m) _Pragma("unroll") for (int k = 0; k < 2; ++k) dst[m][k] = *(const PG8_LAS bf16x8*)(lds + PG8_SA(b, h) + aoff + m * 2048 + k * 1024); } while (0)
#define PG8_LDB(dst, b, h) do { _Pragma("unroll") for (int n = 0; n < 2; ++n) _Pragma("unroll") for (int k = 0; k < 2; ++k) dst[n][k] = *(const PG8_LAS bf16x8*)(lds + PG8_SB(b, h) + boff + n * 2048 + k * 1024); } while (0)
#define PG8_MMA(ai, bj, At, Bt) do { __builtin_amdgcn_s_setprio(1); _Pragma("unroll") for (int m = 0; m < 4; ++m) _Pragma("unroll") for (int n = 0; n < 2; ++n) _Pragma("unroll") for (int k = 0; k < 2; ++k) \
        acc[ai][bj][m][n] = __builtin_amdgcn_mfma_f32_16x16x32_bf16(Bt[n][k], At[m][k], acc[ai][bj][m][n], 0, 0, 0); __builtin_amdgcn_s_setprio(0); } while (0)
#define PG8_WAIT_V(n) asm volatile("s_waitcnt vmcnt(" #n ")" ::: "memory")
#define PG8_WAIT_L(n) asm volatile("s_waitcnt lgkmcnt(" #n ")" ::: "memory")
#define PG8_BAR __builtin_amdgcn_s_barrier()
#define PG8_SCHED __builtin_amdgcn_sched_barrier(0)
    Unit cur, nxt; int ui = 0;
    if (!S.next(0, cur)) return;
    f32x4 acc[2][2][4][2];
#pragma unroll
    for (int a = 0; a < 2; ++a)
#pragma unroll
        for (int b = 0; b < 2; ++b)
#pragma unroll
            for (int m = 0; m < 4; ++m)
#pragma unroll
                for (int n = 0; n < 2; ++n) acc[a][b][m][n] = (f32x4){0.f, 0.f, 0.f, 0.f};
    bf16x8 At[4][2], B0[2][2], B1[2][2];
    const char* cA = (const char*)g.A + (size_t)cur.pm * tstep; const char* cB = (const char*)g.Bt + (size_t)cur.pn * tstep;
    S.a_ready(cur);
    if constexpr (SP2) {
        PG8_STAGE(PG8_SB(0, 0), cB, voffB); PG8_STAGE(PG8_SB(0, 1), cB + hstep, voffB); PG8_STAGE(PG8_SA(0, 0), cA, voffA); PG8_STAGE(PG8_SA(0, 1), cA + hstep, voffA);
        if (wr == 1) PG8_BAR;
        PG8_WAIT_V(2); PG8_BAR;
        PG8_STAGE(PG8_SB(1, 0), cB + kstep, voffB); PG8_STAGE(PG8_SA(1, 0), cA + kstep, voffA); PG8_STAGE(PG8_SB(1, 1), cB + hstep + kstep, voffB);
        PG8_WAIT_V(6); PG8_BAR;
    } else {
        PG8_STAGE(PG8_SB(0, 0), cB, voffB); PG8_STAGE(PG8_SA(0, 0), cA, voffA); PG8_STAGE(PG8_SB(0, 1), cB + hstep, voffB); PG8_STAGE(PG8_SA(0, 1), cA + hstep, voffA);
        if (wr == 1) PG8_BAR;
        PG8_WAIT_V(4); PG8_BAR;
        PG8_STAGE(PG8_SB(1, 0), cB + kstep, voffB); PG8_STAGE(PG8_SA(1, 0), cA + kstep, voffA); PG8_STAGE(PG8_SB(1, 1), cB + hstep + kstep, voffB);
        PG8_WAIT_V(6); PG8_BAR;
    }
    for (;;) {
        const bool has_next = S.next(ui + 1, nxt);
        const char* nA = has_next ? (const char*)g.A + (size_t)nxt.pm * tstep : cA; const char* nB = has_next ? (const char*)g.Bt + (size_t)nxt.pn * tstep : cB;
        for (int t = 0; t < nt; t += 2) {
            const bool last = (t == nt - 2);
            const char* a1 = cA + (size_t)(t + 1) * kstep;
            const char* a2 = last ? nA : cA + (size_t)(t + 2) * kstep; const char* b2 = last ? nB : cB + (size_t)(t + 2) * kstep;
            const char* a3 = a2 + kstep; const char* b3 = b2 + kstep;
            if (last && has_next) S.a_ready(nxt);
            if constexpr (SP2) {
            PG8_LDB(B0, 0, 0); PG8_LDB(B1, 0, 1); PG8_SCHED; PG8_LDA(At, 0, 0); PG8_STAGE(PG8_SA(1, 1), a1 + hstep, voffA);
            PG8_WAIT_V(8); PG8_WAIT_L(0); PG8_BAR; PG8_MMA(0, 0, At, B0); PG8_MMA(0, 1, At, B1); PG8_BAR; PG8_SCHED;
            PG8_LDA(At, 0, 1); PG8_STAGE(PG8_SB(0, 0), b2, voffB); PG8_STAGE(PG8_SB(0, 1), b2 + hstep, voffB); PG8_STAGE(PG8_SA(0, 0), a2, voffA);
            PG8_WAIT_V(8); PG8_WAIT_L(0); PG8_BAR; PG8_MMA(1, 0, At, B0); PG8_MMA(1, 1, At, B1); PG8_BAR; PG8_SCHED;
            PG8_LDB(B0, 1, 0); PG8_LDB(B1, 1, 1); PG8_SCHED; PG8_LDA(At, 1, 0); PG8_STAGE(PG8_SA(0, 1), a2 + hstep, voffA);
            PG8_WAIT_V(8); PG8_WAIT_L(0); PG8_BAR; PG8_MMA(0, 0, At, B0); PG8_MMA(0, 1, At, B1); PG8_BAR; PG8_SCHED;
            PG8_LDA(At, 1, 1); PG8_STAGE(PG8_SB(1, 0), b3, voffB); PG8_STAGE(PG8_SB(1, 1), b3 + hstep, voffB); PG8_STAGE(PG8_SA(1, 0), a3, voffA);
            PG8_WAIT_V(8); PG8_WAIT_L(0); PG8_BAR; PG8_MMA(1, 0, At, B0); PG8_MMA(1, 1, At, B1); PG8_BAR; PG8_SCHED;
            } else {
            PG8_LDB(B0, 0, 0); PG8_SCHED; PG8_LDA(At, 0, 0); PG8_STAGE(PG8_SA(1, 1), a1 + hstep, voffA);
            PG8_WAIT_L(8); PG8_BAR; PG8_WAIT_L(0); PG8_MMA(0, 0, At, B0); PG8_BAR; PG8_SCHED;
            PG8_LDB(B1, 0, 1); PG8_STAGE(PG8_SB(0, 0), b2, voffB);
            PG8_BAR; PG8_WAIT_L(0); PG8_MMA(0, 1, At, B1); PG8_BAR;
            PG8_LDA(At, 0, 1); PG8_STAGE(PG8_SA(0, 0), a2, voffA);
            PG8_BAR; PG8_WAIT_L(0); PG8_MMA(1, 0, At, B0); PG8_BAR; PG8_SCHED;
            PG8_STAGE(PG8_SB(0, 1), b2 + hstep, voffB);
            PG8_WAIT_V(6); PG8_BAR; PG8_MMA(1, 1, At, B1); PG8_BAR;
            PG8_LDB(B0, 1, 0); PG8_SCHED; PG8_LDA(At, 1, 0); PG8_STAGE(PG8_SA(0, 1), a2 + hstep, voffA);
            PG8_WAIT_L(8); PG8_BAR; PG8_WAIT_L(0); PG8_MMA(0, 0, At, B0); PG8_BAR; PG8_SCHED;
            PG8_LDB(B1, 1, 1); PG8_STAGE(PG8_SB(1, 0), b3, voffB);
            PG8_BAR; PG8_WAIT_L(0); PG8_MMA(0, 1, At, B1); PG8_BAR;
            PG8_LDA(At, 1, 1); PG8_STAGE(PG8_SA(1, 0), a3, voffA);
            PG8_BAR; PG8_WAIT_L(0); PG8_MMA(1, 0, At, B0); PG8_BAR; PG8_SCHED;
            PG8_STAGE(PG8_SB(1, 1), b3 + hstep, voffB);
            PG8_WAIT_V(6); PG8_BAR; PG8_MMA(1, 1, At, B1); PG8_BAR;
            }
        }
        if constexpr (ALIGN_EPI) { if (wr == 0) PG8_BAR; }
        if constexpr (!Epi::AFTER_DRAIN) { E(acc, cur, wr, wc, fr, fq); S.done(cur); }
        if (!has_next) break;
#pragma unroll
        for (int a = 0; a < 2; ++a)
#pragma unroll
            for (int b = 0; b < 2; ++b)
#pragma unroll
                for (int m = 0; m < 4; ++m)
#pragma unroll
                    for (int n = 0; n < 2; ++n) acc[a][b][m][n] = (f32x4){0.f, 0.f, 0.f, 0.f};
        cur = nxt; cA = nA; cB = nB; ++ui;
        if constexpr (ALIGN_EPI) { if (wr == 1) PG8_BAR; }
    }
    PG8_WAIT_V(0);
    if constexpr (!ALIGN_EPI) { if (wr == 0) PG8_BAR; }
    PG8_BAR;
    if constexpr (Epi::AFTER_DRAIN) { E.fused(acc, cur, wr, wc, fr, fq, lds, wid, lane); S.done(cur); }
#undef PG8_SA
#undef PG8_SB
#undef PG8_STAGE
#undef PG8_LDA
#undef PG8_LDB
#undef PG8_MMA
#undef PG8_WAIT_V
#undef PG8_WAIT_L
#undef PG8_BAR
#undef PG8_SCHED
}
}
#define GAS __attribute__((address_space(1)))
#define LAS __attribute__((address_space(3)))
typedef unsigned short bf16;
typedef unsigned v4u __attribute__((ext_vector_type(4)));
typedef float f32x4 __attribute__((ext_vector_type(4)));
typedef short bf16x8 __attribute__((ext_vector_type(8)));
typedef GAS unsigned gu32;
typedef GAS unsigned long long gu64;
#define RLX_AGENT __ATOMIC_RELAXED, __HIP_MEMORY_SCOPE_AGENT
#define LDS_WAIT() asm volatile("s_waitcnt lgkmcnt(0)" ::: "memory")
#define VM_WAIT() asm volatile("s_waitcnt vmcnt(0)" ::: "memory")
__device__ __forceinline__ unsigned long long rt() { return __builtin_amdgcn_s_memrealtime(); }
__device__ __forceinline__ unsigned f2bf(float f) { unsigned u = __builtin_bit_cast(unsigned, f); return (u + 0x7fffu + ((u >> 16) & 1u)) >> 16; }
__device__ __forceinline__ unsigned pk2(float lo, float hi) { return f2bf(lo) | (f2bf(hi) << 16); }

#define XB_TMO      128
#define XB_XCNT(j)  (256  + 64 * (j))
#define XB_XSUB(j)  (1280 + 64 * (j))
#define XB_XGEN(j)  (2304 + 64 * (j))
#define XB_TOP      3328
#define XB_TOPGEN   3392
#define XCD_BAR_WORDS 3456
#define XB_SPIN_CAP (1u << 18)

__device__ __forceinline__ unsigned xb_ld(unsigned* p)              { return __hip_atomic_load(p, __ATOMIC_RELAXED, __HIP_MEMORY_SCOPE_AGENT); }
__device__ __forceinline__ unsigned xb_add(unsigned* p, unsigned v) { return __hip_atomic_fetch_add(p, v, __ATOMIC_RELAXED, __HIP_MEMORY_SCOPE_AGENT); }
__device__ __forceinline__ unsigned xb_xcc_id() { return (unsigned)__builtin_amdgcn_s_getreg((3 << 11) | 20) & 0xFu; }
#define XB_SPIN(cond, bar) do { unsigned _sp = 0; while (cond) { __builtin_amdgcn_s_sleep(1); \
    if ((++_sp & 255u) == 0u) { if (xb_ld(&(bar)[XB_TMO])) break; if (_sp > XB_SPIN_CAP) { atomicAdd(&(bar)[XB_TMO], 1u); break; } } } } while (0)

struct XcdBarrier {
    unsigned* bar; unsigned x;
    unsigned w0;
    volatile LAS unsigned* st;
};

#define XB_LANE0() (__builtin_amdgcn_mbcnt_hi(~0u, __builtin_amdgcn_mbcnt_lo(~0u, 0u)) == 0u)
__device__ __forceinline__ XcdBarrier xcd_barrier_post(unsigned* bar, volatile LAS unsigned* st, unsigned w0) {
    XcdBarrier b; b.bar = bar; b.x = xb_xcc_id(); b.st = st; b.w0 = w0;
    if (w0 && XB_LANE0()) (void)xb_add(&bar[XB_XCNT(b.x)], 1u);
    return b;
}
__device__ __forceinline__ void xcd_barrier_complete(unsigned* bar, unsigned x, unsigned& nloc, unsigned& nx) {
    const unsigned G = gridDim.x * gridDim.y * gridDim.z;
    unsigned sum, cnt, mine, sp = 0u;
    for (;;) {
        sum = 0u; cnt = 0u; mine = 0u;
#pragma unroll
        for (unsigned j = 0; j < 16; ++j) { const unsigned c = xb_ld(&bar[XB_XCNT(j)]); sum += c; cnt += (c > 0u) ? 1u : 0u; mine = (j == x) ? c : mine; }
        if (sum == G) break;
        __builtin_amdgcn_s_sleep(1);
        if ((++sp & 255u) == 0u) { if (xb_ld(&bar[XB_TMO])) break; if (sp > XB_SPIN_CAP) { atomicAdd(&bar[XB_TMO], 1u); break; } }
    }
    nloc = mine > 0u ? mine : 1u; nx = cnt > 0u ? cnt : 1u;
}

__device__ __forceinline__ void xcd_barrier(const XcdBarrier& b) {
    asm volatile("s_waitcnt vmcnt(0)" ::: "memory");
    __syncthreads();
    if (b.w0 && XB_LANE0()) {
        unsigned* bar = b.bar;
        __builtin_amdgcn_s_waitcnt(0);
        unsigned nloc = b.st[0], nx = b.st[1];
        if (nloc == 0u) { xcd_barrier_complete(bar, b.x, nloc, nx); b.st[0] = nloc; b.st[1] = nx; }
        const unsigned old = xb_add(&bar[XB_XSUB(b.x)], 1u);
        const unsigned gen = old / nloc;
        if (old + 1u == (gen + 1u) * nloc) {
            __builtin_amdgcn_fence(__ATOMIC_RELEASE, "agent");
            asm volatile("s_waitcnt vmcnt(0)" ::: "memory");
            const unsigned og = xb_add(&bar[XB_TOP], 1u);
            const unsigned tg = og / nx;
            if (og + 1u == (tg + 1u) * nx) xb_add(&bar[XB_TOPGEN], 1u);
            else XB_SPIN(xb_ld(&bar[XB_TOPGEN]) == tg, bar);
            __builtin_amdgcn_fence(__ATOMIC_ACQUIRE, "agent");
            xb_add(&bar[XB_XGEN(b.x)], 1u);
            asm volatile("s_waitcnt vmcnt(0)" ::: "memory");
        } else {
            XB_SPIN(xb_ld(&bar[XB_XGEN(b.x)]) == gen, bar);
            __builtin_amdgcn_fence(__ATOMIC_ACQUIRE, "agent");
            asm volatile("s_waitcnt vmcnt(0)" ::: "memory");
        }
    }
    __syncthreads();
}
constexpr int DM = 1024;
constexpr int TP = 8192, BP = 2, MP = BP * TP;
constexpr int NB_S = 128, SS = 4, MS = NB_S * SS;
constexpr int MT = MP + MS;
constexpr int PIN = 2328, NIN = 2560;
constexpr int FFN = 2816, NGU = 2 * FFN;
constexpr int PAST = 2048, PAGE = 128, NPG = PAST / PAGE, NPOOL = 2560;
constexpr int KVW = 256;
constexpr int NLAYER = 2;
constexpr float LN_EPS = 1e-5f;
constexpr float DN_ALPHA = 1.4142135623730951f;

constexpr size_t O_Y = 0;
constexpr size_t O_CMPP = (size_t)MT * DM;
constexpr size_t O_SLCP = O_CMPP + (size_t)NLAYER * MP * KVW;
constexpr size_t O_WINP = O_SLCP + (size_t)NLAYER * MP * KVW;
constexpr size_t O_CMPS = O_WINP + (size_t)NLAYER * BP * 512 * KVW;
constexpr size_t O_SLCS = O_CMPS + (size_t)NLAYER * MS * KVW;
constexpr size_t O_WINS = O_SLCS + (size_t)NLAYER * MS * KVW;
constexpr size_t O_GV = O_WINS + (size_t)NLAYER * NB_S * 512 * KVW;
constexpr size_t O_END = O_GV + (size_t)NLAYER * MS * 512;
static_assert(O_END == 69206016, "output size");

constexpr size_t MiB = 1u << 20;
constexpr size_t WS_CTL = 0, CTL_ZERO_BYTES = 1 * MiB;
constexpr size_t WS_ROPE = 1 * MiB;
constexpr size_t WS_WIN_T = 4 * MiB;
constexpr size_t WS_WOUT_T = 14 * MiB;
constexpr size_t WS_WGU_T = 18 * MiB;
constexpr size_t WS_WDN_T = 40 * MiB;
constexpr size_t WS_W1C_T = 52 * MiB;
constexpr size_t WS_W2C_T = 56 * MiB;
constexpr size_t WS_GWP = 57 * MiB;
constexpr size_t WS_GWS = 58 * MiB;
constexpr size_t WS_GBS = 59 * MiB;
constexpr size_t WS_XF = 64 * MiB;
constexpr size_t WS_XB = 130 * MiB;
constexpr size_t WS_PRE = 163 * MiB;
constexpr size_t WS_QRAW = 229 * MiB;
constexpr size_t WS_QROT = 246 * MiB;
constexpr size_t WS_KS = 263 * MiB;
constexpr size_t WS_VS = 267 * MiB;
constexpr size_t WS_KW = 271 * MiB;
constexpr size_t WS_VW = 275 * MiB;
constexpr size_t WS_U = 279 * MiB;
constexpr size_t WS_V = 296 * MiB;
constexpr size_t WS_GATES = 313 * MiB;
constexpr size_t WS_CKP = 315 * MiB;
constexpr size_t WS_CVP = WS_CKP + 512 * 1024;
constexpr size_t WS_CKS = 316 * MiB;
constexpr size_t WS_CVS = 320 * MiB;
constexpr size_t WS_MIX = 324 * MiB;
constexpr size_t WS_F = 357 * MiB;
constexpr size_t WS_DBG = 448 * MiB;
constexpr size_t WS_END = 560 * MiB;
static_assert(WS_XF + (size_t)MT * DM * 4 <= WS_XB && WS_XB + (size_t)MT * DM * 2 <= WS_PRE && WS_PRE + (size_t)MT * DM * 4 <= WS_QRAW, "ws map 1");
static_assert(WS_QRAW + (size_t)MT * 512 * 2 <= WS_QROT && WS_QROT + (size_t)MT * 512 * 2 <= WS_KS && WS_U + (size_t)MT * 512 * 2 <= WS_V && WS_V + (size_t)MT * 512 * 2 <= WS_GATES, "ws map 2");
static_assert(WS_GATES + (size_t)MT * 24 * 4 <= WS_CKP && WS_MIX + (size_t)MT * DM * 2 <= WS_F && WS_F + (size_t)MT * FFN * 2 <= WS_END, "ws map 3");
static_assert(WS_WIN_T + (size_t)2 * NIN * DM * 2 <= WS_WOUT_T && WS_WGU_T + (size_t)2 * NGU * DM * 2 <= WS_WDN_T && WS_WDN_T + (size_t)2 * DM * FFN * 2 <= WS_W1C_T, "ws map 4");

constexpr int CW_TMO = 0, CW_CODE = 1;
constexpr int CW_BAR = 4096;
constexpr int CW_ERR = 64;
#ifndef ATT_PROBE_GAIN
#define ATT_PROBE_GAIN 10.0f
#endif
#ifndef ATT_PROBE_SEL
#define ATT_PROBE_SEL 3
#endif

constexpr int NWAVES = 8;
constexpr int RING_OFF = 0, RING_BYTES = 131072;
constexpr int LDSCTL_OFF = 143360, MISC_OFF = LDSCTL_OFF + 320;
constexpr int LDS_BYTES = 147456;

constexpr int PH_P0A = 0, PH_P0B = 1, PH_L0 = 2, PH_PER_LAYER = 8, N_PHASES = PH_L0 + NLAYER * PH_PER_LAYER;
typedef float f32x2 __attribute__((ext_vector_type(2)));
typedef unsigned u32x2 __attribute__((ext_vector_type(2)));
__device__ __forceinline__ float bf2f(unsigned short h) { return __uint_as_float(((unsigned)h) << 16); }
__device__ __forceinline__ float bflo(unsigned w) { return __uint_as_float(w << 16); }
__device__ __forceinline__ float bfhi(unsigned w) { return __uint_as_float(w & 0xffff0000u); }
__device__ __forceinline__ float wave_sum(float v) {
#pragma unroll
    for (int o = 1; o < 64; o <<= 1) v += __shfl_xor(v, o);
    return v;
}
__device__ __forceinline__ float wave_max(float v) {
#pragma unroll
    for (int o = 1; o < 64; o <<= 1) v = fmaxf(v, __shfl_xor(v, o));
    return v;
}
__device__ __forceinline__ float sigmoidf_(float x) { return 1.0f / (1.0f + __expf(-x)); }
__device__ __forceinline__ float siluf_(float x) { return x / (1.0f + __expf(-x)); }
__device__ __forceinline__ float geluf_(float x) { const float u = 1.5957691216057308f * (x + 0.044715f * x * x * x); return x / (1.0f + __expf(-u)); }
#define WAVE_LDS_FENCE() asm volatile("s_waitcnt lgkmcnt(0)" ::: "memory")

struct EpiResid {
    static constexpr bool PERM = false, AFTER_DRAIN = false;
    const float* xf; float* pre;
    __device__ __forceinline__ void operator()(const pg8::f32x4 (&acc)[2][2][4][2], const pg8::Unit& u, int wr, int wc, int fr, int fq) const {
        const int col0 = u.pn * 256 + wc * 32 + 4 * fq;
#pragma unroll
        for (int ai = 0; ai < 2; ++ai)
#pragma unroll
            for (int m = 0; m < 4; ++m) {
                const size_t off = (size_t)(u.pm * 256 + ai * 128 + wr * 64 + m * 16 + fr) * DM + col0;
#pragma unroll
                for (int bj = 0; bj < 2; ++bj)
#pragma unroll
                    for (int n = 0; n < 2; ++n) {
                        const pg8::f32x4 x = *(const pg8::f32x4*)(xf + off + bj * 128 + n * 16);
                        *(pg8::f32x4*)(pre + off + bj * 128 + n * 16) = x * DN_ALPHA + acc[ai][bj][m][n];
                    }
            }
    }
};
struct EpiGateUp {
    static constexpr bool PERM = true, AFTER_DRAIN = false;
    bf16* f;
    __device__ __forceinline__ void operator()(const pg8::f32x4 (&acc)[2][2][4][2], const pg8::Unit& u, int wr, int wc, int fr, int fq) const {
        const int c8 = u.pn * 256 + wc * 32 + 8 * fq;
#pragma unroll
        for (int ai = 0; ai < 2; ++ai)
#pragma unroll
            for (int m = 0; m < 4; ++m) {
                const size_t row = (size_t)(u.pm * 256 + ai * 128 + wr * 64 + m * 16 + fr);
#pragma unroll
                for (int bj = 0; bj < 2; ++bj) {
                    const pg8::f32x4 v0 = acc[ai][bj][m][0], v1 = acc[ai][bj][m][1];
                    const float o0 = siluf_(v0[0]) * v0[1], o1 = siluf_(v0[2]) * v0[3], o2 = siluf_(v1[0]) * v1[1], o3 = siluf_(v1[2]) * v1[3];
                    u32x2 w; w.x = pk2(o0, o1); w.y = pk2(o2, o3);
                    *(u32x2*)(f + row * FFN + ((c8 + bj * 128) >> 1)) = w;
                }
            }
    }
};
struct EpiInProj {
    static constexpr bool PERM = true, AFTER_DRAIN = false;
    int layer; unsigned char* ws; float* out;
    __device__ __forceinline__ void operator()(const pg8::f32x4 (&acc)[2][2][4][2], const pg8::Unit& u, int wr, int wc, int fr, int fq) const {
        const int pn = u.pn;
        const f32x2* rope = (const f32x2*)(ws + WS_ROPE); bf16* qraw = (bf16*)(ws + WS_QRAW); bf16* qrot = (bf16*)(ws + WS_QROT);
        bf16* KS = (bf16*)(ws + WS_KS); bf16* VS = (bf16*)(ws + WS_VS); bf16* KW = (bf16*)(ws + WS_KW); bf16* VW = (bf16*)(ws + WS_VW);
        bf16* U = (bf16*)(ws + WS_U); bf16* V = (bf16*)(ws + WS_V); float* gates = (float*)(ws + WS_GATES);
#pragma unroll
        for (int ai = 0; ai < 2; ++ai)
#pragma unroll
            for (int m = 0; m < 4; ++m) {
                const int r = u.pm * 256 + ai * 128 + wr * 64 + m * 16 + fr;
                const bool prompt = r < MP;
                const int b = r >> 13, t = r & (TP - 1);
                const int si = r - MP, bs = si >> 2, s = si & 3;
                const int pos = prompt ? t : PAST + s;
#pragma unroll
                for (int bj = 0; bj < 2; ++bj) {
                    const int c8 = pn * 256 + bj * 128 + wc * 32 + 8 * fq;
                    const pg8::f32x4 v0 = acc[ai][bj][m][0], v1 = acc[ai][bj][m][1];
                    if (pn < 2) {
                        const int h = c8 >> 6, d = (c8 & 63) >> 1;
                        const f32x2 cs0 = rope[pos * 32 + d], cs1 = rope[pos * 32 + d + 1], cs2 = rope[pos * 32 + d + 2], cs3 = rope[pos * 32 + d + 3];
                        const float a0 = v0[0], b0 = v0[1], a1 = v0[2], b1 = v0[3], a2 = v1[0], b2 = v1[1], a3 = v1[2], b3 = v1[3];
                        const size_t o = (size_t)r * 512 + h * 64 + d;
                        u32x2 w;
                        w.x = pk2(a0, a1); w.y = pk2(a2, a3); *(u32x2*)(qraw + o) = w;
                        w.x = pk2(b0, b1); w.y = pk2(b2, b3); *(u32x2*)(qraw + o + 32) = w;
                        w.x = pk2(a0 * cs0.x - b0 * cs0.y, a1 * cs1.x - b1 * cs1.y); w.y = pk2(a2 * cs2.x - b2 * cs2.y, a3 * cs3.x - b3 * cs3.y); *(u32x2*)(qrot + o) = w;
                        w.x = pk2(b0 * cs0.x + a0 * cs0.y, b1 * cs1.x + a1 * cs1.y); w.y = pk2(b2 * cs2.x + a2 * cs2.y, b3 * cs3.x + a3 * cs3.y); *(u32x2*)(qrot + o + 32) = w;
                    } else if (pn == 2) {
                        const int cc = c8 - 512;
                        float* dst = prompt ? out + O_CMPP + ((size_t)(layer * BP + b) * TP + t) * KVW + cc : out + O_CMPS + ((size_t)layer * MS + si) * KVW + cc;
                        *(pg8::f32x4*)dst = v0; *(pg8::f32x4*)(dst + 4) = v1;
                    } else if (pn == 3 || pn == 4) {
                        const bool is_slc = (pn == 3);
                        const int cc = c8 - (is_slc ? 768 : 1024);
                        float* dst;
                        bool wr_out = true;
                        if (is_slc) dst = prompt ? out + O_SLCP + ((size_t)(layer * BP + b) * TP + t) * KVW : out + O_SLCS + ((size_t)layer * MS + si) * KVW;
                        else { if (prompt) { wr_out = (t >= TP - 512); dst = out + O_WINP + ((size_t)(layer * BP + b) * 512 + (t - (TP - 512))) * KVW; }
                               else dst = out + O_WINS + ((size_t)(layer * NB_S + bs) * 512 + 508 + s) * KVW; }
                        if (cc < 128) {
                            const int g = cc >> 6, d = (cc & 63) >> 1;
                            const f32x2 cs0 = rope[pos * 32 + d], cs1 = rope[pos * 32 + d + 1], cs2 = rope[pos * 32 + d + 2], cs3 = rope[pos * 32 + d + 3];
                            const float a0 = v0[0], b0 = v0[1], a1 = v0[2], b1 = v0[3], a2 = v1[0], b2 = v1[1], a3 = v1[2], b3 = v1[3];
                            const pg8::f32x4 lo = {a0 * cs0.x - b0 * cs0.y, a1 * cs1.x - b1 * cs1.y, a2 * cs2.x - b2 * cs2.y, a3 * cs3.x - b3 * cs3.y};
                            const pg8::f32x4 hi = {b0 * cs0.x + a0 * cs0.y, b1 * cs1.x + a1 * cs1.y, b2 * cs2.x + a2 * cs2.y, b3 * cs3.x + a3 * cs3.y};
                            if (wr_out) { *(pg8::f32x4*)(dst + g * 64 + d) = lo; *(pg8::f32x4*)(dst + g * 64 + d + 32) = hi; }
                            if (prompt) { bf16* kb = (is_slc ? KS : KW) + ((size_t)(b * 2 + g) * TP + t) * 64 + d;
                                u32x2 w; w.x = pk2(lo[0], lo[1]); w.y = pk2(lo[2], lo[3]); *(u32x2*)kb = w;
                                w.x = pk2(hi[0], hi[1]); w.y = pk2(hi[2], hi[3]); *(u32x2*)(kb + 32) = w; }
                        } else {
                            const int g = (cc - 128) >> 6, d = cc & 63;
                            if (wr_out) { *(pg8::f32x4*)(dst + cc) = v0; *(pg8::f32x4*)(dst + cc + 4) = v1; }
                            if (prompt) { bf16* vb = (is_slc ? VS : VW) + ((size_t)(b * 2 + g) * TP + t) * 64 + d;
                                v4u w; w.x = pk2(v0[0], v0[1]); w.y = pk2(v0[2], v0[3]); w.z = pk2(v1[0], v1[1]); w.w = pk2(v1[2], v1[3]); *(v4u*)vb = w; }
                        }
                    } else if (pn < 9) {
                        const bool is_u = pn < 7;
                        const int cc = c8 - (is_u ? 1280 : 1792);
                        bf16* dst = (is_u ? U : V) + (size_t)r * 512 + cc;
                        v4u w; w.x = pk2(geluf_(v0[0]), geluf_(v0[1])); w.y = pk2(geluf_(v0[2]), geluf_(v0[3])); w.z = pk2(geluf_(v1[0]), geluf_(v1[1])); w.w = pk2(geluf_(v1[2]), geluf_(v1[3]));
                        *(v4u*)dst = w;
                    } else {
                        const int cc = c8 - 2304;
                        if (cc < 24) { float* dst = gates + (size_t)r * 24 + cc;
                            const pg8::f32x4 g0 = {sigmoidf_(v0[0]), sigmoidf_(v0[1]), sigmoidf_(v0[2]), sigmoidf_(v0[3])}, g1 = {sigmoidf_(v1[0]), sigmoidf_(v1[1]), sigmoidf_(v1[2]), sigmoidf_(v1[3])};
                            *(pg8::f32x4*)dst = g0; *(pg8::f32x4*)(dst + 4) = g1; }
                    }
                }
            }
    }
};

template <class RowMap>
__device__ __forceinline__ void transpose_item(const float* W, int K, int N, bf16* WT, const RowMap rm, LAS float* scr, int item, int lane) {
    const int nblk = (N + 31) / 32, kb = item / nblk, nb = item % nblk, k0 = 64 * kb, n0 = 32 * nb;
    const int ncol = n0 + (lane & 31);
#pragma unroll 8
    for (int i = 0; i < 32; ++i) { const int kk = 2 * i + (lane >> 5); scr[kk * 33 + (lane & 31)] = (ncol < N) ? W[(size_t)(k0 + kk) * N + ncol] : 0.f; }
    LDS_WAIT(); asm volatile("" ::: "memory");
    const int c = lane & 7;
#pragma unroll
    for (int j = 0; j < 4; ++j) { const int nl = (lane >> 3) + 8 * j; const LAS float* s = scr + (8 * c) * 33 + nl;
        v4u o; o.x = pk2(s[0 * 33], s[1 * 33]); o.y = pk2(s[2 * 33], s[3 * 33]); o.z = pk2(s[4 * 33], s[5 * 33]); o.w = pk2(s[6 * 33], s[7 * 33]);
        if (n0 + nl < N) *(v4u*)(WT + (size_t)rm(n0 + nl) * K + k0 + 8 * c) = o; }
    LDS_WAIT(); asm volatile("" ::: "memory");
}
struct RmIdent { __device__ __forceinline__ int operator()(int n) const { return n; } };
struct RmAffine { int mul, add; __device__ __forceinline__ int operator()(int n) const { return n * mul + add; } };
__device__ __forceinline__ int rope_il(int d) { return d < 32 ? 2 * d : 2 * (d - 32) + 1; }
struct RmInProj { __device__ __forceinline__ int operator()(int c) const {
    if (c < 512) return (c & ~63) + rope_il(c & 63);
    if (c < 768) return c;
    if (c < 1280) { const int base = c < 1024 ? 768 : 1024, cc = c - base; return cc < 128 ? base + (cc & ~63) + rope_il(cc & 63) : c; }
    if (c < 1304) return 2304 + (c - 1280);
    return 1280 + (c - 1304); } };
constexpr int CU_AS = 0, CU_BS = 9216, CU_HS = 46080, CU_LDS = 79872;
__device__ __forceinline__ void compress_unit(LAS unsigned char* lds, const float* arow, const float* pe_k, const bf16* W1t, const float* b1, const bf16* W2t,
                                              bf16* obase, int NC, int rb, int tid) {
    const int wid = __builtin_amdgcn_readfirstlane(tid >> 6), lane = tid & 63, fr = lane & 15, fq = lane >> 4, wr = wid >> 2, wc = wid & 3;
    const int arow_i = tid >> 3, ac = tid & 7;
    pg8::f32x4 acc[2][4];
#pragma unroll
    for (int m = 0; m < 2; ++m)
#pragma unroll
        for (int n = 0; n < 4; ++n) acc[m][n] = (pg8::f32x4){0.f, 0.f, 0.f, 0.f};
    pg8::f32x4 a0, a1, p0, p1; v4u bq[4];
    const float* pe_t = pe_k + ac * 8;
    const bf16* bsrc = W1t + (size_t)arow_i * 2048 + ac * 8;
    a0 = *(const pg8::f32x4*)arow; a1 = *(const pg8::f32x4*)(arow + 4); p0 = *(const pg8::f32x4*)pe_t; p1 = *(const pg8::f32x4*)(pe_t + 4);
#pragma unroll
    for (int j = 0; j < 4; ++j) bq[j] = *(const v4u*)(bsrc + (size_t)j * 64 * 2048);
    for (int l = 0; l < 32; ++l) {
        { v4u w; a0 = a0 + p0; a1 = a1 + p1; w.x = pk2(a0[0], a0[1]); w.y = pk2(a0[2], a0[3]); w.z = pk2(a1[0], a1[1]); w.w = pk2(a1[2], a1[3]);
          *(LAS v4u*)(lds + CU_AS + arow_i * 144 + ac * 16) = w;
#pragma unroll
          for (int j = 0; j < 4; ++j) *(LAS v4u*)(lds + CU_BS + (arow_i + 64 * j) * 144 + ac * 16) = bq[j]; }
        __syncthreads();
        if (l + 1 < 32) {
            const float* an = arow + (size_t)(l + 1) * KVW; const float* pn = pe_t + (l + 1) * 64; const bf16* bn = bsrc + (l + 1) * 64;
            a0 = *(const pg8::f32x4*)an; a1 = *(const pg8::f32x4*)(an + 4); p0 = *(const pg8::f32x4*)pn; p1 = *(const pg8::f32x4*)(pn + 4);
#pragma unroll
            for (int j = 0; j < 4; ++j) bq[j] = *(const v4u*)(bn + (size_t)j * 64 * 2048);
        }
#pragma unroll
        for (int kk = 0; kk < 2; ++kk) {
            bf16x8 af[2], bfr[4];
#pragma unroll
            for (int m = 0; m < 2; ++m) af[m] = *(const LAS bf16x8*)(lds + CU_AS + (wr * 32 + m * 16 + fr) * 144 + (kk * 32 + fq * 8) * 2);
#pragma unroll
            for (int n = 0; n < 4; ++n) bfr[n] = *(const LAS bf16x8*)(lds + CU_BS + (wc * 64 + n * 16 + fr) * 144 + (kk * 32 + fq * 8) * 2);
#pragma unroll
            for (int m = 0; m < 2; ++m)
#pragma unroll
                for (int n = 0; n < 4; ++n) acc[m][n] = __builtin_amdgcn_mfma_f32_16x16x32_bf16(af[m], bfr[n], acc[m][n], 0, 0, 0);
        }
        __syncthreads();
    }
#pragma unroll
    for (int m = 0; m < 2; ++m)
#pragma unroll
        for (int n = 0; n < 4; ++n) { const int col = wc * 64 + n * 16 + fr; const float bb = b1[col];
#pragma unroll
            for (int rg = 0; rg < 4; ++rg) { const int row = wr * 32 + m * 16 + fq * 4 + rg;
                *(LAS unsigned short*)(lds + CU_HS + row * 528 + col * 2) = (unsigned short)f2bf(siluf_(acc[m][n][rg] + bb)); } }
    __syncthreads();
    {
        const int rt = wid >> 1, ch = wid & 1;
        pg8::f32x4 acc2[2] = {(pg8::f32x4){0.f, 0.f, 0.f, 0.f}, (pg8::f32x4){0.f, 0.f, 0.f, 0.f}};
#pragma unroll
        for (int ks = 0; ks < 8; ++ks) {
            const bf16x8 a = *(const LAS bf16x8*)(lds + CU_HS + (rt * 16 + fr) * 528 + (ks * 32 + fq * 8) * 2);
#pragma unroll
            for (int nn = 0; nn < 2; ++nn) { const bf16x8 bb = *(const bf16x8*)(W2t + (size_t)(ch * 32 + nn * 16 + fr) * 256 + ks * 32 + fq * 8);
                acc2[nn] = __builtin_amdgcn_mfma_f32_16x16x32_bf16(a, bb, acc2[nn], 0, 0, 0); }
        }
#pragma unroll
        for (int nn = 0; nn < 2; ++nn)
#pragma unroll
            for (int rg = 0; rg < 4; ++rg) { const int R = rb * 64 + rt * 16 + fq * 4 + rg, col = ch * 32 + nn * 16 + fr;
                const int b = R / (2 * NC), n = (R >> 1) % NC, g = R & 1;
                obase[((size_t)(b * 2 + g) * NC + n) * 64 + col] = (bf16)f2bf(acc2[nn][rg]); }
    }
    __syncthreads();
}

__device__ __forceinline__ void gmlp_unit(LAS unsigned char* lds, LAS unsigned char* lds_stats, int m0, const bf16* U, const bf16* V, const float* Wm, const float* bias, const float* lng, const float* lnb,
                                          bf16* mix, float* gv_out  , int tid) {
    const int wid = __builtin_amdgcn_readfirstlane(tid >> 6), lane = tid & 63;
    LAS f32x2* stats = (LAS f32x2*)lds_stats;
    for (int i = 0; i < 16; ++i) {
        const int row = wid * 16 + i;
        const v4u w = *(const v4u*)(V + (size_t)(m0 + row) * 512 + lane * 8);
        float x[8] = {bflo(w.x), bfhi(w.x), bflo(w.y), bfhi(w.y), bflo(w.z), bfhi(w.z), bflo(w.w), bfhi(w.w)};
        float s = 0.f;
#pragma unroll
        for (int e = 0; e < 8; ++e) s += x[e];
        const float mean = wave_sum(s) * (1.0f / 512.0f);
        float q = 0.f;
#pragma unroll
        for (int e = 0; e < 8; ++e) { const float d = x[e] - mean; q += d * d; }
        const float var = wave_sum(q) * (1.0f / 512.0f);
        if (lane == 0) stats[row] = (f32x2){mean, 1.0f / sqrtf(var + LN_EPS)};
    }
    __syncthreads();
    const int h = wid, col = h * 64 + lane;
    const float gg = lng[col], bb = lnb[col];
    LAS float* part = (LAS float*)(lds + wid * 16384);
    const float* Wh = Wm + (size_t)h * 128 * 128;
#pragma unroll 1
    for (int half = 0; half < 2; ++half) {
        float vn[64];
#pragma unroll
        for (int s = 0; s < 64; ++s) { const f32x2 st = stats[half * 64 + s]; vn[s] = (bf2f(V[(size_t)(m0 + half * 64 + s) * 512 + col]) - st.x) * st.y * gg + bb; }
        if (gv_out) {
#pragma unroll
            for (int s = 0; s < 64; ++s) gv_out[(size_t)(half * 64 + s) * 512 + col] = vn[s];
        }
        for (int t = half * 64; t < 128; ++t) {
            const float w0 = Wh[t * 128 + half * 64 + lane];
            float acc0 = (half == 0) ? bias[h * 128 + t] : part[(t - 64) * 64 + lane], acc1 = 0.f;
#pragma unroll
            for (int s = 0; s < 64; s += 2) { acc0 += __int_as_float(__builtin_amdgcn_readlane(__float_as_int(w0), s)) * vn[s]; acc1 += __int_as_float(__builtin_amdgcn_readlane(__float_as_int(w0), s + 1)) * vn[s + 1]; }
            const float sres = acc0 + acc1;
            if (half == 0 && t >= 64) part[(t - 64) * 64 + lane] = sres;
            else { const float uu = bf2f(U[(size_t)(m0 + t) * 512 + col]); mix[(size_t)(m0 + t) * DM + 512 + col] = (bf16)f2bf(uu * sres); }
        }
        WAVE_LDS_FENCE();
    }
    __syncthreads();
}

__device__ __forceinline__ void ln_row(const float* src, const float* g, const float* b, float* dstf, bf16* dstb, int lane) {
    pg8::f32x4 v[4]; float s = 0.f;
#pragma unroll
    for (int j = 0; j < 4; ++j) { v[j] = *(const pg8::f32x4*)(src + (j * 64 + lane) * 4); s += (v[j][0] + v[j][1]) + (v[j][2] + v[j][3]); }
    const float mean = wave_sum(s) * (1.0f / DM); float q = 0.f;
#pragma unroll
    for (int j = 0; j < 4; ++j) { v[j] = v[j] - mean; q += (v[j][0] * v[j][0] + v[j][1] * v[j][1]) + (v[j][2] * v[j][2] + v[j][3] * v[j][3]); }
    const float rstd = 1.0f / sqrtf(wave_sum(q) * (1.0f / DM) + LN_EPS);
#pragma unroll
    for (int j = 0; j < 4; ++j) { const int c = (j * 64 + lane) * 4;
        const pg8::f32x4 gg = *(const pg8::f32x4*)(g + c), bb = *(const pg8::f32x4*)(b + c);
        const pg8::f32x4 y = v[j] * rstd * gg + bb;
        *(pg8::f32x4*)(dstf + c) = y;
        if (dstb) { u32x2 w; w.x = pk2(y[0], y[1]); w.y = pk2(y[2], y[3]); *(u32x2*)(dstb + c) = w; } }
}

__device__ __forceinline__ void load8(const bf16* p, float (&k)[8]) { const v4u w = *(const v4u*)p; k[0] = bflo(w.x); k[1] = bfhi(w.x); k[2] = bflo(w.y); k[3] = bfhi(w.y); k[4] = bflo(w.z); k[5] = bfhi(w.z); k[6] = bflo(w.w); k[7] = bfhi(w.w); }
__device__ __forceinline__ void load8(const float* p, float (&k)[8]) { const pg8::f32x4 a = *(const pg8::f32x4*)p, b = *(const pg8::f32x4*)(p + 4); k[0] = a[0]; k[1] = a[1]; k[2] = a[2]; k[3] = a[3]; k[4] = b[0]; k[5] = b[1]; k[6] = b[2]; k[7] = b[3]; }
__device__ __forceinline__ float ldv(const bf16* p) { return bf2f(*p); }
__device__ __forceinline__ float ldv(const float* p) { return *p; }
template <class T> __device__ __forceinline__ void dot4(const T* krow, const LAS float* q, float (&s)[4]) {
    s[0] = s[1] = s[2] = s[3] = 0.f;
#pragma unroll 1
    for (int c = 0; c < 8; ++c) {
        float k[8]; load8(krow + c * 8, k);
#pragma unroll
        for (int r = 0; r < 4; ++r) {
            const pg8::f32x4 qa = *(const LAS pg8::f32x4*)(q + r * 64 + c * 8), qb = *(const LAS pg8::f32x4*)(q + r * 64 + c * 8 + 4);
            s[r] += qa[0] * k[0] + qa[1] * k[1] + qa[2] * k[2] + qa[3] * k[3] + qb[0] * k[4] + qb[1] * k[5] + qb[2] * k[6] + qb[3] * k[7];
        }
    }
}
template <class Src>
__device__ __forceinline__ void attend(const Src& S, int nblk, const LAS float* q, LAS float* pbuf, int lane, float (&o)[4], LAS float* impbuf) {
    typedef typename Src::T T;
    float m[4] = {-1e30f, -1e30f, -1e30f, -1e30f}, l[4] = {0.f, 0.f, 0.f, 0.f};
    for (int i = 0; i < nblk; ++i) {
        const T *kb, *vb; bool ok; S.blk(i, lane, kb, vb, ok);
        if (ok) { float s[4]; dot4(kb + (size_t)lane * Src::STRIDE, q, s);
#pragma unroll
            for (int r = 0; r < 4; ++r) { if (s[r] > m[r]) { l[r] = l[r] * __expf(m[r] - s[r]) + 1.0f; m[r] = s[r]; } else l[r] += __expf(s[r] - m[r]); } }
    }
    float Mx[4], inv[4];
#pragma unroll
    for (int r = 0; r < 4; ++r) { Mx[r] = wave_max(m[r]); const float L = wave_sum(l[r] * __expf(m[r] - Mx[r])); inv[r] = 1.0f / fmaxf(L, 1e-30f); }
    o[0] = o[1] = o[2] = o[3] = 0.f;
    if (!(Mx[0] > -1e29f)) return;
    for (int i = 0; i < nblk; ++i) {
        const T *kb, *vb; bool ok; S.blk(i, lane, kb, vb, ok);
        const unsigned long long mask = __ballot(ok);
        if (mask == 0ull) continue;
        pg8::f32x4 p = {0.f, 0.f, 0.f, 0.f};
        if (ok) { float s[4]; dot4(kb + (size_t)lane * Src::STRIDE, q, s);
#pragma unroll
            for (int r = 0; r < 4; ++r) p[r] = __expf(s[r] - Mx[r]) * inv[r]; }
        *(LAS pg8::f32x4*)(pbuf + lane * 4) = p;
        if (impbuf) { const float im = (p[0] + p[1]) + (p[2] + p[3]); const float pr = im + __shfl_xor(im, 1); if (!(lane & 1)) impbuf[(i * 64 + lane) >> 1] = pr; }
        WAVE_LDS_FENCE();
        for (int kk = 0; kk < 64; ++kk) {
            if ((mask >> kk) & 1ull) { const pg8::f32x4 pv = *(const LAS pg8::f32x4*)(pbuf + kk * 4); const float v = ldv(vb + (size_t)kk * Src::STRIDE + lane);
                o[0] += pv[0] * v; o[1] += pv[1] * v; o[2] += pv[2] * v; o[3] += pv[3] * v; }
        }
        WAVE_LDS_FENCE();
    }
}
__device__ __forceinline__ unsigned long long topk_key(float val, int j) { unsigned u = __float_as_uint(val); u = (u & 0x80000000u) ? ~u : (u | 0x80000000u); return ((unsigned long long)u << 32) | (unsigned)(127 - j); }
__device__ __forceinline__ void topk16(const LAS float* imp, int ns, int cur, LAS int* selidx, int lane) {
    unsigned long long k0 = 0ull, k1 = 0ull;
    { const int j = lane; if (j < ns) { const bool valid = j <= cur, forced = (j == 0) | (j == cur) | (j == cur - 1); k0 = topk_key(valid ? imp[j] + (forced ? 1.0e4f : 0.f) : -1.0f, j); } }
    { const int j = lane + 64; if (j < ns) { const bool valid = j <= cur, forced = (j == 0) | (j == cur) | (j == cur - 1); k1 = topk_key(valid ? imp[j] + (forced ? 1.0e4f : 0.f) : -1.0f, j); } }
    for (int it = 0; it < 16; ++it) {
        unsigned long long k = k0 > k1 ? k0 : k1;
#pragma unroll
        for (int o = 1; o < 64; o <<= 1) { const unsigned lo = __shfl_xor((unsigned)k, o), hi = __shfl_xor((unsigned)(k >> 32), o); const unsigned long long kx = ((unsigned long long)hi << 32) | lo; k = kx > k ? kx : k; }
        const int jb = 127 - (int)(unsigned)(k & 0xffffffffull);
        if (lane == 0) selidx[it] = (k == 0ull || jb > cur) ? -1 : jb;
        if (k0 == k) k0 = 0ull;
        if (k1 == k) k1 = 0ull;
    }
    WAVE_LDS_FENCE();
}
struct SrcPromptCmp { typedef bf16 T; static constexpr int STRIDE = 64; const bf16 *ck, *cv; int nvalid;
    __device__ __forceinline__ void blk(int i, int lane, const bf16*& kb, const bf16*& vb, bool& ok) const { kb = ck + (size_t)i * 64 * 64; vb = cv + (size_t)i * 64 * 64; ok = (i * 64 + lane) < nvalid; } };
struct SrcPromptSlc { typedef bf16 T; static constexpr int STRIDE = 64; const bf16 *K, *V; const LAS int* selidx; int t;
    __device__ __forceinline__ void blk(int i, int lane, const bf16*& kb, const bf16*& vb, bool& ok) const { const int j = selidx[i]; const int jj = j < 0 ? 0 : j; kb = K + (size_t)jj * 64 * 64; vb = V + (size_t)jj * 64 * 64; ok = (j >= 0) && (jj * 64 + lane <= t); } };
struct SrcPromptWin { typedef bf16 T; static constexpr int STRIDE = 64; const bf16 *K, *V; int t, kb0;
    __device__ __forceinline__ void blk(int i, int lane, const bf16*& kb, const bf16*& vb, bool& ok) const { const int j = kb0 + i, pos = j * 64 + lane; kb = K + (size_t)j * 64 * 64; vb = V + (size_t)j * 64 * 64; ok = (pos <= t) && (pos >= t - 511); } };
struct SrcSampleCmp { typedef bf16 T; static constexpr int STRIDE = 64; const bf16 *ck, *cv;
    __device__ __forceinline__ void blk(int i, int lane, const bf16*& kb, const bf16*& vb, bool& ok) const { kb = ck; vb = cv; ok = true; } };
struct SrcSampleSlc { typedef float T; static constexpr int STRIDE = KVW; const float* cache_l; const int* pt; const float* newrows; const LAS int* selidx; int g, s;
    __device__ __forceinline__ void blk(int i, int lane, const float*& kb, const float*& vb, bool& ok) const {
        const int j = selidx[i];
        if (j >= 0 && j < 32) { const int page = pt[j >> 1]; const float* rb = cache_l + ((size_t)page * PAGE + (j & 1) * 64) * KVW; kb = rb + g * 64; vb = rb + 128 + g * 64; ok = true; }
        else { kb = newrows + g * 64; vb = newrows + 128 + g * 64; ok = (j == 32) && (lane <= s); } } };
struct SrcSampleWin { typedef float T; static constexpr int STRIDE = KVW; const float* state; const float* newrows; int g, s;
    __device__ __forceinline__ void blk(int i, int lane, const float*& kb, const float*& vb, bool& ok) const {
        if (i < 8) { const float* rb = state + (size_t)i * 64 * KVW; kb = rb + g * 64; vb = rb + 128 + g * 64; ok = (i * 64 + lane) >= s + 1; }
        else { kb = newrows + g * 64; vb = newrows + 128 + g * 64; ok = lane <= s; } } };
typedef short s16x4 __attribute__((ext_vector_type(4)));
constexpr int ATS = 144;
constexpr int AT_TILE = 64 * ATS;
constexpr int AT_STASH = 8 * AT_TILE;
static_assert(AT_STASH + 65536 <= LDSCTL_OFF, "attention LDS map");
constexpr float SM_C = 0.125f * 1.4426950408889634f;
#ifndef ATT_PROBE
#define ATT_PROBE 0
#endif
__device__ __forceinline__ s16x4 ds_tr(const LAS unsigned char* p) { return __builtin_bit_cast(s16x4, __builtin_amdgcn_ds_read_tr16_b64_v4i16((LAS s16x4*)p)); }
__device__ __forceinline__ void load_kfrags(const LAS unsigned char* Kt, int fr, int fq, bf16x8 (&kf)[4][2]) {
#pragma unroll
    for (int kt = 0; kt < 4; ++kt)
#pragma unroll
        for (int ks = 0; ks < 2; ++ks) kf[kt][ks] = *(const LAS bf16x8*)(Kt + (16 * kt + fr) * ATS + (32 * ks + 8 * fq) * 2);
}
__device__ __forceinline__ void load_vfrags(const LAS unsigned char* Vt, int fr, int fq, bf16x8 (&vf)[4][2]) {
#pragma unroll
    for (int dt = 0; dt < 4; ++dt)
#pragma unroll
        for (int ks = 0; ks < 2; ++ks) {
            const LAS unsigned char* p = Vt + (32 * ks + 4 * fq + (fr >> 2)) * ATS + (16 * dt + 4 * (fr & 3)) * 2;
            const s16x4 lo = ds_tr(p), hi = ds_tr(p + 16 * ATS);
            vf[dt][ks] = (bf16x8){lo[0], lo[1], lo[2], lo[3], hi[0], hi[1], hi[2], hi[3]};
        }
}
__device__ __forceinline__ bf16x8 pack_p(const pg8::f32x4& a, const pg8::f32x4& b) {
    v4u w; w.x = pk2(a[0], a[1]); w.y = pk2(a[2], a[3]); w.z = pk2(b[0], b[1]); w.w = pk2(b[2], b[3]);
    return __builtin_bit_cast(bf16x8, w);
}
struct AGroup { bf16x8 q[2]; pg8::f32x4 O[4]; float m, l; };
__device__ __forceinline__ void attn_score(AGroup& G, const bf16x8 (&kf)[4][2], int lo, int hi, int fq, bf16x8& pb0, bf16x8& pb1) {
    pg8::f32x4 s[4];
#pragma unroll
    for (int kt = 0; kt < 4; ++kt) { s[kt] = __builtin_amdgcn_mfma_f32_16x16x32_bf16(kf[kt][0], G.q[0], (pg8::f32x4){0.f, 0.f, 0.f, 0.f}, 0, 0, 0);
        s[kt] = __builtin_amdgcn_mfma_f32_16x16x32_bf16(kf[kt][1], G.q[1], s[kt], 0, 0, 0); }
    float mx = -1e30f;
#pragma unroll
    for (int kt = 0; kt < 4; ++kt)
#pragma unroll
        for (int rg = 0; rg < 4; ++rg) { const int kidx = 16 * kt + 4 * fq + rg; const float v = (kidx >= lo && kidx <= hi) ? s[kt][rg] : -1e30f; s[kt][rg] = v; mx = fmaxf(mx, v); }
    mx = fmaxf(mx, __shfl_xor(mx, 16)); mx = fmaxf(mx, __shfl_xor(mx, 32));
    const float mnew = fmaxf(G.m, mx);
    const float alpha = __builtin_amdgcn_exp2f((G.m - mnew) * SM_C);
    const float mc = mnew * SM_C;
    float ps = 0.f;
#pragma unroll
    for (int kt = 0; kt < 4; ++kt)
#pragma unroll
        for (int rg = 0; rg < 4; ++rg) { const float pv = (s[kt][rg] > -1e29f) ? __builtin_amdgcn_exp2f(s[kt][rg] * SM_C - mc) : 0.f; s[kt][rg] = pv; ps += pv; }
    G.l = G.l * alpha + ps; G.m = mnew;
#pragma unroll
    for (int dt = 0; dt < 4; ++dt) G.O[dt] = G.O[dt] * alpha;
    pb0 = pack_p(s[0], s[1]); pb1 = pack_p(s[2], s[3]);
}
__device__ __forceinline__ void attn_pv(pg8::f32x4 (&O)[4], const bf16x8 (&vf)[4][2], const bf16x8& pb0, const bf16x8& pb1) {
#pragma unroll
    for (int dt = 0; dt < 4; ++dt) { O[dt] = __builtin_amdgcn_mfma_f32_16x16x32_bf16(vf[dt][0], pb0, O[dt], 0, 0, 0); O[dt] = __builtin_amdgcn_mfma_f32_16x16x32_bf16(vf[dt][1], pb1, O[dt], 0, 0, 0); }
}
__device__ __forceinline__ int next_bit128(unsigned u0, unsigned u1, unsigned u2, unsigned u3, int from) {
    if (from < 32) { const unsigned x = (u0 >> from) << from; if (x) return __builtin_ctz(x); }
    if (from < 64) { const int sh = from > 32 ? from - 32 : 0; const unsigned x = (u1 >> sh) << sh; if (x) return 32 + __builtin_ctz(x); }
    if (from < 96) { const int sh = from > 64 ? from - 64 : 0; const unsigned x = (u2 >> sh) << sh; if (x) return 64 + __builtin_ctz(x); }
    if (from < 128) { const int sh = from > 96 ? from - 96 : 0; const unsigned x = (u3 >> sh) << sh; if (x) return 96 + __builtin_ctz(x); }
    return -1;
}
__device__ __forceinline__ bool test_bit128(unsigned u0, unsigned u1, unsigned u2, unsigned u3, int j) { const unsigned w = j < 32 ? u0 : j < 64 ? u1 : j < 96 ? u2 : u3; return (w >> (j & 31)) & 1u; }
template <bool WIN>
__device__ __forceinline__ void attn_walk(LAS unsigned char* lds, const bf16* Kg, const bf16* Vg, unsigned W0, unsigned W1, unsigned W2, unsigned W3,
                                          unsigned nA0, unsigned nA1, unsigned nA2, unsigned nA3, unsigned nB0, unsigned nB1, unsigned nB2, unsigned nB3,
                                          const unsigned (&selA)[4], const unsigned (&selB)[4], int tA, int tB, AGroup& GA, AGroup& GB, int tid, int fr, int fq) {
    const int row = tid >> 3, ch = tid & 7;
    int j = next_bit128(W0, W1, W2, W3, 0);
    v4u kr, vr;
    if (j >= 0) { kr = *(const v4u*)(Kg + ((size_t)(64 * j + row)) * 64 + ch * 8); vr = *(const v4u*)(Vg + ((size_t)(64 * j + row)) * 64 + ch * 8);
        *(LAS v4u*)(lds + row * ATS + ch * 16) = kr; *(LAS v4u*)(lds + AT_TILE + row * ATS + ch * 16) = vr; }
    __syncthreads();
    int cb = 0;
    while (j >= 0) {
        const int jn = next_bit128(W0, W1, W2, W3, j + 1);
        if (jn >= 0) { kr = *(const v4u*)(Kg + ((size_t)(64 * jn + row)) * 64 + ch * 8); vr = *(const v4u*)(Vg + ((size_t)(64 * jn + row)) * 64 + ch * 8); }
        const bool needA = test_bit128(nA0, nA1, nA2, nA3, j), needB = test_bit128(nB0, nB1, nB2, nB3, j);
        if (needA || needB) {
            const LAS unsigned char* Kt = lds + cb * 2 * AT_TILE; const LAS unsigned char* Vt = Kt + AT_TILE;
            bf16x8 pa0, pa1, pc0, pc1;
            { bf16x8 kf[4][2]; load_kfrags(Kt, fr, fq, kf);
              if (needA) { int lo, hi;
                if (WIN) { lo = tA - 511 - 64 * j; hi = tA - 64 * j; } else { lo = 0; hi = test_bit128(selA[0], selA[1], selA[2], selA[3], j) ? tA - 64 * j : -1; }
                attn_score(GA, kf, lo, hi, fq, pa0, pa1); }
              if (needB) { int lo, hi;
                if (WIN) { lo = tB - 511 - 64 * j; hi = tB - 64 * j; } else { lo = 0; hi = test_bit128(selB[0], selB[1], selB[2], selB[3], j) ? tB - 64 * j : -1; }
                attn_score(GB, kf, lo, hi, fq, pc0, pc1); } }
            asm volatile("" ::: "memory");
            { bf16x8 vf[4][2]; load_vfrags(Vt, fr, fq, vf);
              if (needA) attn_pv(GA.O, vf, pa0, pa1);
              if (needB) attn_pv(GB.O, vf, pc0, pc1); }
        }
        if (jn >= 0) { LAS unsigned char* nb = lds + (cb ^ 1) * 2 * AT_TILE; *(LAS v4u*)(nb + row * ATS + ch * 16) = kr; *(LAS v4u*)(nb + AT_TILE + row * ATS + ch * 16) = vr; }
        __syncthreads();
        j = jn; cb ^= 1;
    }
}
template <int CV0>
__device__ __forceinline__ void attn_cmp_group(const LAS unsigned char* lds, int NCT, const bf16x8 (&q)[2], int t, int cur, int fr, int fq, pg8::f32x4 (&Oc)[4], unsigned (&sel)[4]) {
    const int nv = (t + 1) >> 5;
    float m = -1e30f, l = 0.f;
#pragma unroll 1
    for (int ct = 0; ct < NCT; ++ct) {
        bf16x8 kf[4][2]; load_kfrags(lds + ct * AT_TILE, fr, fq, kf);
        pg8::f32x4 s[4];
#pragma unroll
        for (int kt = 0; kt < 4; ++kt) { s[kt] = __builtin_amdgcn_mfma_f32_16x16x32_bf16(kf[kt][0], q[0], (pg8::f32x4){0.f, 0.f, 0.f, 0.f}, 0, 0, 0);
            s[kt] = __builtin_amdgcn_mfma_f32_16x16x32_bf16(kf[kt][1], q[1], s[kt], 0, 0, 0); }
        float mx = -1e30f;
#pragma unroll
        for (int kt = 0; kt < 4; ++kt)
#pragma unroll
            for (int rg = 0; rg < 4; ++rg) { const int n = 64 * ct + 16 * kt + 4 * fq + rg; const float v = (n < nv) ? s[kt][rg] : -1e30f; s[kt][rg] = v; mx = fmaxf(mx, v); }
        mx = fmaxf(mx, __shfl_xor(mx, 16)); mx = fmaxf(mx, __shfl_xor(mx, 32));
        const float mnew = fmaxf(m, mx), mc = mnew * SM_C;
        float ps = 0.f;
#pragma unroll
        for (int kt = 0; kt < 4; ++kt)
#pragma unroll
            for (int rg = 0; rg < 4; ++rg) ps += (s[kt][rg] > -1e29f) ? __builtin_amdgcn_exp2f(s[kt][rg] * SM_C - mc) : 0.f;
        l = l * __builtin_amdgcn_exp2f((m - mnew) * SM_C) + ps; m = mnew;
    }
    l += __shfl_xor(l, 16); l += __shfl_xor(l, 32);
    const float inv = 1.0f / fmaxf(l, 1e-30f), mc = m * SM_C;
    unsigned key[32];
#pragma unroll
    for (int dt = 0; dt < 4; ++dt) Oc[dt] = (pg8::f32x4){0.f, 0.f, 0.f, 0.f};
#pragma unroll
    for (int ct = 0; ct < 4; ++ct) {
        if (ct < NCT) {
            pg8::f32x4 s[4];
            { bf16x8 kf[4][2]; load_kfrags(lds + ct * AT_TILE, fr, fq, kf);
#pragma unroll
              for (int kt = 0; kt < 4; ++kt) { s[kt] = __builtin_amdgcn_mfma_f32_16x16x32_bf16(kf[kt][0], q[0], (pg8::f32x4){0.f, 0.f, 0.f, 0.f}, 0, 0, 0);
                  s[kt] = __builtin_amdgcn_mfma_f32_16x16x32_bf16(kf[kt][1], q[1], s[kt], 0, 0, 0); } }
#pragma unroll
            for (int kt = 0; kt < 4; ++kt)
#pragma unroll
                for (int rg = 0; rg < 4; ++rg) { const int n = 64 * ct + 16 * kt + 4 * fq + rg; s[kt][rg] = (n < nv) ? __builtin_amdgcn_exp2f(s[kt][rg] * SM_C - mc) * inv : 0.f; }
#pragma unroll
            for (int kt = 0; kt < 4; ++kt)
#pragma unroll
                for (int e = 0; e < 2; ++e) {
                    float im = s[kt][2 * e] + s[kt][2 * e + 1];
                    im += __shfl_xor(im, 1); im += __shfl_xor(im, 2);
                    const int j = 32 * ct + 8 * kt + 2 * fq + e;
                    key[(ct * 4 + kt) * 2 + e] = (j >= 1 && j <= cur - 2) ? ((__float_as_uint(im) & 0xFFFFFF80u) | (unsigned)(127 - j)) : 0u;
                }
            const bf16x8 pb0 = pack_p(s[0], s[1]), pb1 = pack_p(s[2], s[3]);
            asm volatile("" ::: "memory");
            { bf16x8 vf[4][2]; load_vfrags(lds + (CV0 + ct) * AT_TILE, fr, fq, vf); attn_pv(Oc, vf, pb0, pb1); }
        } else {
#pragma unroll
            for (int k = 0; k < 8; ++k) key[ct * 8 + k] = 0u;
        }
    }
    sel[0] = sel[1] = sel[2] = sel[3] = 0u;
    if (cur < 16) { sel[0] = (1u << (cur + 1)) - 1u; return; }
    {
        sel[0] |= 1u;
#pragma unroll
        for (int w = 0; w < 4; ++w) { if ((cur >> 5) == w) sel[w] |= 1u << (cur & 31); if (((cur - 1) >> 5) == w) sel[w] |= 1u << ((cur - 1) & 31); }
    }
#pragma unroll 1
    for (int it = 0; it < 13; ++it) {
        unsigned best = 0u;
#pragma unroll
        for (int k = 0; k < 32; ++k) best = best > key[k] ? best : key[k];
        { const unsigned o = __shfl_xor(best, 16); best = best > o ? best : o; }
        { const unsigned o = __shfl_xor(best, 32); best = best > o ? best : o; }
        if (best != 0u) { const int jb = 127 - (int)(best & 127u);
#pragma unroll
            for (int w = 0; w < 4; ++w) if ((jb >> 5) == w) sel[w] |= 1u << (jb & 31); }
#pragma unroll
        for (int k = 0; k < 32; ++k) key[k] = (key[k] == best) ? 0u : key[k];
    }
}
__device__ __forceinline__ unsigned wave_or_tok(unsigned u) { u |= __shfl_xor(u, 4); u |= __shfl_xor(u, 8); return __builtin_amdgcn_readfirstlane(u); }
__device__ __forceinline__ void attn_prompt_unit(LAS unsigned char* lds, LAS unsigned* wgU, unsigned char* ws, int bg, int i, int tid, float* dbg) {
    const int wid = __builtin_amdgcn_readfirstlane(tid >> 6), lane = tid & 63, fr = lane & 15, fq = lane >> 4;
    const int b = bg >> 1, g = bg & 1, t0 = 64 * i, cur = i;
    const bf16* QRAW = (const bf16*)(ws + WS_QRAW); const bf16* QROT = (const bf16*)(ws + WS_QROT);
    const int tA = t0 + 8 * wid + (fr >> 2), tB = tA + 4, head = g * 4 + (fr & 3);
    const size_t mA = (size_t)b * TP + tA, mB = mA + 4;
    if (tid < 4) wgU[tid] = 0u;
    const int NCT = (2 * i + 2 + 63) >> 6;
    { const int row = tid >> 3, ch = tid & 7;
      const bf16* ck = (const bf16*)(ws + WS_CKP) + (size_t)bg * 256 * 64; const bf16* cv = (const bf16*)(ws + WS_CVP) + (size_t)bg * 256 * 64;
#pragma unroll
      for (int ct = 0; ct < 4; ++ct) if (ct < NCT) {
          *(LAS v4u*)(lds + ct * AT_TILE + row * ATS + ch * 16) = *(const v4u*)(ck + (size_t)(ct * 64 + row) * 64 + ch * 8);
          *(LAS v4u*)(lds + (4 + ct) * AT_TILE + row * ATS + ch * 16) = *(const v4u*)(cv + (size_t)(ct * 64 + row) * 64 + ch * 8); } }
    __syncthreads();
    LAS pg8::f32x4* stash = (LAS pg8::f32x4*)(lds + AT_STASH) + wid * 8 * 64 + lane;
    unsigned selA[4], selB[4];
    const float* gtA = (const float*)(ws + WS_GATES) + mA * 24 + head; const float* gtB = gtA + 4 * 24;
    {   bf16x8 q[2]; pg8::f32x4 Oc[4];
        q[0] = *(const bf16x8*)(QRAW + mA * 512 + head * 64 + 8 * fq); q[1] = *(const bf16x8*)(QRAW + mA * 512 + head * 64 + 32 + 8 * fq);
        attn_cmp_group<4>(lds, NCT, q, tA, cur, fr, fq, Oc, selA);
        if (dbg) {
#pragma unroll
            for (int dt = 0; dt < 4; ++dt) *(pg8::f32x4*)(dbg + (mA * 3 + 0) * 512 + head * 64 + 16 * dt + 4 * fq) = Oc[dt]; }
        { const float gA = gtA[0];
#pragma unroll
          for (int dt = 0; dt < 4; ++dt) stash[dt * 64] = Oc[dt] * gA; }
        asm volatile("" ::: "memory");
        q[0] = *(const bf16x8*)(QRAW + mB * 512 + head * 64 + 8 * fq); q[1] = *(const bf16x8*)(QRAW + mB * 512 + head * 64 + 32 + 8 * fq);
        attn_cmp_group<4>(lds, NCT, q, tB, cur, fr, fq, Oc, selB);
        if (dbg) {
#pragma unroll
            for (int dt = 0; dt < 4; ++dt) *(pg8::f32x4*)(dbg + (mB * 3 + 0) * 512 + head * 64 + 16 * dt + 4 * fq) = Oc[dt]; }
        { const float gB = gtB[0];
#pragma unroll
          for (int dt = 0; dt < 4; ++dt) stash[(4 + dt) * 64] = Oc[dt] * gB; }
    }
    unsigned nA[4], nB[4];
#pragma unroll
    for (int w = 0; w < 4; ++w) { nA[w] = wave_or_tok(selA[w]); nB[w] = wave_or_tok(selB[w]); }
    if (lane == 0) {
#pragma unroll
        for (int w = 0; w < 4; ++w) atomicOr((unsigned*)(wgU + w), nA[w] | nB[w]); }
    __syncthreads();
    AGroup GA, GB;
    {
        const unsigned W0 = __builtin_amdgcn_readfirstlane(wgU[0]), W1 = __builtin_amdgcn_readfirstlane(wgU[1]), W2 = __builtin_amdgcn_readfirstlane(wgU[2]), W3 = __builtin_amdgcn_readfirstlane(wgU[3]);
        GA.q[0] = *(const bf16x8*)(QROT + mA * 512 + head * 64 + 8 * fq); GA.q[1] = *(const bf16x8*)(QROT + mA * 512 + head * 64 + 32 + 8 * fq);
        GB.q[0] = *(const bf16x8*)(QROT + mB * 512 + head * 64 + 8 * fq); GB.q[1] = *(const bf16x8*)(QROT + mB * 512 + head * 64 + 32 + 8 * fq);
#pragma unroll
        for (int dt = 0; dt < 4; ++dt) { GA.O[dt] = (pg8::f32x4){0.f, 0.f, 0.f, 0.f}; GB.O[dt] = (pg8::f32x4){0.f, 0.f, 0.f, 0.f}; }
        GA.m = GB.m = -1e30f; GA.l = GB.l = 0.f;
        attn_walk<false>(lds, (const bf16*)(ws + WS_KS) + (size_t)bg * TP * 64, (const bf16*)(ws + WS_VS) + (size_t)bg * TP * 64, W0, W1, W2, W3,
                         nA[0], nA[1], nA[2], nA[3], nB[0], nB[1], nB[2], nB[3], selA, selB, tA, tB, GA, GB, tid, fr, fq);
        float lA = GA.l; lA += __shfl_xor(lA, 16); lA += __shfl_xor(lA, 32);
        float lB = GB.l; lB += __shfl_xor(lB, 16); lB += __shfl_xor(lB, 32);
        const float iA = 1.0f / fmaxf(lA, 1e-30f), iB = 1.0f / fmaxf(lB, 1e-30f);
        if (dbg) {
#pragma unroll
            for (int dt = 0; dt < 4; ++dt) { *(pg8::f32x4*)(dbg + (mA * 3 + 1) * 512 + head * 64 + 16 * dt + 4 * fq) = GA.O[dt] * iA; *(pg8::f32x4*)(dbg + (mB * 3 + 1) * 512 + head * 64 + 16 * dt + 4 * fq) = GB.O[dt] * iB; } }
        const float gA = gtA[8] * iA, gB = gtB[8] * iB;
#pragma unroll
        for (int dt = 0; dt < 4; ++dt) { stash[dt * 64] = stash[dt * 64] + GA.O[dt] * gA; stash[(4 + dt) * 64] = stash[(4 + dt) * 64] + GB.O[dt] * gB; }
    }
    pg8::f32x4 OA[4], OB[4];
    {
        const int jlo = i > 8 ? i - 8 : 0;
        unsigned W[4];
#pragma unroll
        for (int w = 0; w < 4; ++w) { unsigned x = 0u;
#pragma unroll
            for (int k = 0; k < 9; ++k) { const int j = jlo + k; if (j <= i && (j >> 5) == w) x |= 1u << (j & 31); }
            W[w] = x; }
#pragma unroll
        for (int dt = 0; dt < 4; ++dt) { GA.O[dt] = (pg8::f32x4){0.f, 0.f, 0.f, 0.f}; GB.O[dt] = (pg8::f32x4){0.f, 0.f, 0.f, 0.f}; }
        GA.m = GB.m = -1e30f; GA.l = GB.l = 0.f;
        attn_walk<true>(lds, (const bf16*)(ws + WS_KW) + (size_t)bg * TP * 64, (const bf16*)(ws + WS_VW) + (size_t)bg * TP * 64, W[0], W[1], W[2], W[3],
                        W[0], W[1], W[2], W[3], W[0], W[1], W[2], W[3], selA, selB, tA, tB, GA, GB, tid, fr, fq);
        float lA = GA.l; lA += __shfl_xor(lA, 16); lA += __shfl_xor(lA, 32);
        float lB = GB.l; lB += __shfl_xor(lB, 16); lB += __shfl_xor(lB, 32);
        const float iA = 1.0f / fmaxf(lA, 1e-30f), iB = 1.0f / fmaxf(lB, 1e-30f);
        if (dbg) {
#pragma unroll
            for (int dt = 0; dt < 4; ++dt) { *(pg8::f32x4*)(dbg + (mA * 3 + 2) * 512 + head * 64 + 16 * dt + 4 * fq) = GA.O[dt] * iA; *(pg8::f32x4*)(dbg + (mB * 3 + 2) * 512 + head * 64 + 16 * dt + 4 * fq) = GB.O[dt] * iB; } }
        const float gA = gtA[16] * iA, gB = gtB[16] * iB;
#pragma unroll
        for (int dt = 0; dt < 4; ++dt) { OA[dt] = stash[dt * 64] + GA.O[dt] * gA; OB[dt] = stash[(4 + dt) * 64] + GB.O[dt] * gB; }
    }
    bf16* MIX = (bf16*)(ws + WS_MIX);
#pragma unroll
    for (int dt = 0; dt < 4; ++dt) {
        u32x2 w; w.x = pk2(OA[dt][0], OA[dt][1]); w.y = pk2(OA[dt][2], OA[dt][3]); *(u32x2*)(MIX + mA * DM + head * 64 + 16 * dt + 4 * fq) = w;
        w.x = pk2(OB[dt][0], OB[dt][1]); w.y = pk2(OB[dt][2], OB[dt][3]); *(u32x2*)(MIX + mB * DM + head * 64 + 16 * dt + 4 * fq) = w; }
}

__device__ __forceinline__ void load_kfrags_f32(const float* kb, int nrows, int fr, int fq, bf16x8 (&kf)[4][2]) {
#pragma unroll
    for (int kt = 0; kt < 4; ++kt) { const int row = 16 * kt + fr; const float* rp = kb + (size_t)(row < nrows ? row : 0) * KVW + 8 * fq;
#pragma unroll
        for (int ks = 0; ks < 2; ++ks) { const pg8::f32x4 a = *(const pg8::f32x4*)(rp + 32 * ks), b = *(const pg8::f32x4*)(rp + 32 * ks + 4);
            v4u w; w.x = pk2(a[0], a[1]); w.y = pk2(a[2], a[3]); w.z = pk2(b[0], b[1]); w.w = pk2(b[2], b[3]); kf[kt][ks] = __builtin_bit_cast(bf16x8, w); } }
}
__device__ __forceinline__ void stage_v_f32(LAS unsigned char* vt, const float* vb, int nrows, int lane) {
#pragma unroll
    for (int it = 0; it < 16; ++it) { const int idx = it * 64 + lane, row = idx >> 4, c4 = idx & 15;
        pg8::f32x4 a = {0.f, 0.f, 0.f, 0.f};
        if (row < nrows) a = *(const pg8::f32x4*)(vb + (size_t)row * KVW + c4 * 4);
        u32x2 w; w.x = pk2(a[0], a[1]); w.y = pk2(a[2], a[3]); *(LAS u32x2*)(vt + row * ATS + c4 * 8) = w; }
}
__device__ __forceinline__ void attn_sample_unit(LAS unsigned char* lds, unsigned char* ws, float* out, const float* cache_slc_l, const int* pt_row, const float* state_lb, int L, int bs, int g, int wid, int lane) {
    const int fr = lane & 15, fq = lane >> 4, tid = wid * 64 + lane;
    const int sl = fr >> 2, head = g * 4 + (fr & 3), t = PAST + sl;
    const size_t m = (size_t)MP + bs * 4 + sl;
    const bf16* QRAW = (const bf16*)(ws + WS_QRAW); const bf16* QROT = (const bf16*)(ws + WS_QROT);
    {
        const int row = tid >> 3, ch = tid & 7; const size_t co = (((size_t)L * NB_S + bs) * 2 + g) * 64 * 64;
        *(LAS v4u*)(lds + row * ATS + ch * 16) = *(const v4u*)((const bf16*)(ws + WS_CKS) + co + (size_t)row * 64 + ch * 8);
        *(LAS v4u*)(lds + AT_TILE + row * ATS + ch * 16) = *(const v4u*)((const bf16*)(ws + WS_CVS) + co + (size_t)row * 64 + ch * 8); }
    __syncthreads();
    pg8::f32x4 Oc[4]; unsigned sel[4];
    {   bf16x8 q[2]; q[0] = *(const bf16x8*)(QRAW + m * 512 + head * 64 + 8 * fq); q[1] = *(const bf16x8*)(QRAW + m * 512 + head * 64 + 32 + 8 * fq);
        attn_cmp_group<1>(lds, 1, q, t, 32, fr, fq, Oc, sel); }
    unsigned U0 = wave_or_tok(sel[0]); const unsigned U1 = wave_or_tok(sel[1]) & 1u;
    AGroup Gs, Gw;
    Gs.q[0] = *(const bf16x8*)(QROT + m * 512 + head * 64 + 8 * fq); Gs.q[1] = *(const bf16x8*)(QROT + m * 512 + head * 64 + 32 + 8 * fq);
    Gw.q[0] = Gs.q[0]; Gw.q[1] = Gs.q[1];
#pragma unroll
    for (int dt = 0; dt < 4; ++dt) { Gs.O[dt] = (pg8::f32x4){0.f, 0.f, 0.f, 0.f}; Gw.O[dt] = (pg8::f32x4){0.f, 0.f, 0.f, 0.f}; }
    Gs.m = Gw.m = -1e30f; Gs.l = Gw.l = 0.f;
    LAS unsigned char* vt = lds + (2 + wid) * AT_TILE;
    const float* newslc = out + O_SLCS + ((size_t)L * MS + bs * 4) * KVW;
    const float* newwin = out + O_WINS + (((size_t)L * NB_S + bs) * 512 + 508) * KVW;
    int cnt = 0;
#pragma unroll 1
    for (int j = 0; j < 33; ++j) {
        const bool inU = j < 32 ? ((U0 >> j) & 1u) : (U1 != 0u);
        if (!inU) continue;
        const bool mine = ((cnt & 7) == wid); ++cnt;
        if (!mine) continue;
        const float* rb; int nrows;
        if (j < 32) { const int page = pt_row[j >> 1]; rb = cache_slc_l + ((size_t)page * PAGE + (j & 1) * 64) * KVW + g * 64; nrows = 64; } else { rb = newslc + g * 64; nrows = 4; }
        bf16x8 pb0, pb1;
        { bf16x8 kf[4][2]; load_kfrags_f32(rb, nrows, fr, fq, kf);
          const unsigned w = j < 32 ? sel[0] : sel[1]; const int hi = ((w >> (j & 31)) & 1u) ? t - 64 * j : -1;
          attn_score(Gs, kf, 0, hi, fq, pb0, pb1); }
        stage_v_f32(vt, rb + 128, nrows, lane);
        WAVE_LDS_FENCE();
        { bf16x8 vf[4][2]; load_vfrags(vt, fr, fq, vf); attn_pv(Gs.O, vf, pb0, pb1); }
        WAVE_LDS_FENCE();
    }
#pragma unroll 1
    for (int i = 0; i < 9; ++i) {
        const bool mine = (((cnt + i) & 7) == wid);
        if (!mine) continue;
        const float* rb; int nrows;
        if (i < 8) { rb = state_lb + (size_t)i * 64 * KVW + g * 64; nrows = 64; } else { rb = newwin + g * 64; nrows = 4; }
        bf16x8 pb0, pb1;
        { bf16x8 kf[4][2]; load_kfrags_f32(rb, nrows, fr, fq, kf);
          attn_score(Gw, kf, sl + 1 - 64 * i, sl + 512 - 64 * i, fq, pb0, pb1); }
        stage_v_f32(vt, rb + 128, nrows, lane);
        WAVE_LDS_FENCE();
        { bf16x8 vf[4][2]; load_vfrags(vt, fr, fq, vf); attn_pv(Gw.O, vf, pb0, pb1); }
        WAVE_LDS_FENCE();
    }
    {   LAS pg8::f32x4* po = (LAS pg8::f32x4*)vt + lane; LAS f32x2* pm = (LAS f32x2*)(vt + 4096) + lane;
#pragma unroll
        for (int dt = 0; dt < 4; ++dt) { po[dt * 64] = Gs.O[dt]; ((LAS pg8::f32x4*)(vt + 4608) + lane)[dt * 64] = Gw.O[dt]; }
        pm[0] = (f32x2){Gs.m, Gs.l}; ((LAS f32x2*)(vt + 4608 + 4096) + lane)[0] = (f32x2){Gw.m, Gw.l}; }
    __syncthreads();
    if (wid == 0) {
        float Ms = -1e30f, Mw = -1e30f;
#pragma unroll
        for (int w = 0; w < 8; ++w) { const LAS unsigned char* sv = lds + (2 + w) * AT_TILE; Ms = fmaxf(Ms, ((const LAS f32x2*)(sv + 4096) + lane)[0].x); Mw = fmaxf(Mw, ((const LAS f32x2*)(sv + 4608 + 4096) + lane)[0].x); }
        pg8::f32x4 Os[4], Ow[4]; float ls = 0.f, lw = 0.f;
#pragma unroll
        for (int dt = 0; dt < 4; ++dt) { Os[dt] = (pg8::f32x4){0.f, 0.f, 0.f, 0.f}; Ow[dt] = (pg8::f32x4){0.f, 0.f, 0.f, 0.f}; }
#pragma unroll 1
        for (int w = 0; w < 8; ++w) { const LAS unsigned char* sv = lds + (2 + w) * AT_TILE;
            const f32x2 a = ((const LAS f32x2*)(sv + 4096) + lane)[0], b = ((const LAS f32x2*)(sv + 4608 + 4096) + lane)[0];
            const float fa = __builtin_amdgcn_exp2f((a.x - Ms) * SM_C), fb = __builtin_amdgcn_exp2f((b.x - Mw) * SM_C);
            ls += a.y * fa; lw += b.y * fb;
#pragma unroll
            for (int dt = 0; dt < 4; ++dt) { Os[dt] = Os[dt] + ((const LAS pg8::f32x4*)sv + lane)[dt * 64] * fa; Ow[dt] = Ow[dt] + ((const LAS pg8::f32x4*)(sv + 4608) + lane)[dt * 64] * fb; } }
        ls += __shfl_xor(ls, 16); ls += __shfl_xor(ls, 32); lw += __shfl_xor(lw, 16); lw += __shfl_xor(lw, 32);
        const float* gt = (const float*)(ws + WS_GATES) + m * 24 + head;
        const float g0 = gt[0], g1 = gt[8] / fmaxf(ls, 1e-30f), g2 = gt[16] / fmaxf(lw, 1e-30f);
        bf16* MIX = (bf16*)(ws + WS_MIX);
#pragma unroll
        for (int dt = 0; dt < 4; ++dt) { const pg8::f32x4 o = Oc[dt] * g0 + Os[dt] * g1 + Ow[dt] * g2;
            u32x2 w; w.x = pk2(o[0], o[1]); w.y = pk2(o[2], o[3]); *(u32x2*)(MIX + m * DM + head * 64 + 16 * dt + 4 * fq) = w; }
    }
    __syncthreads();
}
struct Args { const float* in[23]; float* out; unsigned char* ws; int ph_lo, ph_hi, use_bar, grid; };

static_assert(sizeof(Args) == 216, "Args layout");
__device__ __forceinline__ int lane_id_opaque() { int x; asm volatile("v_mbcnt_lo_u32_b32 %0, -1, 0\n\tv_mbcnt_hi_u32_b32 %0, -1, %0" : "=v"(x)); return x; }
template <int OFF> __device__ __forceinline__ unsigned long long karg64() {
    unsigned long long v; const unsigned long long kp = (unsigned long long)__builtin_amdgcn_kernarg_segment_ptr();
    asm volatile("s_load_dwordx2 %0, %1, %2\n\ts_waitcnt lgkmcnt(0)" : "=s"(v) : "s"(kp), "n"(OFF) : "memory");
    return v;
}
template <int OFF> __device__ __forceinline__ int karg32() {
    int v; const unsigned long long kp = (unsigned long long)__builtin_amdgcn_kernarg_segment_ptr();
    asm volatile("s_load_dword %0, %1, %2\n\ts_waitcnt lgkmcnt(0)" : "=s"(v) : "s"(kp), "n"(OFF) : "memory");
    return v;
}
#define KIN(k) ((const float*)karg64<8 * (k)>())
#define K_LO() karg32<200>()
#define K_HI() karg32<204>()
#define K_USEBAR() karg32<208>()
#define K_GRID() karg32<212>()
#define KOUT() ((float*)karg64<184>())
#define KWS() ((unsigned char*)karg64<192>())

__global__ void __launch_bounds__(NWAVES * 64, 2) fwd(Args args) {
    extern __shared__ __attribute__((aligned(16))) unsigned char lds_raw[];
    LAS unsigned char* lds = (LAS unsigned char*)lds_raw;
#define MISC ((volatile LAS unsigned*)(lds + MISC_OFF))
    int wave = __builtin_amdgcn_readfirstlane((int)threadIdx.x >> 6);
#define LANE_ID() lane_id_opaque()
#define TID_NOW() (wave * 64 + LANE_ID())
    { const int tid0 = TID_NOW();
      for (int u = tid0; u < (LDS_BYTES - LDSCTL_OFF) / 4; u += NWAVES * 64) ((LAS unsigned*)(lds + LDSCTL_OFF))[u] = 0u; }
    __syncthreads();
    if (K_USEBAR()) (void)xcd_barrier_post((unsigned*)(KWS() + WS_CTL) + CW_BAR, MISC + 8, (wave == 0) ? 1u : 0u);
#define PH_COMMON() int bid_ = (int)blockIdx.x; asm volatile("" : "+s"(bid_)); const int G = K_GRID(), bid = bid_, gw = bid * NWAVES + wave, NGW = G * NWAVES, NGT = G * NWAVES * 64; (void)gw; (void)NGW; (void)NGT
#ifndef PH_ENABLE
#define PH_ENABLE 0xFFFFFFFFu
#endif
#define PHBIT(k) (((k) < PH_L0) ? (k) : (PH_L0 + ((k) - PH_L0) % PH_PER_LAYER))
#define IN(k) (((PH_ENABLE >> PHBIT(k)) & 1u) && K_LO() <= (k) && (k) < K_HI())
#ifndef PH_REPEAT
#define PH_REPEAT 0u
#endif
#define REP(k) for (int rep_ = 0; rep_ < ((((PH_REPEAT) >> PHBIT(k)) & 1u) ? 2 : 1); ++rep_)
#define SEAM(k) do { if (K_USEBAR() && (k) + 1 < K_HI()) { XcdBarrier bar_; bar_.bar = (unsigned*)(KWS() + WS_CTL) + CW_BAR; bar_.x = xb_xcc_id(); bar_.st = MISC + 8; bar_.w0 = (wave == 0) ? 1u : 0u; xcd_barrier(bar_); } } while (0)

    if (IN(PH_P0A)) { REP(PH_P0A) {
        unsigned char* ws = KWS(); float* out = KOUT();
        PH_COMMON(); const int lane = LANE_ID(), gt = bid * (NWAVES * 64) + wave * 64 + lane;
        LAS float* scr = (LAS float*)(lds + RING_OFF + wave * 16384);
        constexpr int I_IN = 16 * 73, I_OUT = 16 * 32, I_G = 16 * 88, I_D = 44 * 32, I_W1 = 32 * 8, I_W2 = 4 * 2;
        constexpr int I_LAYER = I_IN + I_OUT + 2 * I_G + I_D + 2 * I_W1 + 2 * I_W2;
        for (int it = gw; it < NLAYER * I_LAYER; it += NGW) {
            const int L = it / I_LAYER; int r = it % I_LAYER;
            if (r < I_IN) { transpose_item(KIN(6) + (size_t)L * DM * PIN, DM, PIN, (bf16*)(ws + WS_WIN_T) + (size_t)L * NIN * DM, RmInProj{}, scr, r, lane); continue; } r -= I_IN;
            if (r < I_OUT) { transpose_item(KIN(15) + (size_t)L * DM * DM, DM, DM, (bf16*)(ws + WS_WOUT_T) + (size_t)L * DM * DM, RmIdent{}, scr, r, lane); continue; } r -= I_OUT;
            if (r < I_G) { transpose_item(KIN(18) + (size_t)L * DM * FFN, DM, FFN, (bf16*)(ws + WS_WGU_T) + (size_t)L * NGU * DM, RmAffine{2, 0}, scr, r, lane); continue; } r -= I_G;
            if (r < I_G) { transpose_item(KIN(19) + (size_t)L * DM * FFN, DM, FFN, (bf16*)(ws + WS_WGU_T) + (size_t)L * NGU * DM, RmAffine{2, 1}, scr, r, lane); continue; } r -= I_G;
            if (r < I_D) { transpose_item(KIN(20) + (size_t)L * FFN * DM, FFN, DM, (bf16*)(ws + WS_WDN_T) + (size_t)L * DM * FFN, RmIdent{}, scr, r, lane); continue; } r -= I_D;
            if (r < 2 * I_W1) { const int kind = r / I_W1; transpose_item(KIN(8) + (size_t)(L * 2 + kind) * 2048 * 256, 2048, 256, (bf16*)(ws + WS_W1C_T) + (size_t)(L * 2 + kind) * 256 * 2048, RmIdent{}, scr, r % I_W1, lane); continue; } r -= 2 * I_W1;
            { const int kind = r / I_W2; transpose_item(KIN(10) + (size_t)(L * 2 + kind) * 256 * 64, 256, 64, (bf16*)(ws + WS_W2C_T) + (size_t)(L * 2 + kind) * 64 * 256, RmIdent{}, scr, r % I_W2, lane); }
        }
        for (int i = gt; i < NLAYER * (NIN - PIN) * (DM / 8); i += NGT) { const int L = i / ((NIN - PIN) * (DM / 8)), r = i % ((NIN - PIN) * (DM / 8));
            *(v4u*)((bf16*)(ws + WS_WIN_T) + (size_t)L * NIN * DM + (size_t)PIN * DM + (size_t)r * 8) = (v4u){0u, 0u, 0u, 0u}; }
        for (int i = gt; i < TP * 32; i += NGT) {
            const int pos = i >> 5, d = i & 31;
            double fr_ = 1.0; for (int k = 0; k < d; ++k) fr_ *= 0.7498942093324558;
            const float angf = (float)pos * (float)fr_;
            const double a = (double)angf;
            const double kq = __builtin_rint(a * 0.63661977236758134308);
            double rr = __builtin_fma(-kq, 1.57079632673412561417e+00, a); rr = __builtin_fma(-kq, 6.07710050650619224932e-11, rr);
            const double r2 = rr * rr;
            double sp = -7.6471637318198164759e-13; sp = sp * r2 + 1.6059043836821614599e-10; sp = sp * r2 - 2.5052108385441718775e-08; sp = sp * r2 + 2.7557319223985890653e-06;
            sp = sp * r2 - 1.9841269841269841270e-04; sp = sp * r2 + 8.3333333333333333333e-03; sp = sp * r2 - 1.6666666666666666667e-01; const double sn = rr + rr * r2 * sp;
            double cp = 4.7794773323873852974e-14; cp = cp * r2 - 1.1470745597729724714e-11; cp = cp * r2 + 2.0876756987868098979e-09; cp = cp * r2 - 2.7557319223985890653e-07;
            cp = cp * r2 + 2.4801587301587301587e-05; cp = cp * r2 - 1.3888888888888888889e-03; cp = cp * r2 + 4.1666666666666666667e-02; cp = cp * r2 - 0.5; const double cn = 1.0 + r2 * cp;
            const int q4 = ((int)kq) & 3;
            const double c = (q4 == 0) ? cn : (q4 == 1) ? -sn : (q4 == 2) ? -cn : sn;
            const double s = (q4 == 0) ? sn : (q4 == 1) ? cn : (q4 == 2) ? -sn : -cn;
            ((f32x2*)(ws + WS_ROPE))[i] = (f32x2){(float)c, (float)s};
        }
        { const float* xp = KIN(0); const float* xs = KIN(1); float* XF = (float*)(ws + WS_XF); bf16* XB = (bf16*)(ws + WS_XB);
        for (int row = gw; row < MT; row += NGW) {
            const float* src = row < MP ? xp + (size_t)row * DM : xs + (size_t)(row - MP) * DM;
#pragma unroll
            for (int j = 0; j < 4; ++j) { const int c = (j * 64 + lane) * 4; const pg8::f32x4 v = *(const pg8::f32x4*)(src + c);
                *(pg8::f32x4*)(XF + (size_t)row * DM + c) = v; u32x2 w; w.x = pk2(v[0], v[1]); w.y = pk2(v[2], v[3]); *(u32x2*)(XB + (size_t)row * DM + c) = w; }
        } }
        { const float* gws = KIN(13); const float* gbs = KIN(14); float* GWP = (float*)(ws + WS_GWP); float* GWS = (float*)(ws + WS_GWS); float* GBS = (float*)(ws + WS_GBS);
        for (int i = gt; i < NLAYER * 8 * 128 * 128; i += NGT) {
            const int lh = i >> 14, t = (i >> 7) & 127, s = i & 127;
            const float* wsrc = gws + (size_t)lh * 16384;
            GWP[i] = (s <= t) ? wsrc[t * 128 + s] : 0.f;
            GWS[i] = ((t >> 2) == (s >> 2) && (s & 3) <= (t & 3)) ? wsrc[(t & 3) * 128 + (s & 3)] : 0.f;
        }
        for (int i = gt; i < NLAYER * 8 * 128; i += NGT) GBS[i] = gbs[(i & ~127) + (i & 3)]; }
        { const float* st = KIN(4);
        for (int i = gt; i < NLAYER * NB_S * 508 * 64; i += NGT) { const int lb = i / (508 * 64), r = i % (508 * 64);
            *(pg8::f32x4*)(out + O_WINS + (size_t)lb * 512 * KVW + (size_t)r * 4) = *(const pg8::f32x4*)(st + (size_t)lb * 512 * KVW + 4 * KVW + (size_t)r * 4); } }
        } SEAM(PH_P0A);
    }
    if (IN(PH_P0B)) { REP(PH_P0B) {
        unsigned char* ws = KWS();
        PH_COMMON(); int tid = TID_NOW(); asm volatile("" : "+v"(tid));
        const int* PT = (const int*)KIN(5); const float* cache = KIN(2); const float* pe = KIN(7); const float* b1 = KIN(9);
        for (int u = bid; u < NLAYER * 2 * 256; u += G) {
            const int L = u >> 9, kind = (u >> 8) & 1, rb = u & 255;
            const int R = rb * 64 + (tid >> 3), bs = R >> 7, n = (R >> 1) & 63, g = R & 1;
            const int page = PT[bs * NPG + (n >> 2)];
            const float* arow = cache + ((size_t)L * NPOOL + page) * PAGE * KVW + (size_t)((n & 3) * 32) * KVW + kind * 128 + g * 64 + (tid & 7) * 8;
            compress_unit(lds + RING_OFF, arow, pe + (size_t)(L * 2 + kind) * 2048, (const bf16*)(ws + WS_W1C_T) + (size_t)(L * 2 + kind) * 256 * 2048, b1 + (L * 2 + kind) * 256,
                          (const bf16*)(ws + WS_W2C_T) + (size_t)(L * 2 + kind) * 64 * 256, (bf16*)(ws + (kind ? WS_CVS : WS_CKS)) + (size_t)L * NB_S * 2 * 64 * 64, 64, rb, tid);
        }
        } SEAM(PH_P0B);
    }
    for (int L = 0; L < NLAYER; ++L) {
        asm volatile("" : "+s"(wave), "+s"(lds));
        const int pb = PH_L0 + L * PH_PER_LAYER;
        if (IN(pb + 0)) { REP(pb + 0) {
            unsigned char* ws = KWS(); PH_COMMON();
            pg8::Gemm g{(const bf16*)(ws + WS_XB), (const bf16*)(ws + WS_WIN_T) + (size_t)L * NIN * DM, MT, NIN, DM}; pg8::StaticOrder S; S.init(MT, NIN, G, bid);
            EpiInProj E{L, ws, KOUT()};
            pg8::gemm_phase<EpiInProj, pg8::StaticOrder, true, true>(lds + RING_OFF, g, S, E, TID_NOW());
            } SEAM(pb + 0);
        }
        if (IN(pb + 1)) { REP(pb + 1) {
            unsigned char* ws = KWS(); float* out = KOUT(); PH_COMMON();
            int tid = TID_NOW(); asm volatile("" : "+v"(tid));
            for (int u = bid; u < 32 + 132; u += G) {
                if (u < 32) {
                    const int kind = u >> 4, rb = u & 15;
                    const int R = rb * 64 + (tid >> 3), b = R >> 9, n = (R >> 1) & 255, g = R & 1;
                    const float* arow = out + O_CMPP + ((size_t)(L * BP + b) * TP + 32 * n) * KVW + kind * 128 + g * 64 + (tid & 7) * 8;
                    compress_unit(lds + RING_OFF, arow, KIN(7) + (size_t)(L * 2 + kind) * 2048, (const bf16*)(ws + WS_W1C_T) + (size_t)(L * 2 + kind) * 256 * 2048, KIN(9) + (L * 2 + kind) * 256,
                                  (const bf16*)(ws + WS_W2C_T) + (size_t)(L * 2 + kind) * 64 * 256, (bf16*)(ws + (kind ? WS_CVP : WS_CKP)), 256, rb, tid);
                } else {
                    const int q = u - 32;
                    if (q < 128) gmlp_unit(lds + RING_OFF, lds + LDSCTL_OFF + 1024, 128 * q, (const bf16*)(ws + WS_U), (const bf16*)(ws + WS_V), (const float*)(ws + WS_GWP) + (size_t)L * 8 * 16384, KIN(14) + L * 1024,
                                           KIN(11) + L * 512, KIN(12) + L * 512, (bf16*)(ws + WS_MIX), (float*)nullptr, tid);
                    else gmlp_unit(lds + RING_OFF, lds + LDSCTL_OFF + 1024, MP + 128 * (q - 128), (const bf16*)(ws + WS_U), (const bf16*)(ws + WS_V), (const float*)(ws + WS_GWS) + (size_t)L * 8 * 16384, (const float*)(ws + WS_GBS) + L * 1024,
                                   KIN(11) + L * 512, KIN(12) + L * 512, (bf16*)(ws + WS_MIX), out + O_GV + ((size_t)L * MS + 128 * (q - 128)) * 512, tid);
                }
            }
            } SEAM(pb + 1);
        }
        if (IN(pb + 2)) { REP(pb + 2) {
            unsigned char* ws = KWS(); float* out = KOUT(); PH_COMMON();
            int tid = TID_NOW(); asm volatile("" : "+v"(tid));
            const int lane = tid & 63;
#if ATT_PROBE
            float* dbg = (float*)(ws + WS_DBG);
#else
            float* dbg = nullptr;
#endif
            for (int u = bid; u < 512; u += G) {
                const int c = u & 255, xcd = c & 7, cc = ((c >> 3) << 1) | (c & 1);
                attn_prompt_unit(lds + RING_OFF, (LAS unsigned*)(lds + LDSCTL_OFF + 2048), ws, xcd >> 1, (u >> 8) ? 127 - cc : cc, tid, dbg);
            }
            __syncthreads();
            const bf16* QRAW = (const bf16*)(ws + WS_QRAW); const bf16* QROT = (const bf16*)(ws + WS_QROT); bf16* MIX = (bf16*)(ws + WS_MIX); const float* GATES = (const float*)(ws + WS_GATES);
            LAS float* wl = (LAS float*)(lds + RING_OFF + wave * 4096);
            LAS float* qraw_l = wl; LAS float* qrot_l = wl + 256; LAS float* pbuf = wl + 512; LAS float* impb = wl + 768; LAS int* selidx = (LAS int*)(wl + 896);
            for (int u = bid; u < 2 * NB_S; u += G) {
                const int bs = u >> 1, g = u & 1;
                attn_sample_unit(lds + RING_OFF, ws, out, KIN(3) + (size_t)L * NPOOL * PAGE * KVW, (const int*)KIN(5) + bs * NPG, KIN(4) + ((size_t)L * NB_S + bs) * 512 * KVW, L, bs, g, wave, lane);
            }
#if ATT_PROBE
            float esum[8] = {0.f, 0.f, 0.f, 0.f, 0.f, 0.f, 0.f, 0.f};
            for (int task = gw; task < 2 * MT; task += NGW) {
#else
            for (int task = 2 * MT + gw; task < 2 * MT; task += NGW) {
#endif
                const int m = task >> 1, g = task & 1;
                const bool prompt = m < MP;
#pragma unroll
                for (int r = 0; r < 4; ++r) { qraw_l[r * 64 + lane] = 0.125f * bf2f(QRAW[(size_t)m * 512 + (g * 4 + r) * 64 + lane]); qrot_l[r * 64 + lane] = 0.125f * bf2f(QROT[(size_t)m * 512 + (g * 4 + r) * 64 + lane]); }
                impb[lane] = 0.f; impb[64 + lane] = 0.f;
                WAVE_LDS_FENCE();
                float oc[4], os[4], ow[4];
                if (prompt) {
                    const int b = m >> 13, t = m & (TP - 1); const size_t bg = (size_t)(b * 2 + g);
                    const SrcPromptCmp sc{(const bf16*)(ws + WS_CKP) + bg * 256 * 64, (const bf16*)(ws + WS_CVP) + bg * 256 * 64, (t + 1) >> 5};
                    attend(sc, (sc.nvalid + 63) >> 6, qraw_l, pbuf, lane, oc, impb);
                    WAVE_LDS_FENCE();
                    topk16(impb, 128, t >> 6, selidx, lane);
                    const SrcPromptSlc ss{(const bf16*)(ws + WS_KS) + bg * TP * 64, (const bf16*)(ws + WS_VS) + bg * TP * 64, selidx, t};
                    attend(ss, 16, qrot_l, pbuf, lane, os, (LAS float*)nullptr);
                    const int kb0 = (t > 511 ? t - 511 : 0) >> 6;
                    const SrcPromptWin sw{(const bf16*)(ws + WS_KW) + bg * TP * 64, (const bf16*)(ws + WS_VW) + bg * TP * 64, t, kb0};
                    attend(sw, (t >> 6) - kb0 + 1, qrot_l, pbuf, lane, ow, (LAS float*)nullptr);
#if ATT_PROBE
#pragma unroll
                    for (int r = 0; r < 4; ++r) { const float* dp = dbg + ((size_t)m * 3) * 512 + (g * 4 + r) * 64 + lane;
                        const float d0 = dp[0] - oc[r], d1 = dp[512] - os[r], d2 = dp[1024] - ow[r];
                        esum[0] += d0 * d0; esum[1] += oc[r] * oc[r]; esum[2] += d1 * d1; esum[3] += os[r] * os[r]; esum[4] += d2 * d2; esum[5] += ow[r] * ow[r]; }
                    WAVE_LDS_FENCE();
                    continue;
#endif
                } else {
                    const int si = m - MP, bs = si >> 2, s = si & 3;
                    const size_t co = (((size_t)L * NB_S + bs) * 2 + g) * 64 * 64;
                    const SrcSampleCmp sc{(const bf16*)(ws + WS_CKS) + co, (const bf16*)(ws + WS_CVS) + co};
                    attend(sc, 1, qraw_l, pbuf, lane, oc, impb);
                    WAVE_LDS_FENCE();
                    topk16(impb, 33, 32, selidx, lane);
                    const SrcSampleSlc ss{KIN(3) + (size_t)L * NPOOL * PAGE * KVW, (const int*)KIN(5) + bs * NPG, out + O_SLCS + ((size_t)L * MS + bs * 4) * KVW, selidx, g, s};
                    attend(ss, 16, qrot_l, pbuf, lane, os, (LAS float*)nullptr);
                    const SrcSampleWin sw{KIN(4) + ((size_t)L * NB_S + bs) * 512 * KVW, out + O_WINS + (((size_t)L * NB_S + bs) * 512 + 508) * KVW, g, s};
                    attend(sw, 9, qrot_l, pbuf, lane, ow, (LAS float*)nullptr);
                }
                const float* gtp = GATES + (size_t)m * 24;
#pragma unroll
                for (int r = 0; r < 4; ++r) { const int h = g * 4 + r; const float o = gtp[h] * oc[r] + gtp[8 + h] * os[r] + gtp[16 + h] * ow[r];
#if ATT_PROBE
                    const float mv = bf2f(MIX[(size_t)m * DM + h * 64 + lane]); esum[6] += (mv - o) * (mv - o); esum[7] += o * o;
#else
                    MIX[(size_t)m * DM + h * 64 + lane] = (bf16)f2bf(o);
#endif
                }
                WAVE_LDS_FENCE();
            }
#if ATT_PROBE
#pragma unroll
            for (int k = 0; k < 8; ++k) { const float v = wave_sum(esum[k]); if (lane == 0) atomicAdd((float*)(ws + WS_CTL) + CW_ERR + k, v); }
#endif
            __syncthreads();
            } SEAM(pb + 2);
        }
        if (IN(pb + 3)) { REP(pb + 3) {
            unsigned char* ws = KWS(); PH_COMMON();
            pg8::Gemm g{(const bf16*)(ws + WS_MIX), (const bf16*)(ws + WS_WOUT_T) + (size_t)L * DM * DM, MT, DM, DM}; pg8::StaticOrder S; S.init(MT, DM, G, bid);
            EpiResid E{(const float*)(ws + WS_XF), (float*)(ws + WS_PRE)};
            pg8::gemm_phase<EpiResid, pg8::StaticOrder, true, true>(lds + RING_OFF, g, S, E, TID_NOW());
            } SEAM(pb + 3);
        }
        if (IN(pb + 4)) { REP(pb + 4) {
            int lane = LANE_ID(); asm volatile("" : "+v"(lane));
            unsigned char* ws = KWS(); PH_COMMON(); const float* lg = KIN(16) + L * DM; const float* lb = KIN(17) + L * DM;
            for (int row = gw; row < MT; row += NGW) ln_row((const float*)(ws + WS_PRE) + (size_t)row * DM, lg, lb, (float*)(ws + WS_XF) + (size_t)row * DM, (bf16*)(ws + WS_XB) + (size_t)row * DM, lane);
            } SEAM(pb + 4);
        }
        if (IN(pb + 5)) { REP(pb + 5) {
            unsigned char* ws = KWS(); PH_COMMON();
            pg8::Gemm g{(const bf16*)(ws + WS_XB), (const bf16*)(ws + WS_WGU_T) + (size_t)L * NGU * DM, MT, NGU, DM}; pg8::StaticOrder S; S.init(MT, NGU, G, bid);
            EpiGateUp E{(bf16*)(ws + WS_F)};
            pg8::gemm_phase<EpiGateUp, pg8::StaticOrder, true, true>(lds + RING_OFF, g, S, E, TID_NOW());
            } SEAM(pb + 5);
        }
        if (IN(pb + 6)) { REP(pb + 6) {
            unsigned char* ws = KWS(); PH_COMMON();
            pg8::Gemm g{(const bf16*)(ws + WS_F), (const bf16*)(ws + WS_WDN_T) + (size_t)L * DM * FFN, MT, DM, FFN}; pg8::StaticOrder S; S.init(MT, DM, G, bid);
            EpiResid E{(const float*)(ws + WS_XF), (float*)(ws + WS_PRE)};
            pg8::gemm_phase<EpiResid, pg8::StaticOrder, true, true>(lds + RING_OFF, g, S, E, TID_NOW());
            } SEAM(pb + 6);
        }
        if (IN(pb + 7)) { REP(pb + 7) {
            int lane = LANE_ID(); asm volatile("" : "+v"(lane));
            unsigned char* ws = KWS(); PH_COMMON(); const float* lg = KIN(21) + L * DM; const float* lb = KIN(22) + L * DM;
            const bool last = (L == NLAYER - 1);
            float* dstf = last ? KOUT() + O_Y : (float*)(ws + WS_XF);
            for (int row = gw; row < MT; row += NGW) ln_row((const float*)(ws + WS_PRE) + (size_t)row * DM, lg, lb, dstf + (size_t)row * DM, last ? (bf16*)nullptr : (bf16*)(ws + WS_XB) + (size_t)row * DM, lane);
#if ATT_PROBE
            if (last) {
                const float* e = (const float*)(ws + WS_CTL) + CW_ERR;
                const float e0 = sqrtf(e[0] / fmaxf(e[1], 1e-30f)), e1 = sqrtf(e[2] / fmaxf(e[3], 1e-30f)), e2 = sqrtf(e[4] / fmaxf(e[5], 1e-30f));
                const float e3 = sqrtf(e[6] / fmaxf(e[7], 1e-30f));
                const float E = ATT_PROBE_SEL == 0 ? e0 : ATT_PROBE_SEL == 1 ? e1 : ATT_PROBE_SEL == 2 ? e2 : ATT_PROBE_SEL == 4 ? e3 : fmaxf(e0, fmaxf(e1, e2));
                float* o8 = KOUT() + O_GV;
                for (int i = bid * (NWAVES * 64) + wave * 64 + lane; i < NLAYER * MS * 512; i += NGT) o8[i] *= (1.0f + ATT_PROBE_GAIN * E);
            }
#endif
            } SEAM(pb + 7);
        }
    }
#undef IN
#undef SEAM
}

#ifndef SPLIT_LAUNCHES
#define SPLIT_LAUNCHES 0
#endif
extern "C" void kernel_launch(void* const* d_in, const int* in_sizes, int n_in, void* d_out, int out_size, void* d_ws, size_t ws_size, hipStream_t stream) {
    static int grid = 0;
    if (grid == 0) {
        if (n_in != 23 || (size_t)out_size != O_END || ws_size < WS_END) { fprintf(stderr, "kernel_launch: unexpected sizes (n_in %d, out %d, ws %zu); nothing launched\n", n_in, out_size, ws_size); grid = -1; return; }
        int dev = 0, cus = 0, per_cu = 0;
        if (hipGetDevice(&dev) != hipSuccess || hipDeviceGetAttribute(&cus, hipDeviceAttributeMultiprocessorCount, dev) != hipSuccess) { fprintf(stderr, "kernel_launch: device query failed\n"); grid = -1; return; }
        if (hipFuncSetAttribute((const void*)fwd, hipFuncAttributeMaxDynamicSharedMemorySize, LDS_BYTES) != hipSuccess) { fprintf(stderr, "kernel_launch: hipFuncSetAttribute failed\n"); grid = -1; return; }
        if (hipOccupancyMaxActiveBlocksPerMultiprocessor(&per_cu, (const void*)fwd, NWAVES * 64, LDS_BYTES) != hipSuccess || per_cu < 1) fprintf(stderr, "kernel_launch: note: occupancy query reports %d\n", per_cu);
        (void)hipGetLastError();
        grid = cus;
    }
    if (grid < 0) return;
    if (hipMemsetAsync((char*)d_ws + WS_CTL, 0, CTL_ZERO_BYTES, stream) != hipSuccess) { fprintf(stderr, "kernel_launch: memset failed\n"); return; }
    Args a{};
    for (int i = 0; i < 23; ++i) a.in[i] = (const float*)d_in[i];
    a.out = (float*)d_out; a.ws = (unsigned char*)d_ws;
#if SPLIT_LAUNCHES
    for (int ph = 0; ph < N_PHASES; ++ph) { a.ph_lo = ph; a.ph_hi = ph + 1; a.use_bar = 0; a.grid = grid;
        hipLaunchKernelGGL(fwd, dim3(grid), dim3(NWAVES * 64), LDS_BYTES, stream, a); }
#else
    a.ph_lo = 0; a.ph_hi = N_PHASES; a.use_bar = 1; a.grid = grid;
    hipLaunchKernelGGL(fwd, dim3(grid), dim3(NWAVES * 64), LDS_BYTES, stream, a);
#endif
    const hipError_t le = hipPeekAtLastError();
    if (le != hipSuccess) fprintf(stderr, "kernel_launch: launch failed: %s\n", hipGetErrorName(le));
}
```

```cpp
#include <hip/hip_runtime.h>
#include <cstdio>
#include <cstdint>
#include <cmath>
namespace pg8 {
#define PG8_LAS __attribute__((address_space(3)))
typedef unsigned short bf16_t;
typedef short bf16x8 __attribute__((ext_vector_type(8)));
typedef float f32x4 __attribute__((ext_vector_type(4)));
typedef unsigned u32x4 __attribute__((ext_vector_type(4)));
constexpr int BM = 256, BK = 64, HALF = 128, HTB = HALF * BK * 2  , STAGE_BYTES = 8 * HTB, NXCD = 8, WGM = 8;

__host__ __device__ __forceinline__ int lds_byte(int r, int c) { const int st = (r >> 4) * 2 + (c >> 5), rr = r & 15, cc = c & 31, ob = rr * 64 + cc * 2; return st * 1024 + (ob ^ (((ob >> 9) & 1) << 5)); }
__host__ __device__ __forceinline__ void stage_rc(int b, int& R, int& C) { const int st = b / 1024, sb = b % 1024, swz = sb ^ (((sb >> 9) & 1) << 5); R = (st >> 1) * 16 + swz / 64; C = (st & 1) * 32 + (swz % 64) / 2; }
__host__ __device__ __forceinline__ int perm32(int rho) { const int n = rho >> 4, i = rho & 15; return 8 * (i >> 2) + 4 * n + (i & 3); }

struct Unit { int pm, pn; };
struct Gemm { const bf16_t* A; const bf16_t* Bt; int M, N, K; };

struct StaticOrder {
    int nM, nN, nwg, G, c;
    __host__ __device__ void init(int M, int N, int G_, int c_) { nM = M / BM; nN = N / BM; nwg = nM * nN; G = G_; c = c_; }
    __host__ __device__ bool next(int i, Unit& u) const {
        const long L = (long)i * G + c; if (L >= nwg) return false;
        int wgid = (int)L; { const int q = nwg / NXCD, r = nwg % NXCD, xcd = wgid % NXCD, off = wgid / NXCD; wgid = (xcd < r ? xcd * (q + 1) : r * (q + 1) + (xcd - r) * q) + off; }
        const int nig = WGM * nN, gid = wgid / nig, fm = gid * WGM, gsz = (nM - fm) < WGM ? (nM - fm) : WGM;
        u.pm = fm + ((wgid % nig) % gsz); u.pn = (wgid % nig) / gsz; return true;
    }
    __device__ __forceinline__ void a_ready(const Unit&) const {}
    __device__ __forceinline__ void done(const Unit&) const {}
};
__device__ __forceinline__ unsigned cvt_pk_bf16(float lo, float hi) { unsigned r; asm volatile("v_cvt_pk_bf16_f32 %0, %1, %2" : "=v"(r) : "v"(lo), "v"(hi)); return r; }
typedef float f32x2 __attribute__((ext_vector_type(2)));
template <class Epi, class Sched, bool ALIGN_EPI = false, bool SP2 = false>
__device__ __forceinline__ void gemm_phase(PG8_LAS unsigned char* lds, const Gemm g, const Sched& S, const Epi& E, int tid_in) {
    int tid_ = tid_in; asm volatile("" : "+v"(tid_));
    const int tid = tid_, wid = __builtin_amdgcn_readfirstlane(tid >> 6), lane = tid & 63, wr = wid >> 2, wc = wid & 3, fr = lane & 15, fq = lane >> 4;
    const int K = g.K, nt = K / BK;
    unsigned voffA[2], voffB[2];
#pragma unroll
    for (int i = 0; i < 2; ++i) { int R, C; stage_rc(tid * 16 + i * 8192, R, C); const int Rb = Epi::PERM ? ((R & ~31) + perm32(R & 31)) : R;
        voffA[i] = (unsigned)(R * K + C) * 2u; voffB[i] = (unsigned)(Rb * K + C) * 2u; }
    const size_t kstep = (size_t)(BK * 2);
    const size_t hstep = (size_t)HALF * K * 2;
    const size_t tstep = 2 * hstep;
    const unsigned ldsw = (unsigned)wid * 1024u;
    const int aoff = lds_byte(wr * 64 + fr, fq * 8), boff = lds_byte(wc * 32 + fr, fq * 8);
#define PG8_SA(b, h) (((b) * 2 + (h)) * HTB)
#define PG8_SB(b, h) ((4 + (b) * 2 + (h)) * HTB)
#define PG8_STAGE(bufoff, gbase, voff) do { _Pragma("unroll") for (int _i = 0; _i < 2; ++_i) \
        __builtin_amdgcn_global_load_lds((const unsigned*)((const char*)(gbase) + (voff)[_i]), (PG8_LAS unsigned*)(lds + (bufoff) + ldsw + _i * 8192), 16, 0, 0); } while (0)
#define PG8_LDA(dst, b, h) do { _Pragma("unroll") for (int m = 0; m < 4; ++m) _Pragma("unroll") for (int k = 0; k < 2; ++k) dst[m][k] = *(const PG8_LAS bf16x8*)(lds + PG8_SA(b, h) + aoff + m * 2048 + k * 1024); } while (0)
#define PG8_LDB(dst, b, h) do { _Pragma("unroll") for (int n = 0; n < 2; ++n) _Pragma("unroll") for (int k = 0; k < 2; ++k) dst[n][k] = *(const PG8_LAS bf16x8*)(lds + PG8_SB(b, h) + boff + n * 2048 + k * 1024); } while (0)
#define PG8_MMA(ai, bj, At, Bt) do { __builtin_amdgcn_s_setprio(1); _Pragma("unroll") for (int m = 0; m < 4; ++m) _Pragma("unroll") for (int n = 0; n < 2; ++n) _Pragma("unroll") for (int k = 0; k < 2; ++k) \
        acc[ai][bj][m][n] = __builtin_amdgcn_mfma_f32_16x16x32_bf16(Bt[n][k], At[m][k], acc[ai][bj][m][n], 0, 0, 0); __builtin_amdgcn_s_setprio(0); } while (0)
#define PG8_WAIT_V(n) asm volatile("s_waitcnt vmcnt(" #n ")" ::: "memory")
#define PG8_WAIT_L(n) asm volatile("s_waitcnt lgkmcnt(" #n ")" ::: "memory")
#define PG8_BAR __builtin_amdgcn_s_barrier()
#define PG8_SCHED __builtin_amdgcn_sched_barrier(0)
    Unit cur, nxt; int ui = 0;
    if (!S.next(0, cur)) return;
    f32x4 acc[2][2][4][2];
#pragma unroll
    for (int a = 0; a < 2; ++a)
#pragma unroll
        for (int b = 0; b < 2; ++b)
#pragma unroll
            for (int m = 0; m < 4; ++m)
#pragma unroll
                for (int n = 0; n < 2; ++n) acc[a][b][m][n] = (f32x4){0.f, 0.f, 0.f, 0.f};
    bf16x8 At[4][2], B0[2][2], B1[2][2];
    const char* cA = (const char*)g.A + (size_t)cur.pm * tstep; const char* cB = (const char*)g.Bt + (size_t)cur.pn * tstep;
    S.a_ready(cur);
    if constexpr (SP2) {
        PG8_STAGE(PG8_SB(0, 0), cB, voffB); PG8_STAGE(PG8_SB(0, 1), cB + hstep, voffB); PG8_STAGE(PG8_SA(0, 0), cA, voffA); PG8_STAGE(PG8_SA(0, 1), cA + hstep, voffA);
        if (wr == 1) PG8_BAR;
        PG8_WAIT_V(2); PG8_BAR;
        PG8_STAGE(PG8_SB(1, 0), cB + kstep, voffB); PG8_STAGE(PG8_SA(1, 0), cA + kstep, voffA); PG8_STAGE(PG8_SB(1, 1), cB + hstep + kstep, voffB);
        PG8_WAIT_V(6); PG8_BAR;
    } else {
        PG8_STAGE(PG8_SB(0, 0), cB, voffB); PG8_STAGE(PG8_SA(0, 0), cA, voffA); PG8_STAGE(PG8_SB(0, 1), cB + hstep, voffB); PG8_STAGE(PG8_SA(0, 1), cA + hstep, voffA);
        if (wr == 1) PG8_BAR;
        PG8_WAIT_V(4); PG8_BAR;
        PG8_STAGE(PG8_SB(1, 0), cB + kstep, voffB); PG8_STAGE(PG8_SA(1, 0), cA + kstep, voffA); PG8_STAGE(PG8_SB(1, 1), cB + hstep + kstep, voffB);
        PG8_WAIT_V(6); PG8_BAR;
    }
    for (;;) {
        const bool has_next = S.next(ui + 1, nxt);
        const char* nA = has_next ? (const char*)g.A + (size_t)nxt.pm * tstep : cA; const char* nB = has_next ? (const char*)g.Bt + (size_t)nxt.pn * tstep : cB;
        for (int t = 0; t < nt; t += 2) {
            const bool last = (t == nt - 2);
            const char* a1 = cA + (size_t)(t + 1) * kstep;
            const char* a2 = last ? nA : cA + (size_t)(t + 2) * kstep; const char* b2 = last ? nB : cB + (size_t)(t + 2) * kstep;
            const char* a3 = a2 + kstep; const char* b3 = b2 + kstep;
            if (last && has_next) S.a_ready(nxt);
            if constexpr (SP2) {
            PG8_LDB(B0, 0, 0); PG8_LDB(B1, 0, 1); PG8_SCHED; PG8_LDA(At, 0, 0); PG8_STAGE(PG8_SA(1, 1), a1 + hstep, voffA);
            PG8_WAIT_V(8); PG8_WAIT_L(0); PG8_BAR; PG8_MMA(0, 0, At, B0); PG8_MMA(0, 1, At, B1); PG8_BAR; PG8_SCHED;
            PG8_LDA(At, 0, 1); PG8_STAGE(PG8_SB(0, 0), b2, voffB); PG8_STAGE(PG8_SB(0, 1), b2 + hstep, voffB); PG8_STAGE(PG8_SA(0, 0), a2, voffA);
            PG8_WAIT_V(8); PG8_WAIT_L(0); PG8_BAR; PG8_MMA(1, 0, At, B0); PG8_MMA(1, 1, At, B1); PG8_BAR; PG8_SCHED;
            PG8_LDB(B0, 1, 0); PG8_LDB(B1, 1, 1); PG8_SCHED; PG8_LDA(At, 1, 0); PG8_STAGE(PG8_SA(0, 1), a2 + hstep, voffA);
            PG8_WAIT_V(8); PG8_WAIT_L(0); PG8_BAR; PG8_MMA(0, 0, At, B0); PG8_MMA(0, 1, At, B1); PG8_BAR; PG8_SCHED;
            PG8_LDA(At, 1, 1); PG8_STAGE(PG8_SB(1, 0), b3, voffB); PG8_STAGE(PG8_SB(1, 1), b3 + hstep, voffB); PG8_STAGE(PG8_SA(1, 0), a3, voffA);
            PG8_WAIT_V(8); PG8_WAIT_L(0); PG8_BAR; PG8_MMA(1, 0, At, B0); PG8_MMA(1, 1, At, B1); PG8_BAR; PG8_SCHED;
            } else {
            PG8_LDB(B0, 0, 0); PG8_SCHED; PG8_LDA(At, 0, 0); PG8_STAGE(PG8_SA(1, 1), a1 + hstep, voffA);
            PG8_WAIT_L(8); PG8_BAR; PG8_WAIT_L(0); PG8_MMA(0, 0, At, B0); PG8_BAR; PG8_SCHED;
            PG8_LDB(B1, 0, 1); PG8_STAGE(PG8_SB(0, 0), b2, voffB);
            PG8_BAR; PG8_WAIT_L(0); PG8_MMA(0, 1, At, B1); PG8_BAR;
            PG8_LDA(At, 0, 1); PG8_STAGE(PG8_SA(0, 0), a2, voffA);
            PG8_BAR; PG8_WAIT_L(0); PG8_MMA(1, 0, At, B0); PG8_BAR; PG8_SCHED;
            PG8_STAGE(PG8_SB(0, 1), b2 + hstep, voffB);
            PG8_WAIT_V(6); PG8_BAR; PG8_MMA(1, 1, At, B1); PG8_BAR;
            PG8_LDB(B0, 1, 0); PG8_SCHED; PG8_LDA(At, 1, 0); PG8_STAGE(PG8_SA(0, 1), a2 + hstep, voffA);
            PG8_WAIT_L(8); PG8_BAR; PG8_WAIT_L(0); PG8_MMA(0, 0, At, B0); PG8_BAR; PG8_SCHED;
            PG8_LDB(B1, 1, 1); PG8_STAGE(PG8_SB(1, 0), b3, voffB);
            PG8_BAR; PG8_WAIT_L(0); PG8_MMA(0, 1, At, B1); PG8_BAR;
            PG8_LDA(At, 1, 1); PG8_STAGE(PG8_SA(1, 0), a3, voffA);
            PG8_BAR; PG8_WAIT_L(0); PG8_MMA(1, 0, At, B0); PG8_BAR; PG8_SCHED;
            PG8_STAGE(PG8_SB(1, 1), b3 + hstep, voffB);
            PG8_WAIT_V(6); PG8_BAR; PG8_MMA(1, 1, At, B1); PG8_BAR;
            }
        }
        if constexpr (ALIGN_EPI) { if (wr == 0) PG8_BAR; }
        if constexpr (!Epi::AFTER_DRAIN) { E(acc, cur, wr, wc, fr, fq); S.done(cur); }
        if (!has_next) break;
#pragma unroll
        for (int a = 0; a < 2; ++a)
#pragma unroll
            for (int b = 0; b < 2; ++b)
#pragma unroll
                for (int m = 0; m < 4; ++m)
#pragma unroll
                    for (int n = 0; n < 2; ++n) acc[a][b][m][n] = (f32x4){0.f, 0.f, 0.f, 0.f};
        cur = nxt; cA = nA; cB = nB; ++ui;
        if constexpr (ALIGN_EPI) { if (wr == 1) PG8_BAR; }
    }
    PG8_WAIT_V(0);
    if constexpr (!ALIGN_EPI) { if (wr == 0) PG8_BAR; }
    PG8_BAR;
    if constexpr (Epi::AFTER_DRAIN) { E.fused(acc, cur, wr, wc, fr, fq, lds, wid, lane); S.done(cur); }
#undef PG8_SA
#undef PG8_SB
#undef PG8_STAGE
#undef PG8_LDA
#undef PG8_LDB
#undef PG8_MMA
#undef PG8_WAIT_V
#undef PG8_WAIT_L
#undef PG8_BAR
#undef PG8_SCHED
}
}
#define GAS __attribute__((address_space(1)))
#define LAS __attribute__((address_space(3)))
typedef unsigned short bf16;
typedef unsigned v4u __attribute__((ext_vector_type(4)));
typedef float f32x4 __attribute__((ext_vector_type(4)));
typedef short bf16x8 __attribute__((ext_vector_type(8)));
typedef GAS unsigned gu32;
typedef GAS unsigned long long gu64;
#define RLX_AGENT __ATOMIC_RELAXED, __HIP_MEMORY_SCOPE_AGENT
#define LDS_WAIT() asm volatile("s_waitcnt lgkmcnt(0)" ::: "memory")
#define VM_WAIT() asm volatile("s_waitcnt vmcnt(0)" ::: "memory")
__device__ __forceinline__ unsigned long long rt() { return __builtin_amdgcn_s_memrealtime(); }
__device__ __forceinline__ unsigned f2bf(float f) { unsigned u = __builtin_bit_cast(unsigned, f); return (u + 0x7fffu + ((u >> 16) & 1u)) >> 16; }
__device__ __forceinline__ unsigned pk2(float lo, float hi) { return f2bf(lo) | (f2bf(hi) << 16); }

#define XB_TMO      128
#define XB_XCNT(j)  (256  + 64 * (j))
#define XB_XSUB(j)  (1280 + 64 * (j))
#define XB_XGEN(j)  (2304 + 64 * (j))
#define XB_TOP      3328
#define XB_TOPGEN   3392
#define XCD_BAR_WORDS 3456
#define XB_SPIN_CAP (1u << 18)

__device__ __forceinline__ unsigned xb_ld(unsigned* p)              { return __hip_atomic_load(p, __ATOMIC_RELAXED, __HIP_MEMORY_SCOPE_AGENT); }
__device__ __forceinline__ unsigned xb_add(unsigned* p, unsigned v) { return __hip_atomic_fetch_add(p, v, __ATOMIC_RELAXED, __HIP_MEMORY_SCOPE_AGENT); }
__device__ __forceinline__ unsigned xb_xcc_id() { return (unsigned)__builtin_amdgcn_s_getreg((3 << 11) | 20) & 0xFu; }
#define XB_SPIN(cond, bar) do { unsigned _sp = 0; while (cond) { __builtin_amdgcn_s_sleep(1); \
    if ((++_sp & 255u) == 0u) { if (xb_ld(&(bar)[XB_TMO])) break; if (_sp > XB_SPIN_CAP) { atomicAdd(&(bar)[XB_TMO], 1u); break; } } } } while (0)

struct XcdBarrier {
    unsigned* bar; unsigned x;
    unsigned w0;
    volatile LAS unsigned* st;
};

#define XB_LANE0() (__builtin_amdgcn_mbcnt_hi(~0u, __builtin_amdgcn_mbcnt_lo(~0u, 0u)) == 0u)
__device__ __forceinline__ XcdBarrier xcd_barrier_post(unsigned* bar, volatile LAS unsigned* st, unsigned w0) {
    XcdBarrier b; b.bar = bar; b.x = xb_xcc_id(); b.st = st; b.w0 = w0;
    if (w0 && XB_LANE0()) (void)xb_add(&bar[XB_XCNT(b.x)], 1u);
    return b;
}
__device__ __forceinline__ void xcd_barrier_complete(unsigned* bar, unsigned x, unsigned& nloc, unsigned& nx) {
    const unsigned G = gridDim.x * gridDim.y * gridDim.z;
    unsigned sum, cnt, mine, sp = 0u;
    for (;;) {
        sum = 0u; cnt = 0u; mine = 0u;
#pragma unroll
        for (unsigned j = 0; j < 16; ++j) { const unsigned c = xb_ld(&bar[XB_XCNT(j)]); sum += c; cnt += (c > 0u) ? 1u : 0u; mine = (j == x) ? c : mine; }
        if (sum == G) break;
        __builtin_amdgcn_s_sleep(1);
        if ((++sp & 255u) == 0u) { if (xb_ld(&bar[XB_TMO])) break; if (sp > XB_SPIN_CAP) { atomicAdd(&bar[XB_TMO], 1u); break; } }
    }
    nloc = mine > 0u ? mine : 1u; nx = cnt > 0u ? cnt : 1u;
}

__device__ __forceinline__ void xcd_barrier(const XcdBarrier& b) {
    asm volatile("s_waitcnt vmcnt(0)" ::: "memory");
    __syncthreads();
    if (b.w0 && XB_LANE0()) {
        unsigned* bar = b.bar;
        __builtin_amdgcn_s_waitcnt(0);
        unsigned nloc = b.st[0], nx = b.st[1];
        if (nloc == 0u) { xcd_barrier_complete(bar, b.x, nloc, nx); b.st[0] = nloc; b.st[1] = nx; }
        const unsigned old = xb_add(&bar[XB_XSUB(b.x)], 1u);
        const unsigned gen = old / nloc;
        if (old + 1u == (gen + 1u) * nloc) {
            __builtin_amdgcn_fence(__ATOMIC_RELEASE, "agent");
            asm volatile("s_waitcnt vmcnt(0)" ::: "memory");
            const unsigned og = xb_add(&bar[XB_TOP], 1u);
            const unsigned tg = og / nx;
            if (og + 1u == (tg + 1u) * nx) xb_add(&bar[XB_TOPGEN], 1u);
            else XB_SPIN(xb_ld(&bar[XB_TOPGEN]) == tg, bar);
            __builtin_amdgcn_fence(__ATOMIC_ACQUIRE, "agent");
            xb_add(&bar[XB_XGEN(b.x)], 1u);
            asm volatile("s_waitcnt vmcnt(0)" ::: "memory");
        } else {
            XB_SPIN(xb_ld(&bar[XB_XGEN(b.x)]) == gen, bar);
            __builtin_amdgcn_fence(__ATOMIC_ACQUIRE, "agent");
            asm volatile("s_waitcnt vmcnt(0)" ::: "memory");
        }
    }
    __syncthreads();
}
constexpr int DM = 1024;
constexpr int TP = 8192, BP = 2, MP = BP * TP;
constexpr int NB_S = 128, SS = 4, MS = NB_S * SS;
constexpr int MT = MP + MS;
constexpr int PIN = 2328, NIN = 2560;
constexpr int FFN = 2816, NGU = 2 * FFN;
constexpr int PAST = 2048, PAGE = 128, NPG = PAST / PAGE, NPOOL = 2560;
constexpr int KVW = 256;
constexpr int NLAYER = 2;
constexpr float LN_EPS = 1e-5f;
constexpr float DN_ALPHA = 1.4142135623730951f;

constexpr size_t O_Y = 0;
constexpr size_t O_CMPP = (size_t)MT * DM;
constexpr size_t O_SLCP = O_CMPP + (size_t)NLAYER * MP * KVW;
constexpr size_t O_WINP = O_SLCP + (size_t)NLAYER * MP * KVW;
constexpr size_t O_CMPS = O_WINP + (size_t)NLAYER * BP * 512 * KVW;
constexpr size_t O_SLCS = O_CMPS + (size_t)NLAYER * MS * KVW;
constexpr size_t O_WINS = O_SLCS + (size_t)NLAYER * MS * KVW;
constexpr size_t O_GV = O_WINS + (size_t)NLAYER * NB_S * 512 * KVW;
constexpr size_t O_END = O_GV + (size_t)NLAYER * MS * 512;
static_assert(O_END == 69206016, "output size");

constexpr size_t MiB = 1u << 20;
constexpr size_t WS_CTL = 0, CTL_ZERO_BYTES = 1 * MiB;
constexpr size_t WS_ROPE = 1 * MiB;
constexpr size_t WS_WIN_T = 4 * MiB;
constexpr size_t WS_WOUT_T = 14 * MiB;
constexpr size_t WS_WGU_T = 18 * MiB;
constexpr size_t WS_WDN_T = 40 * MiB;
constexpr size_t WS_W1C_T = 52 * MiB;
constexpr size_t WS_W2C_T = 56 * MiB;
constexpr size_t WS_GWP = 57 * MiB;
constexpr size_t WS_GWS = 58 * MiB;
constexpr size_t WS_GBS = 59 * MiB;
constexpr size_t WS_XF = 64 * MiB;
constexpr size_t WS_XB = 130 * MiB;
constexpr size_t WS_PRE = 163 * MiB;
constexpr size_t WS_QRAW = 229 * MiB;
constexpr size_t WS_QROT = 246 * MiB;
constexpr size_t WS_KS = 263 * MiB;
constexpr size_t WS_VS = 267 * MiB;
constexpr size_t WS_KW = 271 * MiB;
constexpr size_t WS_VW = 275 * MiB;
constexpr size_t WS_U = 279 * MiB;
constexpr size_t WS_V = 296 * MiB;
constexpr size_t WS_GATES = 313 * MiB;
constexpr size_t WS_CKP = 315 * MiB;
constexpr size_t WS_CVP = WS_CKP + 512 * 1024;
constexpr size_t WS_CKS = 316 * MiB;
constexpr size_t WS_CVS = 320 * MiB;
constexpr size_t WS_MIX = 324 * MiB;
constexpr size_t WS_F = 357 * MiB;
constexpr size_t WS_DBG = 448 * MiB;
constexpr size_t WS_DBG2 = 552 * MiB;
constexpr size_t WS_END = 560 * MiB;
static_assert(WS_XF + (size_t)MT * DM * 4 <= WS_XB && WS_XB + (size_t)MT * DM * 2 <= WS_PRE && WS_PRE + (size_t)MT * DM * 4 <= WS_QRAW, "ws map 1");
static_assert(WS_QRAW + (size_t)MT * 512 * 2 <= WS_QROT && WS_QROT + (size_t)MT * 512 * 2 <= WS_KS && WS_U + (size_t)MT * 512 * 2 <= WS_V && WS_V + (size_t)MT * 512 * 2 <= WS_GATES, "ws map 2");
static_assert(WS_GATES + (size_t)MT * 24 * 4 <= WS_CKP && WS_MIX + (size_t)MT * DM * 2 <= WS_F && WS_F + (size_t)MT * FFN * 2 <= WS_END, "ws map 3");
static_assert(WS_WIN_T + (size_t)2 * NIN * DM * 2 <= WS_WOUT_T && WS_WGU_T + (size_t)2 * NGU * DM * 2 <= WS_WDN_T && WS_WDN_T + (size_t)2 * DM * FFN * 2 <= WS_W1C_T, "ws map 4");

constexpr int CW_TMO = 0, CW_CODE = 1;
constexpr int CW_BAR = 4096;
constexpr int CW_ERR = 64;
#ifndef ATT_PROBE_GAIN
#define ATT_PROBE_GAIN 10.0f
#endif
#ifndef ATT_PROBE_SEL
#define ATT_PROBE_SEL 3
#endif

constexpr int NWAVES = 8;
constexpr int RING_OFF = 0, RING_BYTES = 131072;
constexpr int LDSCTL_OFF = 143360, MISC_OFF = LDSCTL_OFF + 320;
constexpr int LDS_BYTES = 147456;

constexpr int PH_P0A = 0, PH_P0B = 1, PH_L0 = 2, PH_PER_LAYER = 8, N_PHASES = PH_L0 + NLAYER * PH_PER_LAYER;
typedef float f32x2 __attribute__((ext_vector_type(2)));
typedef unsigned u32x2 __attribute__((ext_vector_type(2)));
__device__ __forceinline__ float bf2f(unsigned short h) { return __uint_as_float(((unsigned)h) << 16); }
__device__ __forceinline__ float bflo(unsigned w) { return __uint_as_float(w << 16); }
__device__ __forceinline__ float bfhi(unsigned w) { return __uint_as_float(w & 0xffff0000u); }
__device__ __forceinline__ float wave_sum(float v) {
#pragma unroll
    for (int o = 1; o < 64; o <<= 1) v += __shfl_xor(v, o);
    return v;
}
__device__ __forceinline__ float wave_max(float v) {
#pragma unroll
    for (int o = 1; o < 64; o <<= 1) v = fmaxf(v, __shfl_xor(v, o));
    return v;
}
__device__ __forceinline__ float sigmoidf_(float x) { return 1.0f / (1.0f + __expf(-x)); }
__device__ __forceinline__ float siluf_(float x) { return x / (1.0f + __expf(-x)); }
__device__ __forceinline__ float geluf_(float x) { const float u = 1.5957691216057308f * (x + 0.044715f * x * x * x); return x / (1.0f + __expf(-u)); }
#define WAVE_LDS_FENCE() asm volatile("s_waitcnt lgkmcnt(0)" ::: "memory")

struct EpiResid {
    static constexpr bool PERM = false, AFTER_DRAIN = false;
    const float* xf; float* pre;
    __device__ __forceinline__ void operator()(const pg8::f32x4 (&acc)[2][2][4][2], const pg8::Unit& u, int wr, int wc, int fr, int fq) const {
        const int col0 = u.pn * 256 + wc * 32 + 4 * fq;
#pragma unroll
        for (int ai = 0; ai < 2; ++ai)
#pragma unroll
            for (int m = 0; m < 4; ++m) {
                const size_t off = (size_t)(u.pm * 256 + ai * 128 + wr * 64 + m * 16 + fr) * DM + col0;
#pragma unroll
                for (int bj = 0; bj < 2; ++bj)
#pragma unroll
                    for (int n = 0; n < 2; ++n) {
                        const pg8::f32x4 x = *(const pg8::f32x4*)(xf + off + bj * 128 + n * 16);
                        *(pg8::f32x4*)(pre + off + bj * 128 + n * 16) = x * DN_ALPHA + acc[ai][bj][m][n];
                    }
            }
    }
};
struct EpiGateUp {
    static constexpr bool PERM = true, AFTER_DRAIN = false;
    bf16* f;
    __device__ __forceinline__ void operator()(const pg8::f32x4 (&acc)[2][2][4][2], const pg8::Unit& u, int wr, int wc, int fr, int fq) const {
        const int c8 = u.pn * 256 + wc * 32 + 8 * fq;
#pragma unroll
        for (int ai = 0; ai < 2; ++ai)
#pragma unroll
            for (int m = 0; m < 4; ++m) {
                const size_t row = (size_t)(u.pm * 256 + ai * 128 + wr * 64 + m * 16 + fr);
#pragma unroll
                for (int bj = 0; bj < 2; ++bj) {
                    const pg8::f32x4 v0 = acc[ai][bj][m][0], v1 = acc[ai][bj][m][1];
                    const float o0 = siluf_(v0[0]) * v0[1], o1 = siluf_(v0[2]) * v0[3], o2 = siluf_(v1[0]) * v1[1], o3 = siluf_(v1[2]) * v1[3];
                    u32x2 w; w.x = pk2(o0, o1); w.y = pk2(o2, o3);
                    *(u32x2*)(f + row * FFN + ((c8 + bj * 128) >> 1)) = w;
                }
            }
    }
};
struct EpiInProj {
    static constexpr bool PERM = true, AFTER_DRAIN = false;
    int layer; unsigned char* ws; float* out;
    __device__ __forceinline__ void operator()(const pg8::f32x4 (&acc)[2][2][4][2], const pg8::Unit& u, int wr, int wc, int fr, int fq) const {
        const int pn = u.pn;
        const f32x2* rope = (const f32x2*)(ws + WS_ROPE); bf16* qraw = (bf16*)(ws + WS_QRAW); bf16* qrot = (bf16*)(ws + WS_QROT);
        bf16* KS = (bf16*)(ws + WS_KS); bf16* VS = (bf16*)(ws + WS_VS); bf16* KW = (bf16*)(ws + WS_KW); bf16* VW = (bf16*)(ws + WS_VW);
        bf16* U = (bf16*)(ws + WS_U); bf16* V = (bf16*)(ws + WS_V); float* gates = (float*)(ws + WS_GATES);
#pragma unroll
        for (int ai = 0; ai < 2; ++ai)
#pragma unroll
            for (int m = 0; m < 4; ++m) {
                const int r = u.pm * 256 + ai * 128 + wr * 64 + m * 16 + fr;
                const bool prompt = r < MP;
                const int b = r >> 13, t = r & (TP - 1);
                const int si = r - MP, bs = si >> 2, s = si & 3;
                const int pos = prompt ? t : PAST + s;
#pragma unroll
                for (int bj = 0; bj < 2; ++bj) {
                    const int c8 = pn * 256 + bj * 128 + wc * 32 + 8 * fq;
                    const pg8::f32x4 v0 = acc[ai][bj][m][0], v1 = acc[ai][bj][m][1];
                    if (pn < 2) {
                        const int h = c8 >> 6, d = (c8 & 63) >> 1;
                        const f32x2 cs0 = rope[pos * 32 + d], cs1 = rope[pos * 32 + d + 1], cs2 = rope[pos * 32 + d + 2], cs3 = rope[pos * 32 + d + 3];
                        const float a0 = v0[0], b0 = v0[1], a1 = v0[2], b1 = v0[3], a2 = v1[0], b2 = v1[1], a3 = v1[2], b3 = v1[3];
                        const size_t o = (size_t)r * 512 + h * 64 + d;
                        u32x2 w;
                        w.x = pk2(a0, a1); w.y = pk2(a2, a3); *(u32x2*)(qraw + o) = w;
                        w.x = pk2(b0, b1); w.y = pk2(b2, b3); *(u32x2*)(qraw + o + 32) = w;
                        w.x = pk2(a0 * cs0.x - b0 * cs0.y, a1 * cs1.x - b1 * cs1.y); w.y = pk2(a2 * cs2.x - b2 * cs2.y, a3 * cs3.x - b3 * cs3.y); *(u32x2*)(qrot + o) = w;
                        w.x = pk2(b0 * cs0.x + a0 * cs0.y, b1 * cs1.x + a1 * cs1.y); w.y = pk2(b2 * cs2.x + a2 * cs2.y, b3 * cs3.x + a3 * cs3.y); *(u32x2*)(qrot + o + 32) = w;
                    } else if (pn == 2) {
                        const int cc = c8 - 512;
                        float* dst = prompt ? out + O_CMPP + ((size_t)(layer * BP + b) * TP + t) * KVW + cc : out + O_CMPS + ((size_t)layer * MS + si) * KVW + cc;
                        *(pg8::f32x4*)dst = v0; *(pg8::f32x4*)(dst + 4) = v1;
                    } else if (pn == 3 || pn == 4) {
                        const bool is_slc = (pn == 3);
                        const int cc = c8 - (is_slc ? 768 : 1024);
                        float* dst;
                        bool wr_out = true;
                        if (is_slc) dst = prompt ? out + O_SLCP + ((size_t)(layer * BP + b) * TP + t) * KVW : out + O_SLCS + ((size_t)layer * MS + si) * KVW;
                        else { if (prompt) { wr_out = (t >= TP - 512); dst = out + O_WINP + ((size_t)(layer * BP + b) * 512 + (t - (TP - 512))) * KVW; }
                               else dst = out + O_WINS + ((size_t)(layer * NB_S + bs) * 512 + 508 + s) * KVW; }
                        if (cc < 128) {
                            const int g = cc >> 6, d = (cc & 63) >> 1;
                            const f32x2 cs0 = rope[pos * 32 + d], cs1 = rope[pos * 32 + d + 1], cs2 = rope[pos * 32 + d + 2], cs3 = rope[pos * 32 + d + 3];
                            const float a0 = v0[0], b0 = v0[1], a1 = v0[2], b1 = v0[3], a2 = v1[0], b2 = v1[1], a3 = v1[2], b3 = v1[3];
                            const pg8::f32x4 lo = {a0 * cs0.x - b0 * cs0.y, a1 * cs1.x - b1 * cs1.y, a2 * cs2.x - b2 * cs2.y, a3 * cs3.x - b3 * cs3.y};
                            const pg8::f32x4 hi = {b0 * cs0.x + a0 * cs0.y, b1 * cs1.x + a1 * cs1.y, b2 * cs2.x + a2 * cs2.y, b3 * cs3.x + a3 * cs3.y};
                            if (wr_out) { *(pg8::f32x4*)(dst + g * 64 + d) = lo; *(pg8::f32x4*)(dst + g * 64 + d + 32) = hi; }
                            if (prompt) { bf16* kb = (is_slc ? KS : KW) + ((size_t)(b * 2 + g) * TP + t) * 64 + d;
                                u32x2 w; w.x = pk2(lo[0], lo[1]); w.y = pk2(lo[2], lo[3]); *(u32x2*)kb = w;
                                w.x = pk2(hi[0], hi[1]); w.y = pk2(hi[2], hi[3]); *(u32x2*)(kb + 32) = w; }
                        } else {
                            const int g = (cc - 128) >> 6, d = cc & 63;
                            if (wr_out) { *(pg8::f32x4*)(dst + cc) = v0; *(pg8::f32x4*)(dst + cc + 4) = v1; }
                            if (prompt) { bf16* vb = (is_slc ? VS : VW) + ((size_t)(b * 2 + g) * TP + t) * 64 + d;
                                v4u w; w.x = pk2(v0[0], v0[1]); w.y = pk2(v0[2], v0[3]); w.z = pk2(v1[0], v1[1]); w.w = pk2(v1[2], v1[3]); *(v4u*)vb = w; }
                        }
                    } else if (pn < 9) {
                        const bool is_u = pn < 7;
                        const int cc = c8 - (is_u ? 1280 : 1792);
                        bf16* dst = (is_u ? U : V) + (size_t)r * 512 + cc;
                        v4u w; w.x = pk2(geluf_(v0[0]), geluf_(v0[1])); w.y = pk2(geluf_(v0[2]), geluf_(v0[3])); w.z = pk2(geluf_(v1[0]), geluf_(v1[1])); w.w = pk2(geluf_(v1[2]), geluf_(v1[3]));
                        *(v4u*)dst = w;
                    } else {
                        const int cc = c8 - 2304;
                        if (cc < 24) { float* dst = gates + (size_t)r * 24 + cc;
                            const pg8::f32x4 g0 = {sigmoidf_(v0[0]), sigmoidf_(v0[1]), sigmoidf_(v0[2]), sigmoidf_(v0[3])}, g1 = {sigmoidf_(v1[0]), sigmoidf_(v1[1]), sigmoidf_(v1[2]), sigmoidf_(v1[3])};
                            *(pg8::f32x4*)dst = g0; *(pg8::f32x4*)(dst + 4) = g1; }
                    }
                }
            }
    }
};

template <class RowMap>
__device__ __forceinline__ void transpose_item(const float* W, int K, int N, bf16* WT, const RowMap rm, LAS float* scr, int item, int lane) {
    const int nblk = (N + 31) / 32, kb = item / nblk, nb = item % nblk, k0 = 64 * kb, n0 = 32 * nb;
    const int ncol = n0 + (lane & 31);
#pragma unroll 8
    for (int i = 0; i < 32; ++i) { const int kk = 2 * i + (lane >> 5); scr[kk * 33 + (lane & 31)] = (ncol < N) ? W[(size_t)(k0 + kk) * N + ncol] : 0.f; }
    LDS_WAIT(); asm volatile("" ::: "memory");
    const int c = lane & 7;
#pragma unroll
    for (int j = 0; j < 4; ++j) { const int nl = (lane >> 3) + 8 * j; const LAS float* s = scr + (8 * c) * 33 + nl;
        v4u o; o.x = pk2(s[0 * 33], s[1 * 33]); o.y = pk2(s[2 * 33], s[3 * 33]); o.z = pk2(s[4 * 33], s[5 * 33]); o.w = pk2(s[6 * 33], s[7 * 33]);
        if (n0 + nl < N) *(v4u*)(WT + (size_t)rm(n0 + nl) * K + k0 + 8 * c) = o; }
    LDS_WAIT(); asm volatile("" ::: "memory");
}
struct RmIdent { __device__ __forceinline__ int operator()(int n) const { return n; } };
struct RmAffine { int mul, add; __device__ __forceinline__ int operator()(int n) const { return n * mul + add; } };
__device__ __forceinline__ int rope_il(int d) { return d < 32 ? 2 * d : 2 * (d - 32) + 1; }
struct RmInProj { __device__ __forceinline__ int operator()(int c) const {
    if (c < 512) return (c & ~63) + rope_il(c & 63);
    if (c < 768) return c;
    if (c < 1280) { const int base = c < 1024 ? 768 : 1024, cc = c - base; return cc < 128 ? base + (cc & ~63) + rope_il(cc & 63) : c; }
    if (c < 1304) return 2304 + (c - 1280);
    return 1280 + (c - 1304); } };
constexpr int CU_AS = 0, CU_BS = 9216, CU_HS = 46080, CU_LDS = 79872;
__device__ __forceinline__ void compress_unit(LAS unsigned char* lds, const float* arow, const float* pe_k, const bf16* W1t, const float* b1, const bf16* W2t,
                                              bf16* obase, int NC, int rb, int tid) {
    const int wid = __builtin_amdgcn_readfirstlane(tid >> 6), lane = tid & 63, fr = lane & 15, fq = lane >> 4, wr = wid >> 2, wc = wid & 3;
    const int arow_i = tid >> 3, ac = tid & 7;
    pg8::f32x4 acc[2][4];
#pragma unroll
    for (int m = 0; m < 2; ++m)
#pragma unroll
        for (int n = 0; n < 4; ++n) acc[m][n] = (pg8::f32x4){0.f, 0.f, 0.f, 0.f};
    pg8::f32x4 a0, a1, p0, p1; v4u bq[4];
    const float* pe_t = pe_k + ac * 8;
    const bf16* bsrc = W1t + (size_t)arow_i * 2048 + ac * 8;
    a0 = *(const pg8::f32x4*)arow; a1 = *(const pg8::f32x4*)(arow + 4); p0 = *(const pg8::f32x4*)pe_t; p1 = *(const pg8::f32x4*)(pe_t + 4);
#pragma unroll
    for (int j = 0; j < 4; ++j) bq[j] = *(const v4u*)(bsrc + (size_t)j * 64 * 2048);
    for (int l = 0; l < 32; ++l) {
        { v4u w; a0 = a0 + p0; a1 = a1 + p1; w.x = pk2(a0[0], a0[1]); w.y = pk2(a0[2], a0[3]); w.z = pk2(a1[0], a1[1]); w.w = pk2(a1[2], a1[3]);
          *(LAS v4u*)(lds + CU_AS + arow_i * 144 + ac * 16) = w;
#pragma unroll
          for (int j = 0; j < 4; ++j) *(LAS v4u*)(lds + CU_BS + (arow_i + 64 * j) * 144 + ac * 16) = bq[j]; }
        __syncthreads();
        if (l + 1 < 32) {
            const float* an = arow + (size_t)(l + 1) * KVW; const float* pn = pe_t + (l + 1) * 64; const bf16* bn = bsrc + (l + 1) * 64;
            a0 = *(const pg8::f32x4*)an; a1 = *(const pg8::f32x4*)(an + 4); p0 = *(const pg8::f32x4*)pn; p1 = *(const pg8::f32x4*)(pn + 4);
#pragma unroll
            for (int j = 0; j < 4; ++j) bq[j] = *(const v4u*)(bn + (size_t)j * 64 * 2048);
        }
#pragma unroll
        for (int kk = 0; kk < 2; ++kk) {
            bf16x8 af[2], bfr[4];
#pragma unroll
            for (int m = 0; m < 2; ++m) af[m] = *(const LAS bf16x8*)(lds + CU_AS + (wr * 32 + m * 16 + fr) * 144 + (kk * 32 + fq * 8) * 2);
#pragma unroll
            for (int n = 0; n < 4; ++n) bfr[n] = *(const LAS bf16x8*)(lds + CU_BS + (wc * 64 + n * 16 + fr) * 144 + (kk * 32 + fq * 8) * 2);
#pragma unroll
            for (int m = 0; m < 2; ++m)
#pragma unroll
                for (int n = 0; n < 4; ++n) acc[m][n] = __builtin_amdgcn_mfma_f32_16x16x32_bf16(af[m], bfr[n], acc[m][n], 0, 0, 0);
        }
        __syncthreads();
    }
#pragma unroll
    for (int m = 0; m < 2; ++m)
#pragma unroll
        for (int n = 0; n < 4; ++n) { const int col = wc * 64 + n * 16 + fr; const float bb = b1[col];
#pragma unroll
            for (int rg = 0; rg < 4; ++rg) { const int row = wr * 32 + m * 16 + fq * 4 + rg;
                *(LAS unsigned short*)(lds + CU_HS + row * 528 + col * 2) = (unsigned short)f2bf(siluf_(acc[m][n][rg] + bb)); } }
    __syncthreads();
    {
        const int rt = wid >> 1, ch = wid & 1;
        pg8::f32x4 acc2[2] = {(pg8::f32x4){0.f, 0.f, 0.f, 0.f}, (pg8::f32x4){0.f, 0.f, 0.f, 0.f}};
#pragma unroll
        for (int ks = 0; ks < 8; ++ks) {
            const bf16x8 a = *(const LAS bf16x8*)(lds + CU_HS + (rt * 16 + fr) * 528 + (ks * 32 + fq * 8) * 2);
#pragma unroll
            for (int nn = 0; nn < 2; ++nn) { const bf16x8 bb = *(const bf16x8*)(W2t + (size_t)(ch * 32 + nn * 16 + fr) * 256 + ks * 32 + fq * 8);
                acc2[nn] = __builtin_amdgcn_mfma_f32_16x16x32_bf16(a, bb, acc2[nn], 0, 0, 0); }
        }
#pragma unroll
        for (int nn = 0; nn < 2; ++nn)
#pragma unroll
            for (int rg = 0; rg < 4; ++rg) { const int R = rb * 64 + rt * 16 + fq * 4 + rg, col = ch * 32 + nn * 16 + fr;
                const int b = R / (2 * NC), n = (R >> 1) % NC, g = R & 1;
                obase[((size_t)(b * 2 + g) * NC + n) * 64 + col] = (bf16)f2bf(acc2[nn][rg]); }
    }
    __syncthreads();
}

constexpr int C32_PART = 32 * 256 * 4, C32_HS_RS = 528;
static_assert(4 * C32_PART <= LDSCTL_OFF, "compress32 LDS map");
__device__ __forceinline__ void compress32_unit(LAS unsigned char* lds, const float* rowbase0, const float* rowbase1  , const float* pe_k, const bf16* W1t,
                                                const float* b1, const bf16* W2t, bf16* obase, int NC, int rb, int tid) {
    const int wid = __builtin_amdgcn_readfirstlane(tid >> 6), lane = tid & 63, fr = lane & 15, fq = lane >> 4, kq = wid >> 1, nh = wid & 1;
    pg8::f32x4 acc[2][8];
#pragma unroll
    for (int mt = 0; mt < 2; ++mt)
#pragma unroll
        for (int nt = 0; nt < 8; ++nt) acc[mt][nt] = (pg8::f32x4){0.f, 0.f, 0.f, 0.f};
#pragma unroll 1
    for (int li = 0; li < 8; ++li) {
        const int l = 8 * kq + li;
#pragma unroll
        for (int ks = 0; ks < 2; ++ks) {
            const float* pp = pe_k + l * 64 + 32 * ks + 8 * fq;
            const pg8::f32x4 p0 = *(const pg8::f32x4*)pp, p1 = *(const pg8::f32x4*)(pp + 4);
            bf16x8 af[2];
#pragma unroll
            for (int mt = 0; mt < 2; ++mt) { const float* ap = (mt ? rowbase1 : rowbase0) + (size_t)l * KVW + 32 * ks + 8 * fq;
                const pg8::f32x4 a0 = *(const pg8::f32x4*)ap + p0, a1 = *(const pg8::f32x4*)(ap + 4) + p1;
                v4u aw; aw.x = pk2(a0[0], a0[1]); aw.y = pk2(a0[2], a0[3]); aw.z = pk2(a1[0], a1[1]); aw.w = pk2(a1[2], a1[3]); af[mt] = __builtin_bit_cast(bf16x8, aw); }
            const bf16* bp = W1t + (size_t)(128 * nh + fr) * 2048 + l * 64 + 32 * ks + 8 * fq;
#pragma unroll
            for (int nt = 0; nt < 8; ++nt) { const bf16x8 bfr = *(const bf16x8*)(bp + (size_t)nt * 16 * 2048);
                acc[0][nt] = __builtin_amdgcn_mfma_f32_16x16x32_bf16(af[0], bfr, acc[0][nt], 0, 0, 0); acc[1][nt] = __builtin_amdgcn_mfma_f32_16x16x32_bf16(af[1], bfr, acc[1][nt], 0, 0, 0); }
        }
    }
    { LAS float* part = (LAS float*)(lds + kq * C32_PART);
#pragma unroll
      for (int mt = 0; mt < 2; ++mt)
#pragma unroll
          for (int nt = 0; nt < 8; ++nt)
#pragma unroll
              for (int rg = 0; rg < 4; ++rg) part[(16 * mt + 4 * fq + rg) * 256 + 128 * nh + 16 * nt + fr] = acc[mt][nt][rg]; }
    __syncthreads();
    v4u hv[2];
    {
        const int row = tid >> 4, c0 = (tid & 15) * 16;
#pragma unroll
        for (int hh = 0; hh < 2; ++hh) {
            pg8::f32x4 s0 = *(const pg8::f32x4*)(b1 + c0 + 8 * hh), s1 = *(const pg8::f32x4*)(b1 + c0 + 8 * hh + 4);
#pragma unroll
            for (int w = 0; w < 4; ++w) { const LAS float* pp = (const LAS float*)(lds + w * C32_PART) + row * 256 + c0 + 8 * hh; s0 = s0 + *(const LAS pg8::f32x4*)pp; s1 = s1 + *(const LAS pg8::f32x4*)(pp + 4); }
            hv[hh].x = pk2(siluf_(s0[0]), siluf_(s0[1])); hv[hh].y = pk2(siluf_(s0[2]), siluf_(s0[3])); hv[hh].z = pk2(siluf_(s1[0]), siluf_(s1[1])); hv[hh].w = pk2(siluf_(s1[2]), siluf_(s1[3])); }
    }
    __syncthreads();
    { const int row = tid >> 4, c0 = (tid & 15) * 16;
      *(LAS v4u*)(lds + row * C32_HS_RS + c0 * 2) = hv[0]; *(LAS v4u*)(lds + row * C32_HS_RS + c0 * 2 + 16) = hv[1]; }
    __syncthreads();
    {
        const int mt = wid >> 2, nt = wid & 3;
        pg8::f32x4 a2 = {0.f, 0.f, 0.f, 0.f};
#pragma unroll
        for (int ks = 0; ks < 8; ++ks) {
            const bf16x8 a = *(const LAS bf16x8*)(lds + (16 * mt + fr) * C32_HS_RS + (ks * 32 + fq * 8) * 2);
            const bf16x8 bb = *(const bf16x8*)(W2t + (size_t)(nt * 16 + fr) * 256 + ks * 32 + fq * 8);
            a2 = __builtin_amdgcn_mfma_f32_16x16x32_bf16(a, bb, a2, 0, 0, 0);
        }
#pragma unroll
        for (int rg = 0; rg < 4; ++rg) { const int R = rb * 32 + 16 * mt + 4 * fq + rg, col = nt * 16 + fr;
            const int b = R / (2 * NC), n = (R >> 1) % NC, g = R & 1;
            obase[((size_t)(b * 2 + g) * NC + n) * 64 + col] = (bf16)f2bf(a2[rg]); }
    }
    __syncthreads();
}

constexpr int GM_RS = 136, GM_TILE = 128 * GM_RS;
static_assert(8 * GM_TILE <= LDSCTL_OFF, "gMLP LDS map");
__device__ __forceinline__ void gmlp_unit(LAS unsigned char* lds, LAS unsigned char* lds_stats, int m0, const bf16* U, const bf16* V, const bf16* WB, const float* bias, const float* lng, const float* lnb,
                                          bf16* mix, float* gv_out  , int tid) {
    typedef short s16x4_ __attribute__((ext_vector_type(4)));
    const int wid = __builtin_amdgcn_readfirstlane(tid >> 6), lane = tid & 63, fr = lane & 15, fq = lane >> 4;
    LAS f32x2* stats = (LAS f32x2*)lds_stats;
    for (int i = 0; i < 16; ++i) {
        const int row = wid * 16 + i;
        const v4u w = *(const v4u*)(V + (size_t)(m0 + row) * 512 + lane * 8);
        float x[8] = {bflo(w.x), bfhi(w.x), bflo(w.y), bfhi(w.y), bflo(w.z), bfhi(w.z), bflo(w.w), bfhi(w.w)};
        float s = 0.f;
#pragma unroll
        for (int e = 0; e < 8; ++e) s += x[e];
        const float mean = wave_sum(s) * (1.0f / 512.0f);
        float q = 0.f;
#pragma unroll
        for (int e = 0; e < 8; ++e) { const float d = x[e] - mean; q += d * d; }
        const float var = wave_sum(q) * (1.0f / 512.0f);
        if (lane == 0) stats[row] = (f32x2){mean, 1.0f / sqrtf(var + LN_EPS)};
    }
    __syncthreads();
    const int h = wid;
    LAS unsigned char* tile = lds + wid * GM_TILE;
    {
        const int ch = lane & 7, c0 = h * 64 + ch * 8;
        float gg[8], bb[8];
        { const pg8::f32x4 g0 = *(const pg8::f32x4*)(lng + c0), g1 = *(const pg8::f32x4*)(lng + c0 + 4), b0 = *(const pg8::f32x4*)(lnb + c0), b1 = *(const pg8::f32x4*)(lnb + c0 + 4);
          gg[0] = g0[0]; gg[1] = g0[1]; gg[2] = g0[2]; gg[3] = g0[3]; gg[4] = g1[0]; gg[5] = g1[1]; gg[6] = g1[2]; gg[7] = g1[3];
          bb[0] = b0[0]; bb[1] = b0[1]; bb[2] = b0[2]; bb[3] = b0[3]; bb[4] = b1[0]; bb[5] = b1[1]; bb[6] = b1[2]; bb[7] = b1[3]; }
#pragma unroll 4
        for (int it = 0; it < 16; ++it) {
            const int s = it * 8 + (lane >> 3);
            const v4u w = *(const v4u*)(V + (size_t)(m0 + s) * 512 + c0);
            const f32x2 st = stats[s];
            float x[8] = {bflo(w.x), bfhi(w.x), bflo(w.y), bfhi(w.y), bflo(w.z), bfhi(w.z), bflo(w.w), bfhi(w.w)};
#pragma unroll
            for (int e = 0; e < 8; ++e) x[e] = (x[e] - st.x) * st.y * gg[e] + bb[e];
            if (gv_out) { *(pg8::f32x4*)(gv_out + (size_t)s * 512 + c0) = (pg8::f32x4){x[0], x[1], x[2], x[3]}; *(pg8::f32x4*)(gv_out + (size_t)s * 512 + c0 + 4) = (pg8::f32x4){x[4], x[5], x[6], x[7]}; }
            u32x2 o0, o1; o0.x = pk2(x[0], x[1]); o0.y = pk2(x[2], x[3]); o1.x = pk2(x[4], x[5]); o1.y = pk2(x[6], x[7]);
            *(LAS u32x2*)(tile + s * GM_RS + ch * 16) = o0; *(LAS u32x2*)(tile + s * GM_RS + ch * 16 + 8) = o1;
        }
    }
    WAVE_LDS_FENCE();
    const bf16* Wh = WB + (size_t)h * 128 * 128;
#pragma unroll 1
    for (int th = 0; th < 2; ++th) {
        pg8::f32x4 acc[4][4];
#pragma unroll
        for (int dt = 0; dt < 4; ++dt)
#pragma unroll
            for (int tt = 0; tt < 4; ++tt) acc[dt][tt] = (pg8::f32x4){0.f, 0.f, 0.f, 0.f};
#pragma unroll 1
        for (int ks = 0; ks < 2 * th + 2; ++ks) {
            bf16x8 vf[4];
#pragma unroll
            for (int dt = 0; dt < 4; ++dt) { const LAS unsigned char* p = tile + (32 * ks + 4 * fq + (fr >> 2)) * GM_RS + (16 * dt + 4 * (fr & 3)) * 2;
                const s16x4_ lo = __builtin_bit_cast(s16x4_, __builtin_amdgcn_ds_read_tr16_b64_v4i16((LAS s16x4_*)p)), hi = __builtin_bit_cast(s16x4_, __builtin_amdgcn_ds_read_tr16_b64_v4i16((LAS s16x4_*)(p + 16 * GM_RS)));
                vf[dt] = (bf16x8){lo[0], lo[1], lo[2], lo[3], hi[0], hi[1], hi[2], hi[3]}; }
#pragma unroll
            for (int tt = 0; tt < 4; ++tt) {
                const bf16* wp = Wh + (size_t)(16 * (4 * th + tt) + fr) * 128 + 32 * ks + 4 * fq;
                const u32x2 w0 = *(const u32x2*)wp, w1 = *(const u32x2*)(wp + 16);
                const bf16x8 wb = __builtin_bit_cast(bf16x8, (v4u){w0.x, w0.y, w1.x, w1.y});
#pragma unroll
                for (int dt = 0; dt < 4; ++dt) acc[dt][tt] = __builtin_amdgcn_mfma_f32_16x16x32_bf16(vf[dt], wb, acc[dt][tt], 0, 0, 0);
            }
        }
#pragma unroll
        for (int tt = 0; tt < 4; ++tt) { const int t = 16 * (4 * th + tt) + fr; const float bv = bias[h * 128 + t];
#pragma unroll
            for (int dt = 0; dt < 4; ++dt) { const size_t off = (size_t)(m0 + t) * 512 + h * 64 + 16 * dt + 4 * fq;
                const u32x2 uw = *(const u32x2*)(U + off);
                const pg8::f32x4 a = acc[dt][tt];
                u32x2 o; o.x = pk2(bflo(uw.x) * (a[0] + bv), bfhi(uw.x) * (a[1] + bv)); o.y = pk2(bflo(uw.y) * (a[2] + bv), bfhi(uw.y) * (a[3] + bv));
                *(u32x2*)(mix + (size_t)(m0 + t) * DM + 512 + h * 64 + 16 * dt + 4 * fq) = o; } }
    }
    __syncthreads();
}

__device__ __forceinline__ void skinny_item(LAS unsigned char* lds, const bf16* A  , const bf16* Bt  , int K, const float* xf, float* pre  , int tid) {
    const int wid = __builtin_amdgcn_readfirstlane(tid >> 6), lane = tid & 63, fr = lane & 15, fq = lane >> 4;
    const int kw = K >> 3, k0 = wid * kw;
    pg8::f32x4 acc[4][2];
#pragma unroll
    for (int mt = 0; mt < 4; ++mt) { acc[mt][0] = (pg8::f32x4){0.f, 0.f, 0.f, 0.f}; acc[mt][1] = (pg8::f32x4){0.f, 0.f, 0.f, 0.f}; }
    const bf16* ap = A + (size_t)fr * K + k0 + 8 * fq; const bf16* bp = Bt + (size_t)fr * K + k0 + 8 * fq;
#pragma unroll 2
    for (int kk = 0; kk < kw; kk += 32) {
        bf16x8 af[4], bfr[2];
#pragma unroll
        for (int mt = 0; mt < 4; ++mt) af[mt] = *(const bf16x8*)(ap + (size_t)(16 * mt) * K + kk);
#pragma unroll
        for (int nt = 0; nt < 2; ++nt) bfr[nt] = *(const bf16x8*)(bp + (size_t)(16 * nt) * K + kk);
#pragma unroll
        for (int mt = 0; mt < 4; ++mt)
#pragma unroll
            for (int nt = 0; nt < 2; ++nt) acc[mt][nt] = __builtin_amdgcn_mfma_f32_16x16x32_bf16(af[mt], bfr[nt], acc[mt][nt], 0, 0, 0);
    }
    { LAS float* part = (LAS float*)(lds + wid * 8192);
#pragma unroll
      for (int mt = 0; mt < 4; ++mt)
#pragma unroll
          for (int nt = 0; nt < 2; ++nt)
#pragma unroll
              for (int rg = 0; rg < 4; ++rg) part[(16 * mt + 4 * fq + rg) * 32 + 16 * nt + fr] = acc[mt][nt][rg]; }
    __syncthreads();
    { const int row = tid >> 3, c4 = (tid & 7) * 4;
      pg8::f32x4 s = *(const pg8::f32x4*)(xf + (size_t)row * DM + c4) * DN_ALPHA;
#pragma unroll
      for (int w = 0; w < 8; ++w) s = s + *(const LAS pg8::f32x4*)((const LAS float*)(lds + w * 8192) + row * 32 + c4);
      *(pg8::f32x4*)(pre + (size_t)row * DM + c4) = s; }
    __syncthreads();
}

__device__ __forceinline__ void ln_row(const float* src, const float* g, const float* b, float* dstf, bf16* dstb, int lane) {
    pg8::f32x4 v[4]; float s = 0.f;
#pragma unroll
    for (int j = 0; j < 4; ++j) { v[j] = *(const pg8::f32x4*)(src + (j * 64 + lane) * 4); s += (v[j][0] + v[j][1]) + (v[j][2] + v[j][3]); }
    const float mean = wave_sum(s) * (1.0f / DM); float q = 0.f;
#pragma unroll
    for (int j = 0; j < 4; ++j) { v[j] = v[j] - mean; q += (v[j][0] * v[j][0] + v[j][1] * v[j][1]) + (v[j][2] * v[j][2] + v[j][3] * v[j][3]); }
    const float rstd = 1.0f / sqrtf(wave_sum(q) * (1.0f / DM) + LN_EPS);
#pragma unroll
    for (int j = 0; j < 4; ++j) { const int c = (j * 64 + lane) * 4;
        const pg8::f32x4 gg = *(const pg8::f32x4*)(g + c), bb = *(const pg8::f32x4*)(b + c);
        const pg8::f32x4 y = v[j] * rstd * gg + bb;
        *(pg8::f32x4*)(dstf + c) = y;
        if (dstb) { u32x2 w; w.x = pk2(y[0], y[1]); w.y = pk2(y[2], y[3]); *(u32x2*)(dstb + c) = w; } }
}

__device__ __forceinline__ void load8(const bf16* p, float (&k)[8]) { const v4u w = *(const v4u*)p; k[0] = bflo(w.x); k[1] = bfhi(w.x); k[2] = bflo(w.y); k[3] = bfhi(w.y); k[4] = bflo(w.z); k[5] = bfhi(w.z); k[6] = bflo(w.w); k[7] = bfhi(w.w); }
__device__ __forceinline__ void load8(const float* p, float (&k)[8]) { const pg8::f32x4 a = *(const pg8::f32x4*)p, b = *(const pg8::f32x4*)(p + 4); k[0] = a[0]; k[1] = a[1]; k[2] = a[2]; k[3] = a[3]; k[4] = b[0]; k[5] = b[1]; k[6] = b[2]; k[7] = b[3]; }
__device__ __forceinline__ float ldv(const bf16* p) { return bf2f(*p); }
__device__ __forceinline__ float ldv(const float* p) { return *p; }
template <class T> __device__ __forceinline__ void dot4(const T* krow, const LAS float* q, float (&s)[4]) {
    s[0] = s[1] = s[2] = s[3] = 0.f;
#pragma unroll 1
    for (int c = 0; c < 8; ++c) {
        float k[8]; load8(krow + c * 8, k);
#pragma unroll
        for (int r = 0; r < 4; ++r) {
            const pg8::f32x4 qa = *(const LAS pg8::f32x4*)(q + r * 64 + c * 8), qb = *(const LAS pg8::f32x4*)(q + r * 64 + c * 8 + 4);
            s[r] += qa[0] * k[0] + qa[1] * k[1] + qa[2] * k[2] + qa[3] * k[3] + qb[0] * k[4] + qb[1] * k[5] + qb[2] * k[6] + qb[3] * k[7];
        }
    }
}
template <class Src>
__device__ __forceinline__ void attend(const Src& S, int nblk, const LAS float* q, LAS float* pbuf, int lane, float (&o)[4], LAS float* impbuf) {
    typedef typename Src::T T;
    float m[4] = {-1e30f, -1e30f, -1e30f, -1e30f}, l[4] = {0.f, 0.f, 0.f, 0.f};
    for (int i = 0; i < nblk; ++i) {
        const T *kb, *vb; bool ok; S.blk(i, lane, kb, vb, ok);
        if (ok) { float s[4]; dot4(kb + (size_t)lane * Src::STRIDE, q, s);
#pragma unroll
            for (int r = 0; r < 4; ++r) { if (s[r] > m[r]) { l[r] = l[r] * __expf(m[r] - s[r]) + 1.0f; m[r] = s[r]; } else l[r] += __expf(s[r] - m[r]); } }
    }
    float Mx[4], inv[4];
#pragma unroll
    for (int r = 0; r < 4; ++r) { Mx[r] = wave_max(m[r]); const float L = wave_sum(l[r] * __expf(m[r] - Mx[r])); inv[r] = 1.0f / fmaxf(L, 1e-30f); }
    o[0] = o[1] = o[2] = o[3] = 0.f;
    if (!(Mx[0] > -1e29f)) return;
    for (int i = 0; i < nblk; ++i) {
        const T *kb, *vb; bool ok; S.blk(i, lane, kb, vb, ok);
        const unsigned long long mask = __ballot(ok);
        if (mask == 0ull) continue;
        pg8::f32x4 p = {0.f, 0.f, 0.f, 0.f};
        if (ok) { float s[4]; dot4(kb + (size_t)lane * Src::STRIDE, q, s);
#pragma unroll
            for (int r = 0; r < 4; ++r) p[r] = __expf(s[r] - Mx[r]) * inv[r]; }
        *(LAS pg8::f32x4*)(pbuf + lane * 4) = p;
        if (impbuf) { const float im = (p[0] + p[1]) + (p[2] + p[3]); const float pr = im + __shfl_xor(im, 1); if (!(lane & 1)) impbuf[(i * 64 + lane) >> 1] = pr; }
        WAVE_LDS_FENCE();
        for (int kk = 0; kk < 64; ++kk) {
            if ((mask >> kk) & 1ull) { const pg8::f32x4 pv = *(const LAS pg8::f32x4*)(pbuf + kk * 4); const float v = ldv(vb + (size_t)kk * Src::STRIDE + lane);
                o[0] += pv[0] * v; o[1] += pv[1] * v; o[2] += pv[2] * v; o[3] += pv[3] * v; }
        }
        WAVE_LDS_FENCE();
    }
}
__device__ __forceinline__ unsigned long long topk_key(float val, int j) { unsigned u = __float_as_uint(val); u = (u & 0x80000000u) ? ~u : (u | 0x80000000u); return ((unsigned long long)u << 32) | (unsigned)(127 - j); }
__device__ __forceinline__ void topk16(const LAS float* imp, int ns, int cur, LAS int* selidx, int lane) {
    unsigned long long k0 = 0ull, k1 = 0ull;
    { const int j = lane; if (j < ns) { const bool valid = j <= cur, forced = (j == 0) | (j == cur) | (j == cur - 1); k0 = topk_key(valid ? imp[j] + (forced ? 1.0e4f : 0.f) : -1.0f, j); } }
    { const int j = lane + 64; if (j < ns) { const bool valid = j <= cur, forced = (j == 0) | (j == cur) | (j == cur - 1); k1 = topk_key(valid ? imp[j] + (forced ? 1.0e4f : 0.f) : -1.0f, j); } }
    for (int it = 0; it < 16; ++it) {
        unsigned long long k = k0 > k1 ? k0 : k1;
#pragma unroll
        for (int o = 1; o < 64; o <<= 1) { const unsigned lo = __shfl_xor((unsigned)k, o), hi = __shfl_xor((unsigned)(k >> 32), o); const unsigned long long kx = ((unsigned long long)hi << 32) | lo; k = kx > k ? kx : k; }
        const int jb = 127 - (int)(unsigned)(k & 0xffffffffull);
        if (lane == 0) selidx[it] = (k == 0ull || jb > cur) ? -1 : jb;
        if (k0 == k) k0 = 0ull;
        if (k1 == k) k1 = 0ull;
    }
    WAVE_LDS_FENCE();
}
struct SrcPromptCmp { typedef bf16 T; static constexpr int STRIDE = 64; const bf16 *ck, *cv; int nvalid;
    __device__ __forceinline__ void blk(int i, int lane, const bf16*& kb, const bf16*& vb, bool& ok) const { kb = ck + (size_t)i * 64 * 64; vb = cv + (size_t)i * 64 * 64; ok = (i * 64 + lane) < nvalid; } };
struct SrcPromptSlc { typedef bf16 T; static constexpr int STRIDE = 64; const bf16 *K, *V; const LAS int* selidx; int t;
    __device__ __forceinline__ void blk(int i, int lane, const bf16*& kb, const bf16*& vb, bool& ok) const { const int j = selidx[i]; const int jj = j < 0 ? 0 : j; kb = K + (size_t)jj * 64 * 64; vb = V + (size_t)jj * 64 * 64; ok = (j >= 0) && (jj * 64 + lane <= t); } };
struct SrcPromptWin { typedef bf16 T; static constexpr int STRIDE = 64; const bf16 *K, *V; int t, kb0;
    __device__ __forceinline__ void blk(int i, int lane, const bf16*& kb, const bf16*& vb, bool& ok) const { const int j = kb0 + i, pos = j * 64 + lane; kb = K + (size_t)j * 64 * 64; vb = V + (size_t)j * 64 * 64; ok = (pos <= t) && (pos >= t - 511); } };
struct SrcSampleCmp { typedef bf16 T; static constexpr int STRIDE = 64; const bf16 *ck, *cv;
    __device__ __forceinline__ void blk(int i, int lane, const bf16*& kb, const bf16*& vb, bool& ok) const { kb = ck; vb = cv; ok = true; } };
struct SrcSampleSlc { typedef float T; static constexpr int STRIDE = KVW; const float* cache_l; const int* pt; const float* newrows; const LAS int* selidx; int g, s;
    __device__ __forceinline__ void blk(int i, int lane, const float*& kb, const float*& vb, bool& ok) const {
        const int j = selidx[i];
        if (j >= 0 && j < 32) { const int page = pt[j >> 1]; const float* rb = cache_l + ((size_t)page * PAGE + (j & 1) * 64) * KVW; kb = rb + g * 64; vb = rb + 128 + g * 64; ok = true; }
        else { kb = newrows + g * 64; vb = newrows + 128 + g * 64; ok = (j == 32) && (lane <= s); } } };
struct SrcSampleWin { typedef float T; static constexpr int STRIDE = KVW; const float* state; const float* newrows; int g, s;
    __device__ __forceinline__ void blk(int i, int lane, const float*& kb, const float*& vb, bool& ok) const {
        if (i < 8) { const float* rb = state + (size_t)i * 64 * KVW; kb = rb + g * 64; vb = rb + 128 + g * 64; ok = (i * 64 + lane) >= s + 1; }
        else { kb = newrows + g * 64; vb = newrows + 128 + g * 64; ok = lane <= s; } } };
typedef short s16x4 __attribute__((ext_vector_type(4)));
constexpr int ATS = 144;
constexpr int AT_TILE = 64 * ATS;
constexpr int AT_STASH = 8 * AT_TILE;
static_assert(AT_STASH + 65536 <= LDSCTL_OFF, "attention LDS map");
constexpr float SM_C = 0.125f * 1.4426950408889634f;
#ifndef ATT_PROBE
#define ATT_PROBE 0
#endif
__device__ __forceinline__ s16x4 ds_tr(const LAS unsigned char* p) { return __builtin_bit_cast(s16x4, __builtin_amdgcn_ds_read_tr16_b64_v4i16((LAS s16x4*)p)); }
__device__ __forceinline__ void load_kfrags(const LAS unsigned char* Kt, int fr, int fq, bf16x8 (&kf)[4][2]) {
#pragma unroll
    for (int kt = 0; kt < 4; ++kt)
#pragma unroll
        for (int ks = 0; ks < 2; ++ks) kf[kt][ks] = *(const LAS bf16x8*)(Kt + (16 * kt + fr) * ATS + (32 * ks + 8 * fq) * 2);
}
__device__ __forceinline__ void load_vfrags(const LAS unsigned char* Vt, int fr, int fq, bf16x8 (&vf)[4][2]) {
#pragma unroll
    for (int dt = 0; dt < 4; ++dt)
#pragma unroll
        for (int ks = 0; ks < 2; ++ks) {
            const LAS unsigned char* p = Vt + (32 * ks + 4 * fq + (fr >> 2)) * ATS + (16 * dt + 4 * (fr & 3)) * 2;
            const s16x4 lo = ds_tr(p), hi = ds_tr(p + 16 * ATS);
            vf[dt][ks] = (bf16x8){lo[0], lo[1], lo[2], lo[3], hi[0], hi[1], hi[2], hi[3]};
        }
}
__device__ __forceinline__ bf16x8 pack_p(const pg8::f32x4& a, const pg8::f32x4& b) {
    v4u w; w.x = pg8::cvt_pk_bf16(a[0], a[1]); w.y = pg8::cvt_pk_bf16(a[2], a[3]); w.z = pg8::cvt_pk_bf16(b[0], b[1]); w.w = pg8::cvt_pk_bf16(b[2], b[3]);
    return __builtin_bit_cast(bf16x8, w);
}
__device__ __forceinline__ float rowq_max(float x) {
    { const auto r = __builtin_amdgcn_permlane16_swap(__float_as_uint(x), __float_as_uint(x), false, false); x = fmaxf(__uint_as_float(r[0]), __uint_as_float(r[1])); }
    { const auto r = __builtin_amdgcn_permlane32_swap(__float_as_uint(x), __float_as_uint(x), false, false); x = fmaxf(__uint_as_float(r[0]), __uint_as_float(r[1])); }
    return x;
}
__device__ __forceinline__ float rowq_sum(float x) {
    { const auto r = __builtin_amdgcn_permlane16_swap(__float_as_uint(x), __float_as_uint(x), false, false); x = __uint_as_float(r[0]) + __uint_as_float(r[1]); }
    { const auto r = __builtin_amdgcn_permlane32_swap(__float_as_uint(x), __float_as_uint(x), false, false); x = __uint_as_float(r[0]) + __uint_as_float(r[1]); }
    return x;
}
__device__ __forceinline__ unsigned rowq_umax(unsigned x) {
    { const auto r = __builtin_amdgcn_permlane16_swap(x, x, false, false); x = r[0] > r[1] ? r[0] : r[1]; }
    { const auto r = __builtin_amdgcn_permlane32_swap(x, x, false, false); x = r[0] > r[1] ? r[0] : r[1]; }
    return x;
}
struct AGroup { bf16x8 q[2]; pg8::f32x4 O[4]; float m, l; };
__device__ __forceinline__ void attn_score(AGroup& G, const bf16x8 (&kf)[4][2], int lo, int hi, int fq, bf16x8& pb0, bf16x8& pb1) {
    pg8::f32x4 s[4];
#pragma unroll
    for (int kt = 0; kt < 4; ++kt) { s[kt] = __builtin_amdgcn_mfma_f32_16x16x32_bf16(kf[kt][0], G.q[0], (pg8::f32x4){0.f, 0.f, 0.f, 0.f}, 0, 0, 0);
        s[kt] = __builtin_amdgcn_mfma_f32_16x16x32_bf16(kf[kt][1], G.q[1], s[kt], 0, 0, 0); }
    float mx = -1e30f;
    const bool none = (hi < 0) || (lo > 63), full = (lo <= 0) && (hi >= 63);
    if (__builtin_amdgcn_ballot_w64(!(none || full)) == 0ull) {
#pragma unroll
        for (int kt = 0; kt < 4; ++kt)
#pragma unroll
            for (int rg = 0; rg < 4; ++rg) { const float v = none ? -1e30f : s[kt][rg]; s[kt][rg] = v; mx = fmaxf(mx, v); }
    } else {
#pragma unroll
        for (int kt = 0; kt < 4; ++kt)
#pragma unroll
            for (int rg = 0; rg < 4; ++rg) { const int kidx = 16 * kt + 4 * fq + rg; const float v = (kidx >= lo && kidx <= hi) ? s[kt][rg] : -1e30f; s[kt][rg] = v; mx = fmaxf(mx, v); }
    }
    mx = rowq_max(mx);
    const float mnew = fmaxf(G.m, mx);
    const float alpha = __builtin_amdgcn_exp2f((G.m - mnew) * SM_C);
    const float mc = fmaxf(mnew, -1e20f) * SM_C;
    float ps = 0.f;
#pragma unroll
    for (int kt = 0; kt < 4; ++kt)
#pragma unroll
        for (int rg = 0; rg < 4; ++rg) { const float pv = __builtin_amdgcn_exp2f(s[kt][rg] * SM_C - mc); s[kt][rg] = pv; ps += pv; }
    G.l = G.l * alpha + ps; G.m = mnew;
#pragma unroll
    for (int dt = 0; dt < 4; ++dt) G.O[dt] = G.O[dt] * alpha;
    pb0 = pack_p(s[0], s[1]); pb1 = pack_p(s[2], s[3]);
}
__device__ __forceinline__ void attn_pv(pg8::f32x4 (&O)[4], const bf16x8 (&vf)[4][2], const bf16x8& pb0, const bf16x8& pb1) {
#pragma unroll
    for (int dt = 0; dt < 4; ++dt) { O[dt] = __builtin_amdgcn_mfma_f32_16x16x32_bf16(vf[dt][0], pb0, O[dt], 0, 0, 0); O[dt] = __builtin_amdgcn_mfma_f32_16x16x32_bf16(vf[dt][1], pb1, O[dt], 0, 0, 0); }
}
__device__ __forceinline__ int next_bit128(unsigned u0, unsigned u1, unsigned u2, unsigned u3, int from) {
    if (from < 32) { const unsigned x = (u0 >> from) << from; if (x) return __builtin_ctz(x); }
    if (from < 64) { const int sh = from > 32 ? from - 32 : 0; const unsigned x = (u1 >> sh) << sh; if (x) return 32 + __builtin_ctz(x); }
    if (from < 96) { const int sh = from > 64 ? from - 64 : 0; const unsigned x = (u2 >> sh) << sh; if (x) return 64 + __builtin_ctz(x); }
    if (from < 128) { const int sh = from > 96 ? from - 96 : 0; const unsigned x = (u3 >> sh) << sh; if (x) return 96 + __builtin_ctz(x); }
    return -1;
}
__device__ __forceinline__ bool test_bit128(unsigned u0, unsigned u1, unsigned u2, unsigned u3, int j) { const unsigned w = j < 32 ? u0 : j < 64 ? u1 : j < 96 ? u2 : u3; return (w >> (j & 31)) & 1u; }
constexpr int RING_D = 4, SLOT_B = 16384;
static_assert(RING_D * SLOT_B <= AT_STASH, "attention ring below the stash");
template <bool WIN>
__device__ __forceinline__ void attn_walk(LAS unsigned char* lds, const bf16* Kg, const bf16* Vg, unsigned W0, unsigned W1, unsigned W2, unsigned W3,
                                          unsigned nA0, unsigned nA1, unsigned nA2, unsigned nA3, unsigned nB0, unsigned nB1, unsigned nB2, unsigned nB3,
                                          const unsigned (&selA)[4], const unsigned (&selB)[4], int tA, int tB, AGroup& GA, AGroup& GB, int tid, int fr, int fq) {
    const int wid = __builtin_amdgcn_readfirstlane(tid >> 6), lane = tid & 63;
    const int drow = 8 * wid + (lane >> 3), dch = (lane & 7) ^ (drow & 6);
    const size_t goff = (size_t)drow * 64 + dch * 8;
    const int koff = fr * 128 + ((fq ^ (fr & 6)) * 16);
    const int vrow = 4 * fq + (fr >> 2);
    const int voff = vrow * 128 + (fr & 1) * 8;
    const int vsw = vrow & 6, vc0 = (fr & 3) >> 1;
#define ATT_ISSUE(jj, slot) do { const LAS unsigned char* sb_ = lds + (slot) * SLOT_B + wid * 1024; \
        __builtin_amdgcn_global_load_lds((const unsigned*)(Kg + (size_t)(jj) * 4096 + goff), (LAS unsigned*)sb_, 16, 0, 0); \
        __builtin_amdgcn_global_load_lds((const unsigned*)(Vg + (size_t)(jj) * 4096 + goff), (LAS unsigned*)(sb_ + 8192), 16, 0, 0); } while (0)
    int j_issue = next_bit128(W0, W1, W2, W3, 0), n_issued = 0, n_done = 0;
#pragma unroll 1
    for (int k = 0; k < RING_D - 1; ++k) if (j_issue >= 0) { ATT_ISSUE(j_issue, n_issued % RING_D); ++n_issued; j_issue = next_bit128(W0, W1, W2, W3, j_issue + 1); }
    int j = next_bit128(W0, W1, W2, W3, 0);
#pragma unroll 1
    while (j >= 0) {
        const int rem = n_issued - n_done - 1;
        if (rem >= 2) asm volatile("s_waitcnt vmcnt(4)" ::: "memory"); else if (rem == 1) asm volatile("s_waitcnt vmcnt(2)" ::: "memory"); else asm volatile("s_waitcnt vmcnt(0)" ::: "memory");
        __builtin_amdgcn_s_barrier(); asm volatile("" ::: "memory");
        if (j_issue >= 0) { ATT_ISSUE(j_issue, n_issued % RING_D); ++n_issued; j_issue = next_bit128(W0, W1, W2, W3, j_issue + 1); }
        const bool needA = test_bit128(nA0, nA1, nA2, nA3, j), needB = test_bit128(nB0, nB1, nB2, nB3, j);
        if (needA || needB) {
            const LAS unsigned char* Kt = lds + (n_done % RING_D) * SLOT_B; const LAS unsigned char* Vt = Kt + 8192;
            bf16x8 pa0, pa1, pc0, pc1;
            { bf16x8 kf[4][2];
#pragma unroll
              for (int kt = 0; kt < 4; ++kt)
#pragma unroll
                  for (int ks = 0; ks < 2; ++ks) kf[kt][ks] = *(const LAS bf16x8*)(Kt + kt * 2048 + (koff ^ (ks * 64)));
              if (needA) { int lo, hi;
                if (WIN) { lo = tA - 511 - 64 * j; hi = tA - 64 * j; } else { lo = 0; hi = test_bit128(selA[0], selA[1], selA[2], selA[3], j) ? tA - 64 * j : -1; }
                attn_score(GA, kf, lo, hi, fq, pa0, pa1); }
              if (needB) { int lo, hi;
                if (WIN) { lo = tB - 511 - 64 * j; hi = tB - 64 * j; } else { lo = 0; hi = test_bit128(selB[0], selB[1], selB[2], selB[3], j) ? tB - 64 * j : -1; }
                attn_score(GB, kf, lo, hi, fq, pc0, pc1); } }
            asm volatile("" ::: "memory");
            { bf16x8 vf[4][2];
#pragma unroll
              for (int dt = 0; dt < 4; ++dt)
#pragma unroll
                  for (int ks = 0; ks < 2; ++ks) { const LAS unsigned char* pp = Vt + ks * 4096 + voff + (((2 * dt + vc0) ^ vsw) * 16);
                      const s16x4 lo = ds_tr(pp), hi = ds_tr(pp + 2048);
                      vf[dt][ks] = (bf16x8){lo[0], lo[1], lo[2], lo[3], hi[0], hi[1], hi[2], hi[3]}; }
              if (needA) attn_pv(GA.O, vf, pa0, pa1);
              if (needB) attn_pv(GB.O, vf, pc0, pc1); }
        }
        ++n_done; j = next_bit128(W0, W1, W2, W3, j + 1);
    }
    asm volatile("s_waitcnt vmcnt(0) lgkmcnt(0)" ::: "memory");
    __builtin_amdgcn_s_barrier(); asm volatile("" ::: "memory");
#undef ATT_ISSUE
}
template <int CV0>
__device__ __forceinline__ void attn_cmp_group(const LAS unsigned char* lds, int NCT, const bf16x8 (&q)[2], int t, int cur, int fr, int fq, pg8::f32x4 (&Oc)[4], unsigned (&sel)[4]) {
    const int nv = (t + 1) >> 5;
    float m = -1e30f, l = 0.f;
#pragma unroll 1
    for (int ct = 0; ct < NCT; ++ct) {
        bf16x8 kf[4][2]; load_kfrags(lds + ct * AT_TILE, fr, fq, kf);
        pg8::f32x4 s[4];
#pragma unroll
        for (int kt = 0; kt < 4; ++kt) { s[kt] = __builtin_amdgcn_mfma_f32_16x16x32_bf16(kf[kt][0], q[0], (pg8::f32x4){0.f, 0.f, 0.f, 0.f}, 0, 0, 0);
            s[kt] = __builtin_amdgcn_mfma_f32_16x16x32_bf16(kf[kt][1], q[1], s[kt], 0, 0, 0); }
        float mx = -1e30f;
#pragma unroll
        for (int kt = 0; kt < 4; ++kt)
#pragma unroll
            for (int rg = 0; rg < 4; ++rg) { const int n = 64 * ct + 16 * kt + 4 * fq + rg; const float v = (n < nv) ? s[kt][rg] : -1e30f; s[kt][rg] = v; mx = fmaxf(mx, v); }
        mx = rowq_max(mx);
        const float mnew = fmaxf(m, mx), mc = fmaxf(mnew, -1e20f) * SM_C;
        float ps = 0.f;
#pragma unroll
        for (int kt = 0; kt < 4; ++kt)
#pragma unroll
            for (int rg = 0; rg < 4; ++rg) ps += __builtin_amdgcn_exp2f(s[kt][rg] * SM_C - mc);
        l = l * __builtin_amdgcn_exp2f((m - mnew) * SM_C) + ps; m = mnew;
    }
    l = rowq_sum(l);
    const float inv = 1.0f / fmaxf(l, 1e-30f), mc = fmaxf(m, -1e20f) * SM_C;
    unsigned key[32];
#pragma unroll
    for (int dt = 0; dt < 4; ++dt) Oc[dt] = (pg8::f32x4){0.f, 0.f, 0.f, 0.f};
#pragma unroll
    for (int ct = 0; ct < 4; ++ct) {
        if (ct < NCT) {
            pg8::f32x4 s[4];
            { bf16x8 kf[4][2]; load_kfrags(lds + ct * AT_TILE, fr, fq, kf);
#pragma unroll
              for (int kt = 0; kt < 4; ++kt) { s[kt] = __builtin_amdgcn_mfma_f32_16x16x32_bf16(kf[kt][0], q[0], (pg8::f32x4){0.f, 0.f, 0.f, 0.f}, 0, 0, 0);
                  s[kt] = __builtin_amdgcn_mfma_f32_16x16x32_bf16(kf[kt][1], q[1], s[kt], 0, 0, 0); } }
#pragma unroll
            for (int kt = 0; kt < 4; ++kt)
#pragma unroll
                for (int rg = 0; rg < 4; ++rg) { const int n = 64 * ct + 16 * kt + 4 * fq + rg; s[kt][rg] = (n < nv) ? __builtin_amdgcn_exp2f(s[kt][rg] * SM_C - mc) * inv : 0.f; }
#pragma unroll
            for (int kt = 0; kt < 4; ++kt)
#pragma unroll
                for (int e = 0; e < 2; ++e) {
                    float im = s[kt][2 * e] + s[kt][2 * e + 1];
                    im += __shfl_xor(im, 1); im += __shfl_xor(im, 2);
                    const int j = 32 * ct + 8 * kt + 2 * fq + e;
                    key[(ct * 4 + kt) * 2 + e] = (j >= 1 && j <= cur - 2) ? ((__float_as_uint(im) & 0xFFFFFF80u) | (unsigned)(127 - j)) : 0u;
                }
            const bf16x8 pb0 = pack_p(s[0], s[1]), pb1 = pack_p(s[2], s[3]);
            asm volatile("" ::: "memory");
            { bf16x8 vf[4][2]; load_vfrags(lds + (CV0 + ct) * AT_TILE, fr, fq, vf); attn_pv(Oc, vf, pb0, pb1); }
        } else {
#pragma unroll
            for (int k = 0; k < 8; ++k) key[ct * 8 + k] = 0u;
        }
    }
    sel[0] = sel[1] = sel[2] = sel[3] = 0u;
    if (cur < 16) { sel[0] = (1u << (cur + 1)) - 1u; return; }
    {
        sel[0] |= 1u;
#pragma unroll
        for (int w = 0; w < 4; ++w) { if ((cur >> 5) == w) sel[w] |= 1u << (cur & 31); if (((cur - 1) >> 5) == w) sel[w] |= 1u << ((cur - 1) & 31); }
    }
#pragma unroll 1
    for (int it = 0; it < 13; ++it) {
        unsigned best = 0u;
#pragma unroll
        for (int k = 0; k < 32; ++k) best = best > key[k] ? best : key[k];
        best = rowq_umax(best);
        if (best != 0u) { const int jb = 127 - (int)(best & 127u);
#pragma unroll
            for (int w = 0; w < 4; ++w) if ((jb >> 5) == w) sel[w] |= 1u << (jb & 31); }
#pragma unroll
        for (int k = 0; k < 32; ++k) key[k] = (key[k] == best) ? 0u : key[k];
    }
}
__device__ __forceinline__ unsigned wave_or_tok(unsigned u) { u |= __shfl_xor(u, 4); u |= __shfl_xor(u, 8); return __builtin_amdgcn_readfirstlane(u); }
__device__ __forceinline__ void attn_prompt_unit(LAS unsigned char* lds, LAS unsigned* wgU, unsigned char* ws, int bg, int i, int tid, float* dbg) {
    const int wid = __builtin_amdgcn_readfirstlane(tid >> 6), lane = tid & 63, fr = lane & 15, fq = lane >> 4;
    const int b = bg >> 1, g = bg & 1, t0 = 64 * i, cur = i;
    const bf16* QRAW = (const bf16*)(ws + WS_QRAW); const bf16* QROT = (const bf16*)(ws + WS_QROT);
    const int tA = t0 + 8 * wid + (fr >> 2), tB = tA + 4, head = g * 4 + (fr & 3);
    const size_t mA = (size_t)b * TP + tA, mB = mA + 4;
    if (tid < 4) wgU[tid] = 0u;
    const int NCT = (2 * i + 2 + 63) >> 6;
    { const int row = tid >> 3, ch = tid & 7;
      const bf16* ck = (const bf16*)(ws + WS_CKP) + (size_t)bg * 256 * 64; const bf16* cv = (const bf16*)(ws + WS_CVP) + (size_t)bg * 256 * 64;
#pragma unroll
      for (int ct = 0; ct < 4; ++ct) if (ct < NCT) {
          *(LAS v4u*)(lds + ct * AT_TILE + row * ATS + ch * 16) = *(const v4u*)(ck + (size_t)(ct * 64 + row) * 64 + ch * 8);
          *(LAS v4u*)(lds + (4 + ct) * AT_TILE + row * ATS + ch * 16) = *(const v4u*)(cv + (size_t)(ct * 64 + row) * 64 + ch * 8); } }
    __syncthreads();
    LAS pg8::f32x4* stash = (LAS pg8::f32x4*)(lds + AT_STASH) + wid * 8 * 64 + lane;
    unsigned selA[4], selB[4];
    const float* gtA = (const float*)(ws + WS_GATES) + mA * 24 + head; const float* gtB = gtA + 4 * 24;
    {   bf16x8 q[2]; pg8::f32x4 Oc[4];
        q[0] = *(const bf16x8*)(QRAW + mA * 512 + head * 64 + 8 * fq); q[1] = *(const bf16x8*)(QRAW + mA * 512 + head * 64 + 32 + 8 * fq);
        attn_cmp_group<4>(lds, NCT, q, tA, cur, fr, fq, Oc, selA);
        if (dbg) {
#pragma unroll
            for (int dt = 0; dt < 4; ++dt) *(pg8::f32x4*)(dbg + (mA * 3 + 0) * 512 + head * 64 + 16 * dt + 4 * fq) = Oc[dt]; }
        { const float gA = gtA[0];
#pragma unroll
          for (int dt = 0; dt < 4; ++dt) stash[dt * 64] = Oc[dt] * gA; }
        asm volatile("" ::: "memory");
        q[0] = *(const bf16x8*)(QRAW + mB * 512 + head * 64 + 8 * fq); q[1] = *(const bf16x8*)(QRAW + mB * 512 + head * 64 + 32 + 8 * fq);
        attn_cmp_group<4>(lds, NCT, q, tB, cur, fr, fq, Oc, selB);
        if (dbg) {
#pragma unroll
            for (int dt = 0; dt < 4; ++dt) *(pg8::f32x4*)(dbg + (mB * 3 + 0) * 512 + head * 64 + 16 * dt + 4 * fq) = Oc[dt]; }
        { const float gB = gtB[0];
#pragma unroll
          for (int dt = 0; dt < 4; ++dt) stash[(4 + dt) * 64] = Oc[dt] * gB; }
    }
    unsigned nA[4], nB[4];
#pragma unroll
    for (int w = 0; w < 4; ++w) { nA[w] = wave_or_tok(selA[w]); nB[w] = wave_or_tok(selB[w]); }
    if (lane == 0) {
#pragma unroll
        for (int w = 0; w < 4; ++w) atomicOr((unsigned*)(wgU + w), nA[w] | nB[w]); }
    __syncthreads();
    AGroup GA, GB;
    {
        const unsigned W0 = __builtin_amdgcn_readfirstlane(wgU[0]), W1 = __builtin_amdgcn_readfirstlane(wgU[1]), W2 = __builtin_amdgcn_readfirstlane(wgU[2]), W3 = __builtin_amdgcn_readfirstlane(wgU[3]);
        GA.q[0] = *(const bf16x8*)(QROT + mA * 512 + head * 64 + 8 * fq); GA.q[1] = *(const bf16x8*)(QROT + mA * 512 + head * 64 + 32 + 8 * fq);
        GB.q[0] = *(const bf16x8*)(QROT + mB * 512 + head * 64 + 8 * fq); GB.q[1] = *(const bf16x8*)(QROT + mB * 512 + head * 64 + 32 + 8 * fq);
#pragma unroll
        for (int dt = 0; dt < 4; ++dt) { GA.O[dt] = (pg8::f32x4){0.f, 0.f, 0.f, 0.f}; GB.O[dt] = (pg8::f32x4){0.f, 0.f, 0.f, 0.f}; }
        GA.m = GB.m = -1e30f; GA.l = GB.l = 0.f;
        attn_walk<false>(lds, (const bf16*)(ws + WS_KS) + (size_t)bg * TP * 64, (const bf16*)(ws + WS_VS) + (size_t)bg * TP * 64, W0, W1, W2, W3,
                         nA[0], nA[1], nA[2], nA[3], nB[0], nB[1], nB[2], nB[3], selA, selB, tA, tB, GA, GB, tid, fr, fq);
        const float lA = rowq_sum(GA.l);
        const float lB = rowq_sum(GB.l);
        const float iA = 1.0f / fmaxf(lA, 1e-30f), iB = 1.0f / fmaxf(lB, 1e-30f);
        if (dbg) {
#pragma unroll
            for (int dt = 0; dt < 4; ++dt) { *(pg8::f32x4*)(dbg + (mA * 3 + 1) * 512 + head * 64 + 16 * dt + 4 * fq) = GA.O[dt] * iA; *(pg8::f32x4*)(dbg + (mB * 3 + 1) * 512 + head * 64 + 16 * dt + 4 * fq) = GB.O[dt] * iB; } }
        const float gA = gtA[8] * iA, gB = gtB[8] * iB;
#pragma unroll
        for (int dt = 0; dt < 4; ++dt) { stash[dt * 64] = stash[dt * 64] + GA.O[dt] * gA; stash[(4 + dt) * 64] = stash[(4 + dt) * 64] + GB.O[dt] * gB; }
    }
    pg8::f32x4 OA[4], OB[4];
    {
        const int jlo = i > 8 ? i - 8 : 0;
        unsigned W[4];
#pragma unroll
        for (int w = 0; w < 4; ++w) { unsigned x = 0u;
#pragma unroll
            for (int k = 0; k < 9; ++k) { const int j = jlo + k; if (j <= i && (j >> 5) == w) x |= 1u << (j & 31); }
            W[w] = x; }
#pragma unroll
        for (int dt = 0; dt < 4; ++dt) { GA.O[dt] = (pg8::f32x4){0.f, 0.f, 0.f, 0.f}; GB.O[dt] = (pg8::f32x4){0.f, 0.f, 0.f, 0.f}; }
        GA.m = GB.m = -1e30f; GA.l = GB.l = 0.f;
        attn_walk<true>(lds, (const bf16*)(ws + WS_KW) + (size_t)bg * TP * 64, (const bf16*)(ws + WS_VW) + (size_t)bg * TP * 64, W[0], W[1], W[2], W[3],
                        W[0], W[1], W[2], W[3], W[0], W[1], W[2], W[3], selA, selB, tA, tB, GA, GB, tid, fr, fq);
        const float lA = rowq_sum(GA.l);
        const float lB = rowq_sum(GB.l);
        const float iA = 1.0f / fmaxf(lA, 1e-30f), iB = 1.0f / fmaxf(lB, 1e-30f);
        if (dbg) {
#pragma unroll
            for (int dt = 0; dt < 4; ++dt) { *(pg8::f32x4*)(dbg + (mA * 3 + 2) * 512 + head * 64 + 16 * dt + 4 * fq) = GA.O[dt] * iA; *(pg8::f32x4*)(dbg + (mB * 3 + 2) * 512 + head * 64 + 16 * dt + 4 * fq) = GB.O[dt] * iB; } }
        const float gA = gtA[16] * iA, gB = gtB[16] * iB;
#pragma unroll
        for (int dt = 0; dt < 4; ++dt) { OA[dt] = stash[dt * 64] + GA.O[dt] * gA; OB[dt] = stash[(4 + dt) * 64] + GB.O[dt] * gB; }
    }
    bf16* MIX = (bf16*)(ws + WS_MIX);
#pragma unroll
    for (int dt = 0; dt < 4; ++dt) {
        u32x2 w; w.x = pk2(OA[dt][0], OA[dt][1]); w.y = pk2(OA[dt][2], OA[dt][3]); *(u32x2*)(MIX + mA * DM + head * 64 + 16 * dt + 4 * fq) = w;
        w.x = pk2(OB[dt][0], OB[dt][1]); w.y = pk2(OB[dt][2], OB[dt][3]); *(u32x2*)(MIX + mB * DM + head * 64 + 16 * dt + 4 * fq) = w; }
}

__device__ __forceinline__ void load_kfrags_f32(const float* kb, int nrows, int fr, int fq, bf16x8 (&kf)[4][2]) {
#pragma unroll
    for (int kt = 0; kt < 4; ++kt) { const int row = 16 * kt + fr; const float* rp = kb + (size_t)(row < nrows ? row : 0) * KVW + 8 * fq;
#pragma unroll
        for (int ks = 0; ks < 2; ++ks) { const pg8::f32x4 a = *(const pg8::f32x4*)(rp + 32 * ks), b = *(const pg8::f32x4*)(rp + 32 * ks + 4);
            v4u w; w.x = pk2(a[0], a[1]); w.y = pk2(a[2], a[3]); w.z = pk2(b[0], b[1]); w.w = pk2(b[2], b[3]); kf[kt][ks] = __builtin_bit_cast(bf16x8, w); } }
}
__device__ __forceinline__ void stage_v_f32(LAS unsigned char* vt, const float* vb, int nrows, int lane) {
#pragma unroll
    for (int it = 0; it < 16; ++it) { const int idx = it * 64 + lane, row = idx >> 4, c4 = idx & 15;
        pg8::f32x4 a = {0.f, 0.f, 0.f, 0.f};
        if (row < nrows) a = *(const pg8::f32x4*)(vb + (size_t)row * KVW + c4 * 4);
        u32x2 w; w.x = pk2(a[0], a[1]); w.y = pk2(a[2], a[3]); *(LAS u32x2*)(vt + row * ATS + c4 * 8) = w; }
}
__device__ __forceinline__ void attn_sample_unit(LAS unsigned char* lds, unsigned char* ws, float* out, const float* cache_slc_l, const int* pt_row, const float* state_lb, int L, int bs, int g, int wid, int lane) {
    const int fr = lane & 15, fq = lane >> 4, tid = wid * 64 + lane;
    const int sl = fr >> 2, head = g * 4 + (fr & 3), t = PAST + sl;
    const size_t m = (size_t)MP + bs * 4 + sl;
    const bf16* QRAW = (const bf16*)(ws + WS_QRAW); const bf16* QROT = (const bf16*)(ws + WS_QROT);
    {
        const int row = tid >> 3, ch = tid & 7; const size_t co = (((size_t)L * NB_S + bs) * 2 + g) * 64 * 64;
        *(LAS v4u*)(lds + row * ATS + ch * 16) = *(const v4u*)((const bf16*)(ws + WS_CKS) + co + (size_t)row * 64 + ch * 8);
        *(LAS v4u*)(lds + AT_TILE + row * ATS + ch * 16) = *(const v4u*)((const bf16*)(ws + WS_CVS) + co + (size_t)row * 64 + ch * 8); }
    __syncthreads();
    pg8::f32x4 Oc[4]; unsigned sel[4];
    {   bf16x8 q[2]; q[0] = *(const bf16x8*)(QRAW + m * 512 + head * 64 + 8 * fq); q[1] = *(const bf16x8*)(QRAW + m * 512 + head * 64 + 32 + 8 * fq);
        attn_cmp_group<1>(lds, 1, q, t, 32, fr, fq, Oc, sel); }
    unsigned U0 = wave_or_tok(sel[0]); const unsigned U1 = wave_or_tok(sel[1]) & 1u;
    AGroup Gs, Gw;
    Gs.q[0] = *(const bf16x8*)(QROT + m * 512 + head * 64 + 8 * fq); Gs.q[1] = *(const bf16x8*)(QROT + m * 512 + head * 64 + 32 + 8 * fq);
    Gw.q[0] = Gs.q[0]; Gw.q[1] = Gs.q[1];
#pragma unroll
    for (int dt = 0; dt < 4; ++dt) { Gs.O[dt] = (pg8::f32x4){0.f, 0.f, 0.f, 0.f}; Gw.O[dt] = (pg8::f32x4){0.f, 0.f, 0.f, 0.f}; }
    Gs.m = Gw.m = -1e30f; Gs.l = Gw.l = 0.f;
    LAS unsigned char* vt = lds + (2 + wid) * AT_TILE;
    const float* newslc = out + O_SLCS + ((size_t)L * MS + bs * 4) * KVW;
    const float* newwin = out + O_WINS + (((size_t)L * NB_S + bs) * 512 + 508) * KVW;
    int cnt = 0;
#pragma unroll 1
    for (int j = 0; j < 33; ++j) {
        const bool inU = j < 32 ? ((U0 >> j) & 1u) : (U1 != 0u);
        if (!inU) continue;
        const bool mine = ((cnt & 7) == wid); ++cnt;
        if (!mine) continue;
        const float* rb; int nrows;
        if (j < 32) { const int page = pt_row[j >> 1]; rb = cache_slc_l + ((size_t)page * PAGE + (j & 1) * 64) * KVW + g * 64; nrows = 64; } else { rb = newslc + g * 64; nrows = 4; }
        bf16x8 pb0, pb1;
        { bf16x8 kf[4][2]; load_kfrags_f32(rb, nrows, fr, fq, kf);
          const unsigned w = j < 32 ? sel[0] : sel[1]; const int hi = ((w >> (j & 31)) & 1u) ? t - 64 * j : -1;
          attn_score(Gs, kf, 0, hi, fq, pb0, pb1); }
        stage_v_f32(vt, rb + 128, nrows, lane);
        WAVE_LDS_FENCE();
        { bf16x8 vf[4][2]; load_vfrags(vt, fr, fq, vf); attn_pv(Gs.O, vf, pb0, pb1); }
        WAVE_LDS_FENCE();
    }
#pragma unroll 1
    for (int i = 0; i < 9; ++i) {
        const bool mine = (((cnt + i) & 7) == wid);
        if (!mine) continue;
        const float* rb; int nrows;
        if (i < 8) { rb = state_lb + (size_t)i * 64 * KVW + g * 64; nrows = 64; } else { rb = newwin + g * 64; nrows = 4; }
        bf16x8 pb0, pb1;
        { bf16x8 kf[4][2]; load_kfrags_f32(rb, nrows, fr, fq, kf);
          attn_score(Gw, kf, sl + 1 - 64 * i, sl + 512 - 64 * i, fq, pb0, pb1); }
        stage_v_f32(vt, rb + 128, nrows, lane);
        WAVE_LDS_FENCE();
        { bf16x8 vf[4][2]; load_vfrags(vt, fr, fq, vf); attn_pv(Gw.O, vf, pb0, pb1); }
        WAVE_LDS_FENCE();
    }
    {   LAS pg8::f32x4* po = (LAS pg8::f32x4*)vt + lane; LAS f32x2* pm = (LAS f32x2*)(vt + 4096) + lane;
#pragma unroll
        for (int dt = 0; dt < 4; ++dt) { po[dt * 64] = Gs.O[dt]; ((LAS pg8::f32x4*)(vt + 4608) + lane)[dt * 64] = Gw.O[dt]; }
        pm[0] = (f32x2){Gs.m, Gs.l}; ((LAS f32x2*)(vt + 4608 + 4096) + lane)[0] = (f32x2){Gw.m, Gw.l}; }
    __syncthreads();
    if (wid == 0) {
        float Ms = -1e30f, Mw = -1e30f;
#pragma unroll
        for (int w = 0; w < 8; ++w) { const LAS unsigned char* sv = lds + (2 + w) * AT_TILE; Ms = fmaxf(Ms, ((const LAS f32x2*)(sv + 4096) + lane)[0].x); Mw = fmaxf(Mw, ((const LAS f32x2*)(sv + 4608 + 4096) + lane)[0].x); }
        pg8::f32x4 Os[4], Ow[4]; float ls = 0.f, lw = 0.f;
#pragma unroll
        for (int dt = 0; dt < 4; ++dt) { Os[dt] = (pg8::f32x4){0.f, 0.f, 0.f, 0.f}; Ow[dt] = (pg8::f32x4){0.f, 0.f, 0.f, 0.f}; }
#pragma unroll 1
        for (int w = 0; w < 8; ++w) { const LAS unsigned char* sv = lds + (2 + w) * AT_TILE;
            const f32x2 a = ((const LAS f32x2*)(sv + 4096) + lane)[0], b = ((const LAS f32x2*)(sv + 4608 + 4096) + lane)[0];
            const float fa = __builtin_amdgcn_exp2f((a.x - Ms) * SM_C), fb = __builtin_amdgcn_exp2f((b.x - Mw) * SM_C);
            ls += a.y * fa; lw += b.y * fb;
#pragma unroll
            for (int dt = 0; dt < 4; ++dt) { Os[dt] = Os[dt] + ((const LAS pg8::f32x4*)sv + lane)[dt * 64] * fa; Ow[dt] = Ow[dt] + ((const LAS pg8::f32x4*)(sv + 4608) + lane)[dt * 64] * fb; } }
        ls = rowq_sum(ls); lw = rowq_sum(lw);
        const float* gt = (const float*)(ws + WS_GATES) + m * 24 + head;
        const float g0 = gt[0], g1 = gt[8] / fmaxf(ls, 1e-30f), g2 = gt[16] / fmaxf(lw, 1e-30f);
        bf16* MIX = (bf16*)(ws + WS_MIX);
#pragma unroll
        for (int dt = 0; dt < 4; ++dt) { const pg8::f32x4 o = Oc[dt] * g0 + Os[dt] * g1 + Ow[dt] * g2;
            u32x2 w; w.x = pk2(o[0], o[1]); w.y = pk2(o[2], o[3]); *(u32x2*)(MIX + m * DM + head * 64 + 16 * dt + 4 * fq) = w; }
    }
    __syncthreads();
}
struct Args { const float* in[23]; float* out; unsigned char* ws; int ph_lo, ph_hi, use_bar, grid; };

static_assert(sizeof(Args) == 216, "Args layout");
__device__ __forceinline__ int lane_id_opaque() { int x; asm volatile("v_mbcnt_lo_u32_b32 %0, -1, 0\n\tv_mbcnt_hi_u32_b32 %0, -1, %0" : "=v"(x)); return x; }
template <int OFF> __device__ __forceinline__ unsigned long long karg64() {
    unsigned long long v; const unsigned long long kp = (unsigned long long)__builtin_amdgcn_kernarg_segment_ptr();
    asm volatile("s_load_dwordx2 %0, %1, %2\n\ts_waitcnt lgkmcnt(0)" : "=s"(v) : "s"(kp), "n"(OFF) : "memory");
    return v;
}
template <int OFF> __device__ __forceinline__ int karg32() {
    int v; const unsigned long long kp = (unsigned long long)__builtin_amdgcn_kernarg_segment_ptr();
    asm volatile("s_load_dword %0, %1, %2\n\ts_waitcnt lgkmcnt(0)" : "=s"(v) : "s"(kp), "n"(OFF) : "memory");
    return v;
}
#define KIN(k) ((const float*)karg64<8 * (k)>())
#define K_LO() karg32<200>()
#define K_HI() karg32<204>()
#define K_USEBAR() karg32<208>()
#define K_GRID() karg32<212>()
#define KOUT() ((float*)karg64<184>())
#define KWS() ((unsigned char*)karg64<192>())

__global__ void __launch_bounds__(NWAVES * 64, 2) fwd(Args args) {
    extern __shared__ __attribute__((aligned(16))) unsigned char lds_raw[];
    LAS unsigned char* lds = (LAS unsigned char*)lds_raw;
#define MISC ((volatile LAS unsigned*)(lds + MISC_OFF))
    int wave = __builtin_amdgcn_readfirstlane((int)threadIdx.x >> 6);
#define LANE_ID() lane_id_opaque()
#define TID_NOW() (wave * 64 + LANE_ID())
    { const int tid0 = TID_NOW();
      for (int u = tid0; u < (LDS_BYTES - LDSCTL_OFF) / 4; u += NWAVES * 64) ((LAS unsigned*)(lds + LDSCTL_OFF))[u] = 0u; }
    __syncthreads();
    if (K_USEBAR()) (void)xcd_barrier_post((unsigned*)(KWS() + WS_CTL) + CW_BAR, MISC + 8, (wave == 0) ? 1u : 0u);
#define PH_COMMON() int bid_ = (int)blockIdx.x; asm volatile("" : "+s"(bid_)); const int G = K_GRID(), bid = bid_, gw = bid * NWAVES + wave, NGW = G * NWAVES, NGT = G * NWAVES * 64; (void)gw; (void)NGW; (void)NGT
#ifndef PH_ENABLE
#define PH_ENABLE 0xFFFFFFFFu
#endif
#define PHBIT(k) (((k) < PH_L0) ? (k) : (PH_L0 + ((k) - PH_L0) % PH_PER_LAYER))
#define IN(k) (((PH_ENABLE >> PHBIT(k)) & 1u) && K_LO() <= (k) && (k) < K_HI())
#ifndef PH_REPEAT
#define PH_REPEAT 0u
#endif
#define REP(k) for (int rep_ = 0; rep_ < ((((PH_REPEAT) >> PHBIT(k)) & 1u) ? 2 : 1); ++rep_)
#define SEAM(k) do { if (K_USEBAR() && (k) + 1 < K_HI()) { XcdBarrier bar_; bar_.bar = (unsigned*)(KWS() + WS_CTL) + CW_BAR; bar_.x = xb_xcc_id(); bar_.st = MISC + 8; bar_.w0 = (wave == 0) ? 1u : 0u; xcd_barrier(bar_); } } while (0)

    if (IN(PH_P0A)) { REP(PH_P0A) {
        unsigned char* ws = KWS(); float* out = KOUT();
        PH_COMMON(); const int lane = LANE_ID(), gt = bid * (NWAVES * 64) + wave * 64 + lane;
        LAS float* scr = (LAS float*)(lds + RING_OFF + wave * 16384);
        constexpr int I_IN = 16 * 73, I_OUT = 16 * 32, I_G = 16 * 88, I_D = 44 * 32, I_W1 = 32 * 8, I_W2 = 4 * 2;
        constexpr int I_LAYER = I_IN + I_OUT + 2 * I_G + I_D + 2 * I_W1 + 2 * I_W2;
        for (int it = gw; it < NLAYER * I_LAYER; it += NGW) {
            const int L = it / I_LAYER; int r = it % I_LAYER;
            if (r < I_IN) { transpose_item(KIN(6) + (size_t)L * DM * PIN, DM, PIN, (bf16*)(ws + WS_WIN_T) + (size_t)L * NIN * DM, RmInProj{}, scr, r, lane); continue; } r -= I_IN;
            if (r < I_OUT) { transpose_item(KIN(15) + (size_t)L * DM * DM, DM, DM, (bf16*)(ws + WS_WOUT_T) + (size_t)L * DM * DM, RmIdent{}, scr, r, lane); continue; } r -= I_OUT;
            if (r < I_G) { transpose_item(KIN(18) + (size_t)L * DM * FFN, DM, FFN, (bf16*)(ws + WS_WGU_T) + (size_t)L * NGU * DM, RmAffine{2, 0}, scr, r, lane); continue; } r -= I_G;
            if (r < I_G) { transpose_item(KIN(19) + (size_t)L * DM * FFN, DM, FFN, (bf16*)(ws + WS_WGU_T) + (size_t)L * NGU * DM, RmAffine{2, 1}, scr, r, lane); continue; } r -= I_G;
            if (r < I_D) { transpose_item(KIN(20) + (size_t)L * FFN * DM, FFN, DM, (bf16*)(ws + WS_WDN_T) + (size_t)L * DM * FFN, RmIdent{}, scr, r, lane); continue; } r -= I_D;
            if (r < 2 * I_W1) { const int kind = r / I_W1; transpose_item(KIN(8) + (size_t)(L * 2 + kind) * 2048 * 256, 2048, 256, (bf16*)(ws + WS_W1C_T) + (size_t)(L * 2 + kind) * 256 * 2048, RmIdent{}, scr, r % I_W1, lane); continue; } r -= 2 * I_W1;
            { const int kind = r / I_W2; transpose_item(KIN(10) + (size_t)(L * 2 + kind) * 256 * 64, 256, 64, (bf16*)(ws + WS_W2C_T) + (size_t)(L * 2 + kind) * 64 * 256, RmIdent{}, scr, r % I_W2, lane); }
        }
        for (int i = gt; i < NLAYER * (NIN - PIN) * (DM / 8); i += NGT) { const int L = i / ((NIN - PIN) * (DM / 8)), r = i % ((NIN - PIN) * (DM / 8));
            *(v4u*)((bf16*)(ws + WS_WIN_T) + (size_t)L * NIN * DM + (size_t)PIN * DM + (size_t)r * 8) = (v4u){0u, 0u, 0u, 0u}; }
        for (int i = gt; i < TP * 32; i += NGT) {
            const int pos = i >> 5, d = i & 31;
            double fr_ = 1.0; for (int k = 0; k < d; ++k) fr_ *= 0.7498942093324558;
            const float angf = (float)pos * (float)fr_;
            const double a = (double)angf;
            const double kq = __builtin_rint(a * 0.63661977236758134308);
            double rr = __builtin_fma(-kq, 1.57079632673412561417e+00, a); rr = __builtin_fma(-kq, 6.07710050650619224932e-11, rr);
            const double r2 = rr * rr;
            double sp = -7.6471637318198164759e-13; sp = sp * r2 + 1.6059043836821614599e-10; sp = sp * r2 - 2.5052108385441718775e-08; sp = sp * r2 + 2.7557319223985890653e-06;
            sp = sp * r2 - 1.9841269841269841270e-04; sp = sp * r2 + 8.3333333333333333333e-03; sp = sp * r2 - 1.6666666666666666667e-01; const double sn = rr + rr * r2 * sp;
            double cp = 4.7794773323873852974e-14; cp = cp * r2 - 1.1470745597729724714e-11; cp = cp * r2 + 2.0876756987868098979e-09; cp = cp * r2 - 2.7557319223985890653e-07;
            cp = cp * r2 + 2.4801587301587301587e-05; cp = cp * r2 - 1.3888888888888888889e-03; cp = cp * r2 + 4.1666666666666666667e-02; cp = cp * r2 - 0.5; const double cn = 1.0 + r2 * cp;
            const int q4 = ((int)kq) & 3;
            const double c = (q4 == 0) ? cn : (q4 == 1) ? -sn : (q4 == 2) ? -cn : sn;
            const double s = (q4 == 0) ? sn : (q4 == 1) ? cn : (q4 == 2) ? -sn : -cn;
            ((f32x2*)(ws + WS_ROPE))[i] = (f32x2){(float)c, (float)s};
        }
        { const float* xp = KIN(0); const float* xs = KIN(1); float* XF = (float*)(ws + WS_XF); bf16* XB = (bf16*)(ws + WS_XB);
        for (int row = gw; row < MT; row += NGW) {
            const float* src = row < MP ? xp + (size_t)row * DM : xs + (size_t)(row - MP) * DM;
#pragma unroll
            for (int j = 0; j < 4; ++j) { const int c = (j * 64 + lane) * 4; const pg8::f32x4 v = *(const pg8::f32x4*)(src + c);
                *(pg8::f32x4*)(XF + (size_t)row * DM + c) = v; u32x2 w; w.x = pk2(v[0], v[1]); w.y = pk2(v[2], v[3]); *(u32x2*)(XB + (size_t)row * DM + c) = w; }
        } }
        { const float* gws = KIN(13); const float* gbs = KIN(14); bf16* GWP = (bf16*)(ws + WS_GWP); bf16* GWS = (bf16*)(ws + WS_GWS); float* GBS = (float*)(ws + WS_GBS);
        for (int i = gt; i < NLAYER * 8 * 128 * 128; i += NGT) {
            const int lh = i >> 14, t = (i >> 7) & 127, s = i & 127;
            const float* wsrc = gws + (size_t)lh * 16384;
            GWP[i] = (bf16)f2bf((s <= t) ? wsrc[t * 128 + s] : 0.f);
            GWS[i] = (bf16)f2bf(((t >> 2) == (s >> 2) && (s & 3) <= (t & 3)) ? wsrc[(t & 3) * 128 + (s & 3)] : 0.f);
        }
        for (int i = gt; i < NLAYER * 8 * 128; i += NGT) GBS[i] = gbs[(i & ~127) + (i & 3)]; }
        { const float* st = KIN(4);
        for (int i = gt; i < NLAYER * NB_S * 508 * 64; i += NGT) { const int lb = i / (508 * 64), r = i % (508 * 64);
            *(pg8::f32x4*)(out + O_WINS + (size_t)lb * 512 * KVW + (size_t)r * 4) = *(const pg8::f32x4*)(st + (size_t)lb * 512 * KVW + 4 * KVW + (size_t)r * 4); } }
        } SEAM(PH_P0A);
    }
    if (IN(PH_P0B)) { REP(PH_P0B) {
        unsigned char* ws = KWS();
        PH_COMMON(); int tid = TID_NOW(); asm volatile("" : "+v"(tid));
        const int* PT = (const int*)KIN(5); const float* cache = KIN(2); const float* pe = KIN(7); const float* b1 = KIN(9);
        for (int u = bid; u < NLAYER * 2 * 256; u += G) {
            const int L = u >> 9, kind = (u >> 8) & 1, rb = u & 255;
            const int R = rb * 64 + (tid >> 3), bs = R >> 7, n = (R >> 1) & 63, g = R & 1;
            const int page = PT[bs * NPG + (n >> 2)];
            const float* arow = cache + ((size_t)L * NPOOL + page) * PAGE * KVW + (size_t)((n & 3) * 32) * KVW + kind * 128 + g * 64 + (tid & 7) * 8;
            compress_unit(lds + RING_OFF, arow, pe + (size_t)(L * 2 + kind) * 2048, (const bf16*)(ws + WS_W1C_T) + (size_t)(L * 2 + kind) * 256 * 2048, b1 + (L * 2 + kind) * 256,
                          (const bf16*)(ws + WS_W2C_T) + (size_t)(L * 2 + kind) * 64 * 256, (bf16*)(ws + (kind ? WS_CVS : WS_CKS)) + (size_t)L * NB_S * 2 * 64 * 64, 64, rb, tid);
        }
        } SEAM(PH_P0B);
    }
    for (int L = 0; L < NLAYER; ++L) {
        asm volatile("" : "+s"(wave), "+s"(lds));
        const int pb = PH_L0 + L * PH_PER_LAYER;
        if (IN(pb + 0)) { REP(pb + 0) {
            unsigned char* ws = KWS(); PH_COMMON();
            pg8::Gemm g{(const bf16*)(ws + WS_XB), (const bf16*)(ws + WS_WIN_T) + (size_t)L * NIN * DM, MT, NIN, DM}; pg8::StaticOrder S; S.init(MT, NIN, G, bid);
            EpiInProj E{L, ws, KOUT()};
            pg8::gemm_phase<EpiInProj, pg8::StaticOrder, true, true>(lds + RING_OFF, g, S, E, TID_NOW());
            } SEAM(pb + 0);
        }
        if (IN(pb + 1)) { REP(pb + 1) {
            unsigned char* ws = KWS(); float* out = KOUT(); PH_COMMON();
            int tid = TID_NOW(); asm volatile("" : "+v"(tid));
            for (int u = bid; u < 64 + 132; u += G) {
                if (u < 64) {
                    const int kind = u >> 5, rb = u & 31;
                    const int R0 = rb * 32 + (tid & 15), R1 = R0 + 16;
                    const float* rowbase0 = out + O_CMPP + ((size_t)(L * BP + (R0 >> 9)) * TP + 32 * ((R0 >> 1) & 255)) * KVW + kind * 128 + (R0 & 1) * 64;
                    const float* rowbase1 = out + O_CMPP + ((size_t)(L * BP + (R1 >> 9)) * TP + 32 * ((R1 >> 1) & 255)) * KVW + kind * 128 + (R1 & 1) * 64;
                    compress32_unit(lds + RING_OFF, rowbase0, rowbase1, KIN(7) + (size_t)(L * 2 + kind) * 2048, (const bf16*)(ws + WS_W1C_T) + (size_t)(L * 2 + kind) * 256 * 2048, KIN(9) + (L * 2 + kind) * 256,
                                    (const bf16*)(ws + WS_W2C_T) + (size_t)(L * 2 + kind) * 64 * 256, (bf16*)(ws + (kind ? WS_CVP : WS_CKP)), 256, rb, tid);
#if ATT_PROBE
                    {
                        __syncthreads();
                        const int rb64 = rb >> 1;
                        const int R = rb64 * 64 + (tid >> 3), b_ = R >> 9, n_ = (R >> 1) & 255, g_ = R & 1;
                        const float* arow = out + O_CMPP + ((size_t)(L * BP + b_) * TP + 32 * n_) * KVW + kind * 128 + g_ * 64 + (tid & 7) * 8;
                        bf16* alt = (bf16*)(ws + WS_DBG2) + (size_t)kind * 4 * 256 * 64;
                        if ((rb & 1) == 0) compress_unit(lds + RING_OFF, arow, KIN(7) + (size_t)(L * 2 + kind) * 2048, (const bf16*)(ws + WS_W1C_T) + (size_t)(L * 2 + kind) * 256 * 2048, KIN(9) + (L * 2 + kind) * 256,
                                      (const bf16*)(ws + WS_W2C_T) + (size_t)(L * 2 + kind) * 64 * 256, alt, 256, rb64, tid);
                    }
#endif
                } else {
                    const int q = u - 64;
                    if (q < 128) gmlp_unit(lds + RING_OFF, lds + LDSCTL_OFF + 1024, 128 * q, (const bf16*)(ws + WS_U), (const bf16*)(ws + WS_V), (const bf16*)(ws + WS_GWP) + (size_t)L * 8 * 16384, KIN(14) + L * 1024,
                                           KIN(11) + L * 512, KIN(12) + L * 512, (bf16*)(ws + WS_MIX), (float*)nullptr, tid);
                    else gmlp_unit(lds + RING_OFF, lds + LDSCTL_OFF + 1024, MP + 128 * (q - 128), (const bf16*)(ws + WS_U), (const bf16*)(ws + WS_V), (const bf16*)(ws + WS_GWS) + (size_t)L * 8 * 16384, (const float*)(ws + WS_GBS) + L * 1024,
                                   KIN(11) + L * 512, KIN(12) + L * 512, (bf16*)(ws + WS_MIX), out + O_GV + ((size_t)L * MS + 128 * (q - 128)) * 512, tid);
                }
            }
            } SEAM(pb + 1);
        }
        if (IN(pb + 2)) { REP(pb + 2) {
            unsigned char* ws = KWS(); float* out = KOUT(); PH_COMMON();
            int tid = TID_NOW(); asm volatile("" : "+v"(tid));
            const int lane = tid & 63;
#if ATT_PROBE
            float* dbg = (float*)(ws + WS_DBG);
#else
            float* dbg = nullptr;
#endif
#ifndef ATT_REP_PROMPT
#define ATT_REP_PROMPT 1
#endif
#ifndef ATT_REP_SAMPLE
#define ATT_REP_SAMPLE 1
#endif
            int nrep_p = ATT_REP_PROMPT; asm volatile("" : "+s"(nrep_p));
#pragma unroll 1
            for (int rp_ = 0; rp_ < nrep_p; ++rp_)
            for (int u = bid; u < 512; u += G) {
                const int c = u & 255, xcd = c & 7, cc = ((c >> 3) << 1) | (c & 1);
                attn_prompt_unit(lds + RING_OFF, (LAS unsigned*)(lds + LDSCTL_OFF + 2048), ws, xcd >> 1, (u >> 8) ? 127 - cc : cc, tid, dbg);
            }
            __syncthreads();
            const bf16* QRAW = (const bf16*)(ws + WS_QRAW); const bf16* QROT = (const bf16*)(ws + WS_QROT); bf16* MIX = (bf16*)(ws + WS_MIX); const float* GATES = (const float*)(ws + WS_GATES);
            LAS float* wl = (LAS float*)(lds + RING_OFF + wave * 4096);
            LAS float* qraw_l = wl; LAS float* qrot_l = wl + 256; LAS float* pbuf = wl + 512; LAS float* impb = wl + 768; LAS int* selidx = (LAS int*)(wl + 896);
            int nrep_s = ATT_REP_SAMPLE; asm volatile("" : "+s"(nrep_s));
#pragma unroll 1
            for (int rp_ = 0; rp_ < nrep_s; ++rp_)
            for (int u = bid; u < 2 * NB_S; u += G) {
                const int bs = u >> 1, g = u & 1;
                attn_sample_unit(lds + RING_OFF, ws, out, KIN(3) + (size_t)L * NPOOL * PAGE * KVW, (const int*)KIN(5) + bs * NPG, KIN(4) + ((size_t)L * NB_S + bs) * 512 * KVW, L, bs, g, wave, lane);
            }
#if ATT_PROBE
            float esum[10] = {0.f, 0.f, 0.f, 0.f, 0.f, 0.f, 0.f, 0.f, 0.f, 0.f};
            {
                const bf16* A0 = (const bf16*)(ws + WS_CKP); const bf16* A1 = (const bf16*)(ws + WS_CVP); const bf16* B0 = (const bf16*)(ws + WS_DBG2);
                for (int i = gw * 64 + lane; i < 2 * 4 * 256 * 64; i += NGW * 64) { const int kind = i / (4 * 256 * 64), r = i % (4 * 256 * 64);
                    const float a = bf2f((kind ? A1 : A0)[r]), b = bf2f(B0[i]); esum[8] += (a - b) * (a - b); esum[9] += b * b; } }
            for (int task = gw; task < 2 * MT; task += NGW) {
#else
            for (int task = 2 * MT + gw; task < 2 * MT; task += NGW) {
#endif
                const int m = task >> 1, g = task & 1;
                const bool prompt = m < MP;
#pragma unroll
                for (int r = 0; r < 4; ++r) { qraw_l[r * 64 + lane] = 0.125f * bf2f(QRAW[(size_t)m * 512 + (g * 4 + r) * 64 + lane]); qrot_l[r * 64 + lane] = 0.125f * bf2f(QROT[(size_t)m * 512 + (g * 4 + r) * 64 + lane]); }
                impb[lane] = 0.f; impb[64 + lane] = 0.f;
                WAVE_LDS_FENCE();
                float oc[4], os[4], ow[4];
                if (prompt) {
                    const int b = m >> 13, t = m & (TP - 1); const size_t bg = (size_t)(b * 2 + g);
                    const SrcPromptCmp sc{(const bf16*)(ws + WS_CKP) + bg * 256 * 64, (const bf16*)(ws + WS_CVP) + bg * 256 * 64, (t + 1) >> 5};
                    attend(sc, (sc.nvalid + 63) >> 6, qraw_l, pbuf, lane, oc, impb);
                    WAVE_LDS_FENCE();
                    topk16(impb, 128, t >> 6, selidx, lane);
                    const SrcPromptSlc ss{(const bf16*)(ws + WS_KS) + bg * TP * 64, (const bf16*)(ws + WS_VS) + bg * TP * 64, selidx, t};
                    attend(ss, 16, qrot_l, pbuf, lane, os, (LAS float*)nullptr);
                    const int kb0 = (t > 511 ? t - 511 : 0) >> 6;
                    const SrcPromptWin sw{(const bf16*)(ws + WS_KW) + bg * TP * 64, (const bf16*)(ws + WS_VW) + bg * TP * 64, t, kb0};
                    attend(sw, (t >> 6) - kb0 + 1, qrot_l, pbuf, lane, ow, (LAS float*)nullptr);
#if ATT_PROBE
#pragma unroll
                    for (int r = 0; r < 4; ++r) { const float* dp = dbg + ((size_t)m * 3) * 512 + (g * 4 + r) * 64 + lane;
                        const float d0 = dp[0] - oc[r], d1 = dp[512] - os[r], d2 = dp[1024] - ow[r];
                        esum[0] += d0 * d0; esum[1] += oc[r] * oc[r]; esum[2] += d1 * d1; esum[3] += os[r] * os[r]; esum[4] += d2 * d2; esum[5] += ow[r] * ow[r]; }
                    WAVE_LDS_FENCE();
                    continue;
#endif
                } else {
                    const int si = m - MP, bs = si >> 2, s = si & 3;
                    const size_t co = (((size_t)L * NB_S + bs) * 2 + g) * 64 * 64;
                    const SrcSampleCmp sc{(const bf16*)(ws + WS_CKS) + co, (const bf16*)(ws + WS_CVS) + co};
                    attend(sc, 1, qraw_l, pbuf, lane, oc, impb);
                    WAVE_LDS_FENCE();
                    topk16(impb, 33, 32, selidx, lane);
                    const SrcSampleSlc ss{KIN(3) + (size_t)L * NPOOL * PAGE * KVW, (const int*)KIN(5) + bs * NPG, out + O_SLCS + ((size_t)L * MS + bs * 4) * KVW, selidx, g, s};
                    attend(ss, 16, qrot_l, pbuf, lane, os, (LAS float*)nullptr);
                    const SrcSampleWin sw{KIN(4) + ((size_t)L * NB_S + bs) * 512 * KVW, out + O_WINS + (((size_t)L * NB_S + bs) * 512 + 508) * KVW, g, s};
                    attend(sw, 9, qrot_l, pbuf, lane, ow, (LAS float*)nullptr);
                }
                const float* gtp = GATES + (size_t)m * 24;
#pragma unroll
                for (int r = 0; r < 4; ++r) { const int h = g * 4 + r; const float o = gtp[h] * oc[r] + gtp[8 + h] * os[r] + gtp[16 + h] * ow[r];
#if ATT_PROBE
                    const float mv = bf2f(MIX[(size_t)m * DM + h * 64 + lane]); esum[6] += (mv - o) * (mv - o); esum[7] += o * o;
#else
                    MIX[(size_t)m * DM + h * 64 + lane] = (bf16)f2bf(o);
#endif
                }
                WAVE_LDS_FENCE();
            }
#if ATT_PROBE
#pragma unroll
            for (int k = 0; k < 10; ++k) { const float v = wave_sum(esum[k]); if (lane == 0) atomicAdd((float*)(ws + WS_CTL) + CW_ERR + k, v); }
#endif
            __syncthreads();
            } SEAM(pb + 2);
        }
        if (IN(pb + 3)) { REP(pb + 3) {
            unsigned char* ws = KWS(); PH_COMMON();
            pg8::Gemm g{(const bf16*)(ws + WS_MIX), (const bf16*)(ws + WS_WOUT_T) + (size_t)L * DM * DM, MP, DM, DM}; pg8::StaticOrder S; S.init(MP, DM, G, bid);
            EpiResid E{(const float*)(ws + WS_XF), (float*)(ws + WS_PRE)};
            pg8::gemm_phase<EpiResid, pg8::StaticOrder, true, true>(lds + RING_OFF, g, S, E, TID_NOW());
            { int tid = TID_NOW(); asm volatile("" : "+v"(tid));
              for (int it = bid; it < 256; it += G) { const int rbk = it >> 5, cbk = it & 31; const size_t r0 = (size_t)MP + 64 * rbk;
                  skinny_item(lds + RING_OFF, (const bf16*)(ws + WS_MIX) + r0 * DM, (const bf16*)(ws + WS_WOUT_T) + (size_t)L * DM * DM + (size_t)(32 * cbk) * DM, DM,
                              (const float*)(ws + WS_XF) + r0 * DM + 32 * cbk, (float*)(ws + WS_PRE) + r0 * DM + 32 * cbk, tid); } }
            } SEAM(pb + 3);
        }
        if (IN(pb + 4)) { REP(pb + 4) {
            int lane = LANE_ID(); asm volatile("" : "+v"(lane));
            unsigned char* ws = KWS(); PH_COMMON(); const float* lg = KIN(16) + L * DM; const float* lb = KIN(17) + L * DM;
            for (int row = gw; row < MT; row += NGW) ln_row((const float*)(ws + WS_PRE) + (size_t)row * DM, lg, lb, (float*)(ws + WS_XF) + (size_t)row * DM, (bf16*)(ws + WS_XB) + (size_t)row * DM, lane);
            } SEAM(pb + 4);
        }
        if (IN(pb + 5)) { REP(pb + 5) {
            unsigned char* ws = KWS(); PH_COMMON();
            pg8::Gemm g{(const bf16*)(ws + WS_XB), (const bf16*)(ws + WS_WGU_T) + (size_t)L * NGU * DM, MT, NGU, DM}; pg8::StaticOrder S; S.init(MT, NGU, G, bid);
            EpiGateUp E{(bf16*)(ws + WS_F)};
            pg8::gemm_phase<EpiGateUp, pg8::StaticOrder, true, true>(lds + RING_OFF, g, S, E, TID_NOW());
            } SEAM(pb + 5);
        }
        if (IN(pb + 6)) { REP(pb + 6) {
            unsigned char* ws = KWS(); PH_COMMON();
            pg8::Gemm g{(const bf16*)(ws + WS_F), (const bf16*)(ws + WS_WDN_T) + (size_t)L * DM * FFN, MP, DM, FFN}; pg8::StaticOrder S; S.init(MP, DM, G, bid);
            EpiResid E{(const float*)(ws + WS_XF), (float*)(ws + WS_PRE)};
            pg8::gemm_phase<EpiResid, pg8::StaticOrder, true, true>(lds + RING_OFF, g, S, E, TID_NOW());
            { int tid = TID_NOW(); asm volatile("" : "+v"(tid));
              for (int it = bid; it < 256; it += G) { const int rbk = it >> 5, cbk = it & 31; const size_t r0 = (size_t)MP + 64 * rbk;
                  skinny_item(lds + RING_OFF, (const bf16*)(ws + WS_F) + r0 * FFN, (const bf16*)(ws + WS_WDN_T) + (size_t)L * DM * FFN + (size_t)(32 * cbk) * FFN, FFN,
                              (const float*)(ws + WS_XF) + r0 * DM + 32 * cbk, (float*)(ws + WS_PRE) + r0 * DM + 32 * cbk, tid); } }
            } SEAM(pb + 6);
        }
        if (IN(pb + 7)) { REP(pb + 7) {
            int lane = LANE_ID(); asm volatile("" : "+v"(lane));
            unsigned char* ws = KWS(); PH_COMMON(); const float* lg = KIN(21) + L * DM; const float* lb = KIN(22) + L * DM;
            const bool last = (L == NLAYER - 1);
            float* dstf = last ? KOUT() + O_Y : (float*)(ws + WS_XF);
            for (int row = gw; row < MT; row += NGW) ln_row((const float*)(ws + WS_PRE) + (size_t)row * DM, lg, lb, dstf + (size_t)row * DM, last ? (bf16*)nullptr : (bf16*)(ws + WS_XB) + (size_t)row * DM, lane);
#if ATT_PROBE
            if (last) {
                const float* e = (const float*)(ws + WS_CTL) + CW_ERR;
                const float e0 = sqrtf(e[0] / fmaxf(e[1], 1e-30f)), e1 = sqrtf(e[2] / fmaxf(e[3], 1e-30f)), e2 = sqrtf(e[4] / fmaxf(e[5], 1e-30f));
                const float e3 = sqrtf(e[6] / fmaxf(e[7], 1e-30f)), e4 = sqrtf(e[8] / fmaxf(e[9], 1e-30f));
                const float E = ATT_PROBE_SEL == 0 ? e0 : ATT_PROBE_SEL == 1 ? e1 : ATT_PROBE_SEL == 2 ? e2 : ATT_PROBE_SEL == 4 ? e3 : ATT_PROBE_SEL == 5 ? e4 : fmaxf(e0, fmaxf(e1, e2));
                float* o8 = KOUT() + O_GV;
                for (int i = bid * (NWAVES * 64) + wave * 64 + lane; i < NLAYER * MS * 512; i += NGT) o8[i] *= (1.0f + ATT_PROBE_GAIN * E);
            }
#endif
            } SEAM(pb + 7);
        }
    }
#undef IN
#undef SEAM
}

#ifndef SPLIT_LAUNCHES
#define SPLIT_LAUNCHES 0
#endif
extern "C" void kernel_launch(void* const* d_in, const int* in_sizes, int n_in, void* d_out, int out_size, void* d_ws, size_t ws_size, hipStream_t stream) {
    static int grid = 0;
    if (grid == 0) {
        if (n_in != 23 || (size_t)out_size != O_END || ws_size < WS_END) { fprintf(stderr, "kernel_launch: unexpected sizes (n_in %d, out %d, ws %zu); nothing launched\n", n_in, out_size, ws_size); grid = -1; return; }
        int dev = 0, cus = 0, per_cu = 0;
        if (hipGetDevice(&dev) != hipSuccess || hipDeviceGetAttribute(&cus, hipDeviceAttributeMultiprocessorCount, dev) != hipSuccess) { fprintf(stderr, "kernel_launch: device query failed\n"); grid = -1; return; }
        if (hipFuncSetAttribute((const void*)fwd, hipFuncAttributeMaxDynamicSharedMemorySize, LDS_BYTES) != hipSuccess) { fprintf(stderr, "kernel_launch: hipFuncSetAttribute failed\n"); grid = -1; return; }
        if (hipOccupancyMaxActiveBlocksPerMultiprocessor(&per_cu, (const void*)fwd, NWAVES * 64, LDS_BYTES) != hipSuccess || per_cu < 1) fprintf(stderr, "kernel_launch: note: occupancy query reports %d\n", per_cu);
        (void)hipGetLastError();
        grid = cus;
    }
    if (grid < 0) return;
    if (hipMemsetAsync((char*)d_ws + WS_CTL, 0, CTL_ZERO_BYTES, stream) != hipSuccess) { fprintf(stderr, "kernel_launch: memset failed\n"); return; }
    Args a{};
    for (int i = 0; i < 23; ++i) a.in[i] = (const float*)d_in[i];
    a.out = (float*)d_out; a.ws = (unsigned char*)d_ws;
#if SPLIT_LAUNCHES
    for (int ph = 0; ph < N_PHASES; ++ph) { a.ph_lo = ph; a.ph_hi = ph + 1; a.use_bar = 0; a.grid = grid;
        hipLaunchKernelGGL(fwd, dim3(grid), dim3(NWAVES * 64), LDS_BYTES, stream, a); }
#else
    a.ph_lo = 0; a.ph_hi = N_PHASES; a.use_bar = 1; a.grid = grid;
    hipLaunchKernelGGL(fwd, dim3(grid), dim3(NWAVES * 64), LDS_BYTES, stream, a);
#endif
    const hipError_t le = hipPeekAtLastError();
    if (le != hipSuccess) fprintf(stderr, "kernel_launch: launch failed: %s\n", hipGetErrorName(le));
}
```

```cpp
#include <hip/hip_runtime.h>
#include <cstdio>
#include <cstdint>
#include <cmath>
namespace pg8 {
#define PG8_LAS __attribute__((address_space(3)))
typedef unsigned short bf16_t;
typedef short bf16x8 __attribute__((ext_vector_type(8)));
typedef float f32x4 __attribute__((ext_vector_type(4)));
typedef unsigned u32x4 __attribute__((ext_vector_type(4)));
constexpr int BM = 256, BK = 64, HALF = 128, HTB = HALF * BK * 2  , STAGE_BYTES = 8 * HTB, NXCD = 8, WGM = 8;

__host__ __device__ __forceinline__ int lds_byte(int r, int c) { const int st = (r >> 4) * 2 + (c >> 5), rr = r & 15, cc = c & 31, ob = rr * 64 + cc * 2; return st * 1024 + (ob ^ (((ob >> 9) & 1) << 5)); }
__host__ __device__ __forceinline__ void stage_rc(int b, int& R, int& C) { const int st = b / 1024, sb = b % 1024, swz = sb ^ (((sb >> 9) & 1) << 5); R = (st >> 1) * 16 + swz / 64; C = (st & 1) * 32 + (swz % 64) / 2; }
__host__ __device__ __forceinline__ int perm32(int rho) { const int n = rho >> 4, i = rho & 15; return 8 * (i >> 2) + 4 * n + (i & 3); }

struct Unit { int pm, pn; };
struct Gemm { const bf16_t* A; const bf16_t* Bt; int M, N, K; };

struct StaticOrder {
    int nM, nN, nwg, G, c;
    __host__ __device__ void init(int M, int N, int G_, int c_) { nM = M / BM; nN = N / BM; nwg = nM * nN; G = G_; c = c_; }
    __host__ __device__ bool next(int i, Unit& u) const {
        const long L = (long)i * G + c; if (L >= nwg) return false;
        int wgid = (int)L; { const int q = nwg / NXCD, r = nwg % NXCD, xcd = wgid % NXCD, off = wgid / NXCD; wgid = (xcd < r ? xcd * (q + 1) : r * (q + 1) + (xcd - r) * q) + off; }
        const int nig = WGM * nN, gid = wgid / nig, fm = gid * WGM, gsz = (nM - fm) < WGM ? (nM - fm) : WGM;
        u.pm = fm + ((wgid % nig) % gsz); u.pn = (wgid % nig) / gsz; return true;
    }
    __device__ __forceinline__ void a_ready(const Unit&) const {}
    __device__ __forceinline__ void done(const Unit&) const {}
};
__device__ __forceinline__ unsigned cvt_pk_bf16(float lo, float hi) { unsigned r; asm volatile("v_cvt_pk_bf16_f32 %0, %1, %2" : "=v"(r) : "v"(lo), "v"(hi)); return r; }
typedef float f32x2 __attribute__((ext_vector_type(2)));
template <class Epi, class Sched, bool ALIGN_EPI = false, bool SP2 = false>
__device__ __forceinline__ void gemm_phase(PG8_LAS unsigned char* lds, const Gemm g, const Sched& S, const Epi& E, int tid_in) {
    int tid_ = tid_in; asm volatile("" : "+v"(tid_));
    const int tid = tid_, wid = __builtin_amdgcn_readfirstlane(tid >> 6), lane = tid & 63, wr = wid >> 2, wc = wid & 3, fr = lane & 15, fq = lane >> 4;
    const int K = g.K, nt = K / BK;
    unsigned voffA[2], voffB[2];
#pragma unroll
    for (int i = 0; i < 2; ++i) { int R, C; stage_rc(tid * 16 + i * 8192, R, C); const int Rb = Epi::PERM ? ((R & ~31) + perm32(R & 31)) : R;
        voffA[i] = (unsigned)(R * K + C) * 2u; voffB[i] = (unsigned)(Rb * K + C) * 2u; }
    const size_t kstep = (size_t)(BK * 2);
    const size_t hstep = (size_t)HALF * K * 2;
    const size_t tstep = 2 * hstep;
    const unsigned ldsw = (unsigned)wid * 1024u;
    const int aoff = lds_byte(wr * 64 + fr, fq * 8), boff = lds_byte(wc * 32 + fr, fq * 8);
#define PG8_SA(b, h) (((b) * 2 + (h)) * HTB)
#define PG8_SB(b, h) ((4 + (b) * 2 + (h)) * HTB)
#define PG8_STAGE(bufoff, gbase, voff) do { _Pragma("unroll") for (int _i = 0; _i < 2; ++_i) \
        __builtin_amdgcn_global_load_lds((const unsigned*)((const char*)(gbase) + (voff)[_i]), (PG8_LAS unsigned*)(lds + (bufoff) + ldsw + _i * 8192), 16, 0, 0); } while (0)
#define PG8_LDA(dst, b, h) do { _Pragma("unroll") for (int m = 0; m < 4; ++m) _Pragma("unroll") for (int k = 0; k < 2; ++k) dst[m][k] = *(const PG8_LAS bf16x8*)(lds + PG8_SA(b, h) + aoff + m * 2048 + k * 1024); } while (0)
#define PG8_LDB(dst, b, h) do { _Pragma("unroll") for (int n = 0; n < 2; ++n) _Pragma("unroll") for (int k = 0; k < 2; ++k) dst[n][k] = *(const PG8_LAS bf16x8*)(lds + PG8_SB(b, h) + boff + n * 2048 + k * 1024); } while (0)
#define PG8_MMA(ai, bj, At, Bt) do { __builtin_amdgcn_s_setprio(1); _Pragma("unroll") for (int m = 0; m < 4; ++m) _Pragma("unroll") for (int n = 0; n < 2; ++n) _Pragma("unroll") for (int k = 0; k < 2; ++k) \
        acc[ai][bj][m][n] = __builtin_amdgcn_mfma_f32_16x16x32_bf16(Bt[n][k], At[m][k], acc[ai][bj][m][n], 0, 0, 0); __builtin_amdgcn_s_setprio(0); } while (0)
#define PG8_WAIT_V(n) asm volatile("s_waitcnt vmcnt(" #n ")" ::: "memory")
#define PG8_WAIT_L(n) asm volatile("s_waitcnt lgkmcnt(" #n ")" ::: "memory")
#define PG8_BAR __builtin_amdgcn_s_barrier()
#define PG8_SCHED __builtin_amdgcn_sched_barrier(0)
    Unit cur, nxt; int ui = 0;
    if (!S.next(0, cur)) return;
    f32x4 acc[2][2][4][2];
#pragma unroll
    for (int a = 0; a < 2; ++a)
#pragma unroll
        for (int b = 0; b < 2; ++b)
#pragma unroll
            for (int m = 0; m < 4; ++m)
#pragma unroll
                for (int n = 0; n < 2; ++n) acc[a][b][m][n] = (f32x4){0.f, 0.f, 0.f, 0.f};
    bf16x8 At[4][2], B0[2][2], B1[2][2];
    const char* cA = (const char*)g.A + (size_t)cur.pm * tstep; const char* cB = (const char*)g.Bt + (size_t)cur.pn * tstep;
    S.a_ready(cur);
    if constexpr (SP2) {
        PG8_STAGE(PG8_SB(0, 0), cB, voffB); PG8_STAGE(PG8_SB(0, 1), cB + hstep, voffB); PG8_STAGE(PG8_SA(0, 0), cA, voffA); PG8_STAGE(PG8_SA(0, 1), cA + hstep, voffA);
        if (wr == 1) PG8_BAR;
        PG8_WAIT_V(2); PG8_BAR;
        PG8_STAGE(PG8_SB(1, 0), cB + kstep, voffB); PG8_STAGE(PG8_SA(1, 0), cA + kstep, voffA); PG8_STAGE(PG8_SB(1, 1), cB + hstep + kstep, voffB);
        PG8_WAIT_V(6); PG8_BAR;
    } else {
        PG8_STAGE(PG8_SB(0, 0), cB, voffB); PG8_STAGE(PG8_SA(0, 0), cA, voffA); PG8_STAGE(PG8_SB(0, 1), cB + hstep, voffB); PG8_STAGE(PG8_SA(0, 1), cA + hstep, voffA);
        if (wr == 1) PG8_BAR;
        PG8_WAIT_V(4); PG8_BAR;
        PG8_STAGE(PG8_SB(1, 0), cB + kstep, voffB); PG8_STAGE(PG8_SA(1, 0), cA + kstep, voffA); PG8_STAGE(PG8_SB(1, 1), cB + hstep + kstep, voffB);
        PG8_WAIT_V(6); PG8_BAR;
    }
    for (;;) {
        const bool has_next = S.next(ui + 1, nxt);
        const char* nA = has_next ? (const char*)g.A + (size_t)nxt.pm * tstep : cA; const char* nB = has_next ? (const char*)g.Bt + (size_t)nxt.pn * tstep : cB;
        for (int t = 0; t < nt; t += 2) {
            const bool last = (t == nt - 2);
            const char* a1 = cA + (size_t)(t + 1) * kstep;
            const char* a2 = last ? nA : cA + (size_t)(t + 2) * kstep; const char* b2 = last ? nB : cB + (size_t)(t + 2) * kstep;
            const char* a3 = a2 + kstep; const char* b3 = b2 + kstep;
            if (last && has_next) S.a_ready(nxt);
            if constexpr (SP2) {
            PG8_LDB(B0, 0, 0); PG8_LDB(B1, 0, 1); PG8_SCHED; PG8_LDA(At, 0, 0); PG8_STAGE(PG8_SA(1, 1), a1 + hstep, voffA);
            PG8_WAIT_V(8); PG8_WAIT_L(0); PG8_BAR; PG8_MMA(0, 0, At, B0); PG8_MMA(0, 1, At, B1); PG8_BAR; PG8_SCHED;
            PG8_LDA(At, 0, 1); PG8_STAGE(PG8_SB(0, 0), b2, voffB); PG8_STAGE(PG8_SB(0, 1), b2 + hstep, voffB); PG8_STAGE(PG8_SA(0, 0), a2, voffA);
            PG8_WAIT_V(8); PG8_WAIT_L(0); PG8_BAR; PG8_MMA(1, 0, At, B0); PG8_MMA(1, 1, At, B1); PG8_BAR; PG8_SCHED;
            PG8_LDB(B0, 1, 0); PG8_LDB(B1, 1, 1); PG8_SCHED; PG8_LDA(At, 1, 0); PG8_STAGE(PG8_SA(0, 1), a2 + hstep, voffA);
            PG8_WAIT_V(8); PG8_WAIT_L(0); PG8_BAR; PG8_MMA(0, 0, At, B0); PG8_MMA(0, 1, At, B1); PG8_BAR; PG8_SCHED;
            PG8_LDA(At, 1, 1); PG8_STAGE(PG8_SB(1, 0), b3, voffB); PG8_STAGE(PG8_SB(1, 1), b3 + hstep, voffB); PG8_STAGE(PG8_SA(1, 0), a3, voffA);
            PG8_WAIT_V(8); PG8_WAIT_L(0); PG8_BAR; PG8_MMA(1, 0, At, B0); PG8_MMA(1, 1, At, B1); PG8_BAR; PG8_SCHED;
            } else {
            PG8_LDB(B0, 0, 0); PG8_SCHED; PG8_LDA(At, 0, 0); PG8_STAGE(PG8_SA(1, 1), a1 + hstep, voffA);
            PG8_WAIT_L(8); PG8_BAR; PG8_WAIT_L(0); PG8_MMA(0, 0, At, B0); PG8_BAR; PG8_SCHED;
            PG8_LDB(B1, 0, 1); PG8_STAGE(PG8_SB(0, 0), b2, voffB);
            PG8_BAR; PG8_WAIT_L(0); PG8_MMA(0, 1, At, B1); PG8_BAR;
            PG8_LDA(At, 0, 1); PG8_STAGE(PG8_SA(0, 0), a2, voffA);
            PG8_BAR; PG8_WAIT_L(0); PG8_MMA(1, 0, At, B0); PG8_BAR; PG8_SCHED;
            PG8_STAGE(PG8_SB(0, 1), b2 + hstep, voffB);
            PG8_WAIT_V(6); PG8_BAR; PG8_MMA(1, 1, At, B1); PG8_BAR;
            PG8_LDB(B0, 1, 0); PG8_SCHED; PG8_LDA(At, 1, 0); PG8_STAGE(PG8_SA(0, 1), a2 + hstep, voffA);
            PG8_WAIT_L(8); PG8_BAR; PG8_WAIT_L(0); PG8_MMA(0, 0, At, B0); PG8_BAR; PG8_SCHED;
            PG8_LDB(B1, 1, 1); PG8_STAGE(PG8_SB(1, 0), b3, voffB);
            PG8_BAR; PG8_WAIT_L(0); PG8_MMA(0, 1, At, B1); PG8_BAR;
            PG8_LDA(At, 1, 1); PG8_STAGE(PG8_SA(1, 0), a3, voffA);
            PG8_BAR; PG8_WAIT_L(0); PG8_MMA(1, 0, At, B0); PG8_BAR; PG8_SCHED;
            PG8_STAGE(PG8_SB(1, 1), b3 + hstep, voffB);
            PG8_WAIT_V(6); PG8_BAR; PG8_MMA(1, 1, At, B1); PG8_BAR;
            }
        }
        if constexpr (ALIGN_EPI) { if (wr == 0) PG8_BAR; }
        if constexpr (!Epi::AFTER_DRAIN) { E(acc, cur, wr, wc, fr, fq); S.done(cur); }
        if (!has_next) break;
#pragma unroll
        for (int a = 0; a < 2; ++a)
#pragma unroll
            for (int b = 0; b < 2; ++b)
#pragma unroll
                for (int m = 0; m < 4; ++m)
#pragma unroll
                    for (int n = 0; n < 2; ++n) acc[a][b][m][n] = (f32x4){0.f, 0.f, 0.f, 0.f};
        cur = nxt; cA = nA; cB = nB; ++ui;
        if constexpr (ALIGN_EPI) { if (wr == 1) PG8_BAR; }
    }
    PG8_WAIT_V(0);
    if constexpr (!ALIGN_EPI) { if (wr == 0) PG8_BAR; }
    PG8_BAR;
    if constexpr (Epi::AFTER_DRAIN) { E.fused(acc, cur, wr, wc, fr, fq, lds, wid, lane); S.done(cur); }
#undef PG8_SA
#undef PG8_SB
#undef PG8_STAGE
#undef PG8_LDA
#undef PG8_LDB
#undef PG8_MMA
#undef PG8_WAIT_V
#undef PG8_WAIT_L
#undef PG8_BAR
#undef PG8_SCHED
}
}
#define GAS __attribute__((address_space(1)))
#define LAS __attribute__((address_space(3)))
typedef unsigned short bf16;
typedef unsigned v4u __attribute__((ext_vector_type(4)));
typedef float f32x4 __attribute__((ext_vector_type(4)));
typedef short bf16x8 __attribute__((ext_vector_type(8)));
typedef GAS unsigned gu32;
typedef GAS unsigned long long gu64;
#define RLX_AGENT __ATOMIC_RELAXED, __HIP_MEMORY_SCOPE_AGENT
#define LDS_WAIT() asm volatile("s_waitcnt lgkmcnt(0)" ::: "memory")
#define VM_WAIT() asm volatile("s_waitcnt vmcnt(0)" ::: "memory")
__device__ __forceinline__ unsigned long long rt() { return __builtin_amdgcn_s_memrealtime(); }
__device__ __forceinline__ unsigned f2bf(float f) { unsigned u = __builtin_bit_cast(unsigned, f); return (u + 0x7fffu + ((u >> 16) & 1u)) >> 16; }
__device__ __forceinline__ unsigned pk2(float lo, float hi) { return f2bf(lo) | (f2bf(hi) << 16); }

#define XB_TMO      128
#define XB_XCNT(j)  (256  + 64 * (j))
#define XB_XSUB(j)  (1280 + 64 * (j))
#define XB_XGEN(j)  (2304 + 64 * (j))
#define XB_TOP      3328
#define XB_TOPGEN   3392
#define XCD_BAR_WORDS 3456
#define XB_SPIN_CAP (1u << 18)

__device__ __forceinline__ unsigned xb_ld(unsigned* p)              { return __hip_atomic_load(p, __ATOMIC_RELAXED, __HIP_MEMORY_SCOPE_AGENT); }
__device__ __forceinline__ unsigned xb_add(unsigned* p, unsigned v) { return __hip_atomic_fetch_add(p, v, __ATOMIC_RELAXED, __HIP_MEMORY_SCOPE_AGENT); }
__device__ __forceinline__ unsigned xb_xcc_id() { return (unsigned)__builtin_amdgcn_s_getreg((3 << 11) | 20) & 0xFu; }
#define XB_SPIN(cond, bar) do { unsigned _sp = 0; while (cond) { __builtin_amdgcn_s_sleep(1); \
    if ((++_sp & 255u) == 0u) { if (xb_ld(&(bar)[XB_TMO])) break; if (_sp > XB_SPIN_CAP) { atomicAdd(&(bar)[XB_TMO], 1u); break; } } } } while (0)

struct XcdBarrier {
    unsigned* bar; unsigned x;
    unsigned w0;
    volatile LAS unsigned* st;
};

#define XB_LANE0() (__builtin_amdgcn_mbcnt_hi(~0u, __builtin_amdgcn_mbcnt_lo(~0u, 0u)) == 0u)
__device__ __forceinline__ XcdBarrier xcd_barrier_post(unsigned* bar, volatile LAS unsigned* st, unsigned w0) {
    XcdBarrier b; b.bar = bar; b.x = xb_xcc_id(); b.st = st; b.w0 = w0;
    if (w0 && XB_LANE0()) (void)xb_add(&bar[XB_XCNT(b.x)], 1u);
    return b;
}
__device__ __forceinline__ void xcd_barrier_complete(unsigned* bar, unsigned x, unsigned& nloc, unsigned& nx) {
    const unsigned G = gridDim.x * gridDim.y * gridDim.z;
    unsigned sum, cnt, mine, sp = 0u;
    for (;;) {
        sum = 0u; cnt = 0u; mine = 0u;
#pragma unroll
        for (unsigned j = 0; j < 16; ++j) { const unsigned c = xb_ld(&bar[XB_XCNT(j)]); sum += c; cnt += (c > 0u) ? 1u : 0u; mine = (j == x) ? c : mine; }
        if (sum == G) break;
        __builtin_amdgcn_s_sleep(1);
        if ((++sp & 255u) == 0u) { if (xb_ld(&bar[XB_TMO])) break; if (sp > XB_SPIN_CAP) { atomicAdd(&bar[XB_TMO], 1u); break; } }
    }
    nloc = mine > 0u ? mine : 1u; nx = cnt > 0u ? cnt : 1u;
}

__device__ __forceinline__ void xcd_barrier(const XcdBarrier& b) {
    asm volatile("s_waitcnt vmcnt(0)" ::: "memory");
    __syncthreads();
    if (b.w0 && XB_LANE0()) {
        unsigned* bar = b.bar;
        __builtin_amdgcn_s_waitcnt(0);
        unsigned nloc = b.st[0], nx = b.st[1];
        if (nloc == 0u) { xcd_barrier_complete(bar, b.x, nloc, nx); b.st[0] = nloc; b.st[1] = nx; }
        const unsigned old = xb_add(&bar[XB_XSUB(b.x)], 1u);
        const unsigned gen = old / nloc;
        if (old + 1u == (gen + 1u) * nloc) {
            __builtin_amdgcn_fence(__ATOMIC_RELEASE, "agent");
            asm volatile("s_waitcnt vmcnt(0)" ::: "memory");
            const unsigned og = xb_add(&bar[XB_TOP], 1u);
            const unsigned tg = og / nx;
            if (og + 1u == (tg + 1u) * nx) xb_add(&bar[XB_TOPGEN], 1u);
            else XB_SPIN(xb_ld(&bar[XB_TOPGEN]) == tg, bar);
            __builtin_amdgcn_fence(__ATOMIC_ACQUIRE, "agent");
            xb_add(&bar[XB_XGEN(b.x)], 1u);
            asm volatile("s_waitcnt vmcnt(0)" ::: "memory");
        } else {
            XB_SPIN(xb_ld(&bar[XB_XGEN(b.x)]) == gen, bar);
            __builtin_amdgcn_fence(__ATOMIC_ACQUIRE, "agent");
            asm volatile("s_waitcnt vmcnt(0)" ::: "memory");
        }
    }
    __syncthreads();
}
constexpr int DM = 1024;
constexpr int TP = 8192, BP = 2, MP = BP * TP;
constexpr int NB_S = 128, SS = 4, MS = NB_S * SS;
constexpr int MT = MP + MS;
constexpr int PIN = 2328, NIN = 2560;
constexpr int FFN = 2816, NGU = 2 * FFN;
constexpr int PAST = 2048, PAGE = 128, NPG = PAST / PAGE, NPOOL = 2560;
constexpr int KVW = 256;
constexpr int NLAYER = 2;
constexpr float LN_EPS = 1e-5f;
constexpr float DN_ALPHA = 1.4142135623730951f;

constexpr size_t O_Y = 0;
constexpr size_t O_CMPP = (size_t)MT * DM;
constexpr size_t O_SLCP = O_CMPP + (size_t)NLAYER * MP * KVW;
constexpr size_t O_WINP = O_SLCP + (size_t)NLAYER * MP * KVW;
constexpr size_t O_CMPS = O_WINP + (size_t)NLAYER * BP * 512 * KVW;
constexpr size_t O_SLCS = O_CMPS + (size_t)NLAYER * MS * KVW;
constexpr size_t O_WINS = O_SLCS + (size_t)NLAYER * MS * KVW;
constexpr size_t O_GV = O_WINS + (size_t)NLAYER * NB_S * 512 * KVW;
constexpr size_t O_END = O_GV + (size_t)NLAYER * MS * 512;
static_assert(O_END == 69206016, "output size");

constexpr size_t MiB = 1u << 20;
constexpr size_t WS_CTL = 0, CTL_ZERO_BYTES = 1 * MiB;
constexpr size_t WS_ROPE = 1 * MiB;
constexpr size_t WS_WIN_T = 4 * MiB;
constexpr size_t WS_WOUT_T = 14 * MiB;
constexpr size_t WS_WGU_T = 18 * MiB;
constexpr size_t WS_WDN_T = 40 * MiB;
constexpr size_t WS_W1C_T = 52 * MiB;
constexpr size_t WS_W2C_T = 56 * MiB;
constexpr size_t WS_GWP = 57 * MiB;
constexpr size_t WS_GWS = 58 * MiB;
constexpr size_t WS_GBS = 59 * MiB;
constexpr size_t WS_XF = 64 * MiB;
constexpr size_t WS_XB = 130 * MiB;
constexpr size_t WS_PRE = 163 * MiB;
constexpr size_t WS_QRAW = 229 * MiB;
constexpr size_t WS_QROT = 246 * MiB;
constexpr size_t WS_KS = 263 * MiB;
constexpr size_t WS_VS = 267 * MiB;
constexpr size_t WS_KW = 271 * MiB;
constexpr size_t WS_VW = 275 * MiB;
constexpr size_t WS_U = 279 * MiB;
constexpr size_t WS_V = 296 * MiB;
constexpr size_t WS_GATES = 313 * MiB;
constexpr size_t WS_CKP = 315 * MiB;
constexpr size_t WS_CVP = WS_CKP + 512 * 1024;
constexpr size_t WS_CKS = 316 * MiB;
constexpr size_t WS_CVS = 320 * MiB;
constexpr size_t WS_MIX = 324 * MiB;
constexpr size_t WS_F = 357 * MiB;
constexpr size_t WS_DBG = 448 * MiB;
constexpr size_t WS_DBG2 = 552 * MiB;
constexpr size_t WS_DBG3 = 560 * MiB;
constexpr size_t WS_END = 576 * MiB;
static_assert(WS_XF + (size_t)MT * DM * 4 <= WS_XB && WS_XB + (size_t)MT * DM * 2 <= WS_PRE && WS_PRE + (size_t)MT * DM * 4 <= WS_QRAW, "ws map 1");
static_assert(WS_QRAW + (size_t)MT * 512 * 2 <= WS_QROT && WS_QROT + (size_t)MT * 512 * 2 <= WS_KS && WS_U + (size_t)MT * 512 * 2 <= WS_V && WS_V + (size_t)MT * 512 * 2 <= WS_GATES, "ws map 2");
static_assert(WS_GATES + (size_t)MT * 24 * 4 <= WS_CKP && WS_MIX + (size_t)MT * DM * 2 <= WS_F && WS_F + (size_t)MT * FFN * 2 <= WS_END, "ws map 3");
static_assert(WS_WIN_T + (size_t)2 * NIN * DM * 2 <= WS_WOUT_T && WS_WGU_T + (size_t)2 * NGU * DM * 2 <= WS_WDN_T && WS_WDN_T + (size_t)2 * DM * FFN * 2 <= WS_W1C_T, "ws map 4");

constexpr int CW_TMO = 0, CW_CODE = 1;
constexpr int CW_BAR = 4096;
constexpr int CW_ERR = 64;
#ifndef ATT_PROBE_GAIN
#define ATT_PROBE_GAIN 10.0f
#endif
#ifndef ATT_PROBE_SEL
#define ATT_PROBE_SEL 3
#endif

constexpr int NWAVES = 8;
constexpr int RING_OFF = 0, RING_BYTES = 131072;
constexpr int LDSCTL_OFF = 143360, MISC_OFF = LDSCTL_OFF + 320;
constexpr int LDS_BYTES = 147456;

constexpr int PH_P0A = 0, PH_P0B = 1, PH_L0 = 2, PH_PER_LAYER = 8, N_PHASES = PH_L0 + NLAYER * PH_PER_LAYER;
typedef float f32x2 __attribute__((ext_vector_type(2)));
typedef unsigned u32x2 __attribute__((ext_vector_type(2)));
__device__ __forceinline__ float bf2f(unsigned short h) { return __uint_as_float(((unsigned)h) << 16); }
__device__ __forceinline__ float bflo(unsigned w) { return __uint_as_float(w << 16); }
__device__ __forceinline__ float bfhi(unsigned w) { return __uint_as_float(w & 0xffff0000u); }
__device__ __forceinline__ float wave_sum(float v) {
#pragma unroll
    for (int o = 1; o < 64; o <<= 1) v += __shfl_xor(v, o);
    return v;
}
__device__ __forceinline__ float wave_max(float v) {
#pragma unroll
    for (int o = 1; o < 64; o <<= 1) v = fmaxf(v, __shfl_xor(v, o));
    return v;
}
__device__ __forceinline__ float sigmoidf_(float x) { return 1.0f / (1.0f + __expf(-x)); }
__device__ __forceinline__ float siluf_(float x) { return x / (1.0f + __expf(-x)); }
__device__ __forceinline__ float geluf_(float x) { const float u = 1.5957691216057308f * (x + 0.044715f * x * x * x); return x / (1.0f + __expf(-u)); }
#define WAVE_LDS_FENCE() asm volatile("s_waitcnt lgkmcnt(0)" ::: "memory")

struct EpiResid {
    static constexpr bool PERM = false, AFTER_DRAIN = false;
    const float* xf; float* pre;
    __device__ __forceinline__ void operator()(const pg8::f32x4 (&acc)[2][2][4][2], const pg8::Unit& u, int wr, int wc, int fr, int fq) const {
        const int col0 = u.pn * 256 + wc * 32 + 4 * fq;
#pragma unroll
        for (int ai = 0; ai < 2; ++ai)
#pragma unroll
            for (int m = 0; m < 4; ++m) {
                const size_t off = (size_t)(u.pm * 256 + ai * 128 + wr * 64 + m * 16 + fr) * DM + col0;
#pragma unroll
                for (int bj = 0; bj < 2; ++bj)
#pragma unroll
                    for (int n = 0; n < 2; ++n) {
                        const pg8::f32x4 x = *(const pg8::f32x4*)(xf + off + bj * 128 + n * 16);
                        *(pg8::f32x4*)(pre + off + bj * 128 + n * 16) = x * DN_ALPHA + acc[ai][bj][m][n];
                    }
            }
    }
};
struct EpiGateUp {
    static constexpr bool PERM = true, AFTER_DRAIN = false;
    bf16* f;
    __device__ __forceinline__ void operator()(const pg8::f32x4 (&acc)[2][2][4][2], const pg8::Unit& u, int wr, int wc, int fr, int fq) const {
        const int c8 = u.pn * 256 + wc * 32 + 8 * fq;
#pragma unroll
        for (int ai = 0; ai < 2; ++ai)
#pragma unroll
            for (int m = 0; m < 4; ++m) {
                const size_t row = (size_t)(u.pm * 256 + ai * 128 + wr * 64 + m * 16 + fr);
#pragma unroll
                for (int bj = 0; bj < 2; ++bj) {
                    const pg8::f32x4 v0 = acc[ai][bj][m][0], v1 = acc[ai][bj][m][1];
                    const float o0 = siluf_(v0[0]) * v0[1], o1 = siluf_(v0[2]) * v0[3], o2 = siluf_(v1[0]) * v1[1], o3 = siluf_(v1[2]) * v1[3];
                    u32x2 w; w.x = pk2(o0, o1); w.y = pk2(o2, o3);
                    *(u32x2*)(f + row * FFN + ((c8 + bj * 128) >> 1)) = w;
                }
            }
    }
};
struct EpiInProj {
    static constexpr bool PERM = true, AFTER_DRAIN = false;
    int layer; unsigned char* ws; float* out;
    __device__ __forceinline__ void operator()(const pg8::f32x4 (&acc)[2][2][4][2], const pg8::Unit& u, int wr, int wc, int fr, int fq) const {
        const int pn = u.pn;
        const f32x2* rope = (const f32x2*)(ws + WS_ROPE); bf16* qraw = (bf16*)(ws + WS_QRAW); bf16* qrot = (bf16*)(ws + WS_QROT);
        bf16* KS = (bf16*)(ws + WS_KS); bf16* VS = (bf16*)(ws + WS_VS); bf16* KW = (bf16*)(ws + WS_KW); bf16* VW = (bf16*)(ws + WS_VW);
        bf16* U = (bf16*)(ws + WS_U); bf16* V = (bf16*)(ws + WS_V); float* gates = (float*)(ws + WS_GATES);
#pragma unroll
        for (int ai = 0; ai < 2; ++ai)
#pragma unroll
            for (int m = 0; m < 4; ++m) {
                const int r = u.pm * 256 + ai * 128 + wr * 64 + m * 16 + fr;
                const bool prompt = r < MP;
                const int b = r >> 13, t = r & (TP - 1);
                const int si = r - MP, bs = si >> 2, s = si & 3;
                const int pos = prompt ? t : PAST + s;
#pragma unroll
                for (int bj = 0; bj < 2; ++bj) {
                    const int c8 = pn * 256 + bj * 128 + wc * 32 + 8 * fq;
                    const pg8::f32x4 v0 = acc[ai][bj][m][0], v1 = acc[ai][bj][m][1];
                    if (pn < 2) {
                        const int h = c8 >> 6, d = (c8 & 63) >> 1;
                        const f32x2 cs0 = rope[pos * 32 + d], cs1 = rope[pos * 32 + d + 1], cs2 = rope[pos * 32 + d + 2], cs3 = rope[pos * 32 + d + 3];
                        const float a0 = v0[0], b0 = v0[1], a1 = v0[2], b1 = v0[3], a2 = v1[0], b2 = v1[1], a3 = v1[2], b3 = v1[3];
                        const size_t o = (size_t)r * 512 + h * 64 + d;
                        u32x2 w;
                        w.x = pk2(a0, a1); w.y = pk2(a2, a3); *(u32x2*)(qraw + o) = w;
                        w.x = pk2(b0, b1); w.y = pk2(b2, b3); *(u32x2*)(qraw + o + 32) = w;
                        w.x = pk2(a0 * cs0.x - b0 * cs0.y, a1 * cs1.x - b1 * cs1.y); w.y = pk2(a2 * cs2.x - b2 * cs2.y, a3 * cs3.x - b3 * cs3.y); *(u32x2*)(qrot + o) = w;
                        w.x = pk2(b0 * cs0.x + a0 * cs0.y, b1 * cs1.x + a1 * cs1.y); w.y = pk2(b2 * cs2.x + a2 * cs2.y, b3 * cs3.x + a3 * cs3.y); *(u32x2*)(qrot + o + 32) = w;
                    } else if (pn == 2) {
                        const int cc = c8 - 512;
                        float* dst = prompt ? out + O_CMPP + ((size_t)(layer * BP + b) * TP + t) * KVW + cc : out + O_CMPS + ((size_t)layer * MS + si) * KVW + cc;
                        *(pg8::f32x4*)dst = v0; *(pg8::f32x4*)(dst + 4) = v1;
                    } else if (pn == 3 || pn == 4) {
                        const bool is_slc = (pn == 3);
                        const int cc = c8 - (is_slc ? 768 : 1024);
                        float* dst;
                        bool wr_out = true;
                        if (is_slc) dst = prompt ? out + O_SLCP + ((size_t)(layer * BP + b) * TP + t) * KVW : out + O_SLCS + ((size_t)layer * MS + si) * KVW;
                        else { if (prompt) { wr_out = (t >= TP - 512); dst = out + O_WINP + ((size_t)(layer * BP + b) * 512 + (t - (TP - 512))) * KVW; }
                               else dst = out + O_WINS + ((size_t)(layer * NB_S + bs) * 512 + 508 + s) * KVW; }
                        if (cc < 128) {
                            const int g = cc >> 6, d = (cc & 63) >> 1;
                            const f32x2 cs0 = rope[pos * 32 + d], cs1 = rope[pos * 32 + d + 1], cs2 = rope[pos * 32 + d + 2], cs3 = rope[pos * 32 + d + 3];
                            const float a0 = v0[0], b0 = v0[1], a1 = v0[2], b1 = v0[3], a2 = v1[0], b2 = v1[1], a3 = v1[2], b3 = v1[3];
                            const pg8::f32x4 lo = {a0 * cs0.x - b0 * cs0.y, a1 * cs1.x - b1 * cs1.y, a2 * cs2.x - b2 * cs2.y, a3 * cs3.x - b3 * cs3.y};
                            const pg8::f32x4 hi = {b0 * cs0.x + a0 * cs0.y, b1 * cs1.x + a1 * cs1.y, b2 * cs2.x + a2 * cs2.y, b3 * cs3.x + a3 * cs3.y};
                            if (wr_out) { *(pg8::f32x4*)(dst + g * 64 + d) = lo; *(pg8::f32x4*)(dst + g * 64 + d + 32) = hi; }
                            if (prompt) { bf16* kb = (is_slc ? KS : KW) + ((size_t)(b * 2 + g) * TP + t) * 64 + d;
                                u32x2 w; w.x = pk2(lo[0], lo[1]); w.y = pk2(lo[2], lo[3]); *(u32x2*)kb = w;
                                w.x = pk2(hi[0], hi[1]); w.y = pk2(hi[2], hi[3]); *(u32x2*)(kb + 32) = w; }
                        } else {
                            const int g = (cc - 128) >> 6, d = cc & 63;
                            if (wr_out) { *(pg8::f32x4*)(dst + cc) = v0; *(pg8::f32x4*)(dst + cc + 4) = v1; }
                            if (prompt) { bf16* vb = (is_slc ? VS : VW) + ((size_t)(b * 2 + g) * TP + t) * 64 + d;
                                v4u w; w.x = pk2(v0[0], v0[1]); w.y = pk2(v0[2], v0[3]); w.z = pk2(v1[0], v1[1]); w.w = pk2(v1[2], v1[3]); *(v4u*)vb = w; }
                        }
                    } else if (pn < 9) {
                        const bool is_u = pn < 7;
                        const int cc = c8 - (is_u ? 1280 : 1792);
                        bf16* dst = (is_u ? U : V) + (size_t)r * 512 + cc;
                        v4u w; w.x = pk2(geluf_(v0[0]), geluf_(v0[1])); w.y = pk2(geluf_(v0[2]), geluf_(v0[3])); w.z = pk2(geluf_(v1[0]), geluf_(v1[1])); w.w = pk2(geluf_(v1[2]), geluf_(v1[3]));
                        *(v4u*)dst = w;
                    } else {
                        const int cc = c8 - 2304;
                        if (cc < 24) { float* dst = gates + (size_t)r * 24 + cc;
                            const pg8::f32x4 g0 = {sigmoidf_(v0[0]), sigmoidf_(v0[1]), sigmoidf_(v0[2]), sigmoidf_(v0[3])}, g1 = {sigmoidf_(v1[0]), sigmoidf_(v1[1]), sigmoidf_(v1[2]), sigmoidf_(v1[3])};
                            *(pg8::f32x4*)dst = g0; *(pg8::f32x4*)(dst + 4) = g1; }
                    }
                }
            }
    }
};

template <class RowMap>
__device__ __forceinline__ void transpose_item(const float* W, int K, int N, bf16* WT, const RowMap rm, LAS float* scr, int item, int lane) {
    const int nblk = (N + 31) / 32, kb = item / nblk, nb = item % nblk, k0 = 64 * kb, n0 = 32 * nb;
    const int ncol = n0 + (lane & 31);
#pragma unroll 8
    for (int i = 0; i < 32; ++i) { const int kk = 2 * i + (lane >> 5); scr[kk * 33 + (lane & 31)] = (ncol < N) ? W[(size_t)(k0 + kk) * N + ncol] : 0.f; }
    LDS_WAIT(); asm volatile("" ::: "memory");
    const int c = lane & 7;
#pragma unroll
    for (int j = 0; j < 4; ++j) { const int nl = (lane >> 3) + 8 * j; const LAS float* s = scr + (8 * c) * 33 + nl;
        v4u o; o.x = pk2(s[0 * 33], s[1 * 33]); o.y = pk2(s[2 * 33], s[3 * 33]); o.z = pk2(s[4 * 33], s[5 * 33]); o.w = pk2(s[6 * 33], s[7 * 33]);
        if (n0 + nl < N) *(v4u*)(WT + (size_t)rm(n0 + nl) * K + k0 + 8 * c) = o; }
    LDS_WAIT(); asm volatile("" ::: "memory");
}
struct RmIdent { __device__ __forceinline__ int operator()(int n) const { return n; } };
struct RmAffine { int mul, add; __device__ __forceinline__ int operator()(int n) const { return n * mul + add; } };
__device__ __forceinline__ int rope_il(int d) { return d < 32 ? 2 * d : 2 * (d - 32) + 1; }
struct RmInProj { __device__ __forceinline__ int operator()(int c) const {
    if (c < 512) return (c & ~63) + rope_il(c & 63);
    if (c < 768) return c;
    if (c < 1280) { const int base = c < 1024 ? 768 : 1024, cc = c - base; return cc < 128 ? base + (cc & ~63) + rope_il(cc & 63) : c; }
    if (c < 1304) return 2304 + (c - 1280);
    return 1280 + (c - 1304); } };
constexpr int CU_AS = 0, CU_BS = 9216, CU_HS = 46080, CU_LDS = 79872;
__device__ __forceinline__ void compress_unit(LAS unsigned char* lds, const float* arow, const float* pe_k, const bf16* W1t, const float* b1, const bf16* W2t,
                                              bf16* obase, int NC, int rb, int tid) {
    const int wid = __builtin_amdgcn_readfirstlane(tid >> 6), lane = tid & 63, fr = lane & 15, fq = lane >> 4, wr = wid >> 2, wc = wid & 3;
    const int arow_i = tid >> 3, ac = tid & 7;
    pg8::f32x4 acc[2][4];
#pragma unroll
    for (int m = 0; m < 2; ++m)
#pragma unroll
        for (int n = 0; n < 4; ++n) acc[m][n] = (pg8::f32x4){0.f, 0.f, 0.f, 0.f};
    pg8::f32x4 ar[4][2], pr[4][2]; v4u bq[2][4];
    const float* pe_t = pe_k + ac * 8;
    const bf16* bsrc = W1t + (size_t)arow_i * 2048 + ac * 8;
#pragma unroll
    for (int u = 0; u < 4; ++u) { const float* an = arow + (size_t)u * KVW; const float* pn = pe_t + u * 64;
        ar[u][0] = *(const pg8::f32x4*)an; ar[u][1] = *(const pg8::f32x4*)(an + 4); pr[u][0] = *(const pg8::f32x4*)pn; pr[u][1] = *(const pg8::f32x4*)(pn + 4); }
#pragma unroll
    for (int u = 0; u < 2; ++u)
#pragma unroll
        for (int j = 0; j < 4; ++j) bq[u][j] = *(const v4u*)(bsrc + (size_t)j * 64 * 2048 + u * 64);
#pragma unroll 1
    for (int l0 = 0; l0 < 32; l0 += 4) {
#pragma unroll
        for (int u = 0; u < 4; ++u) {
            const int l = l0 + u;
            { const pg8::f32x4 a0 = ar[u][0] + pr[u][0], a1 = ar[u][1] + pr[u][1];
              v4u w; w.x = pg8::cvt_pk_bf16(a0[0], a0[1]); w.y = pg8::cvt_pk_bf16(a0[2], a0[3]); w.z = pg8::cvt_pk_bf16(a1[0], a1[1]); w.w = pg8::cvt_pk_bf16(a1[2], a1[3]);
              *(LAS v4u*)(lds + CU_AS + arow_i * 144 + ac * 16) = w;
#pragma unroll
              for (int j = 0; j < 4; ++j) *(LAS v4u*)(lds + CU_BS + (arow_i + 64 * j) * 144 + ac * 16) = bq[u & 1][j]; }
            asm volatile("s_waitcnt lgkmcnt(0)" ::: "memory"); __builtin_amdgcn_s_barrier(); asm volatile("" ::: "memory");
            { const int la = (l + 4 < 32) ? l + 4 : 31, lb = (l + 2 < 32) ? l + 2 : 31;
              const float* an = arow + (size_t)la * KVW; const float* pn = pe_t + la * 64;
              ar[u][0] = *(const pg8::f32x4*)an; ar[u][1] = *(const pg8::f32x4*)(an + 4); pr[u][0] = *(const pg8::f32x4*)pn; pr[u][1] = *(const pg8::f32x4*)(pn + 4);
#pragma unroll
              for (int j = 0; j < 4; ++j) bq[u & 1][j] = *(const v4u*)(bsrc + (size_t)j * 64 * 2048 + lb * 64); }
#pragma unroll
            for (int kk = 0; kk < 2; ++kk) {
                bf16x8 af[2], bfr[4];
#pragma unroll
                for (int m = 0; m < 2; ++m) af[m] = *(const LAS bf16x8*)(lds + CU_AS + (wr * 32 + m * 16 + fr) * 144 + (kk * 32 + fq * 8) * 2);
#pragma unroll
                for (int n = 0; n < 4; ++n) bfr[n] = *(const LAS bf16x8*)(lds + CU_BS + (wc * 64 + n * 16 + fr) * 144 + (kk * 32 + fq * 8) * 2);
#pragma unroll
                for (int m = 0; m < 2; ++m)
#pragma unroll
                    for (int n = 0; n < 4; ++n) acc[m][n] = __builtin_amdgcn_mfma_f32_16x16x32_bf16(af[m], bfr[n], acc[m][n], 0, 0, 0);
            }
            asm volatile("s_waitcnt lgkmcnt(0)" ::: "memory"); __builtin_amdgcn_s_barrier(); asm volatile("" ::: "memory");
        }
    }
#pragma unroll
    for (int m = 0; m < 2; ++m)
#pragma unroll
        for (int n = 0; n < 4; ++n) { const int col = wc * 64 + n * 16 + fr; const float bb = b1[col];
#pragma unroll
            for (int rg = 0; rg < 4; ++rg) { const int row = wr * 32 + m * 16 + fq * 4 + rg;
                *(LAS unsigned short*)(lds + CU_HS + row * 528 + col * 2) = (unsigned short)f2bf(siluf_(acc[m][n][rg] + bb)); } }
    __syncthreads();
    {
        const int rt = wid >> 1, ch = wid & 1;
        pg8::f32x4 acc2[2] = {(pg8::f32x4){0.f, 0.f, 0.f, 0.f}, (pg8::f32x4){0.f, 0.f, 0.f, 0.f}};
#pragma unroll
        for (int ks = 0; ks < 8; ++ks) {
            const bf16x8 a = *(const LAS bf16x8*)(lds + CU_HS + (rt * 16 + fr) * 528 + (ks * 32 + fq * 8) * 2);
#pragma unroll
            for (int nn = 0; nn < 2; ++nn) { const bf16x8 bb = *(const bf16x8*)(W2t + (size_t)(ch * 32 + nn * 16 + fr) * 256 + ks * 32 + fq * 8);
                acc2[nn] = __builtin_amdgcn_mfma_f32_16x16x32_bf16(a, bb, acc2[nn], 0, 0, 0); }
        }
#pragma unroll
        for (int nn = 0; nn < 2; ++nn)
#pragma unroll
            for (int rg = 0; rg < 4; ++rg) { const int R = rb * 64 + rt * 16 + fq * 4 + rg, col = ch * 32 + nn * 16 + fr;
                const int b = R / (2 * NC), n = (R >> 1) % NC, g = R & 1;
                obase[((size_t)(b * 2 + g) * NC + n) * 64 + col] = (bf16)f2bf(acc2[nn][rg]); }
    }
    __syncthreads();
}

constexpr int C32_PART = 32 * 256 * 4, C32_HS_RS = 528;
static_assert(4 * C32_PART <= LDSCTL_OFF, "compress32 LDS map");
__device__ __forceinline__ void compress32_unit(LAS unsigned char* lds, const float* rowbase0, const float* rowbase1  , const float* pe_k, const bf16* W1t,
                                                const float* b1, const bf16* W2t, bf16* obase, int NC, int rb, int tid) {
    const int wid = __builtin_amdgcn_readfirstlane(tid >> 6), lane = tid & 63, fr = lane & 15, fq = lane >> 4, kq = wid >> 1, nh = wid & 1;
    pg8::f32x4 acc[2][8];
#pragma unroll
    for (int mt = 0; mt < 2; ++mt)
#pragma unroll
        for (int nt = 0; nt < 8; ++nt) acc[mt][nt] = (pg8::f32x4){0.f, 0.f, 0.f, 0.f};
#pragma unroll 1
    for (int li = 0; li < 8; ++li) {
        const int l = 8 * kq + li;
#pragma unroll
        for (int ks = 0; ks < 2; ++ks) {
            const float* pp = pe_k + l * 64 + 32 * ks + 8 * fq;
            const pg8::f32x4 p0 = *(const pg8::f32x4*)pp, p1 = *(const pg8::f32x4*)(pp + 4);
            bf16x8 af[2];
#pragma unroll
            for (int mt = 0; mt < 2; ++mt) { const float* ap = (mt ? rowbase1 : rowbase0) + (size_t)l * KVW + 32 * ks + 8 * fq;
                const pg8::f32x4 a0 = *(const pg8::f32x4*)ap + p0, a1 = *(const pg8::f32x4*)(ap + 4) + p1;
                v4u aw; aw.x = pk2(a0[0], a0[1]); aw.y = pk2(a0[2], a0[3]); aw.z = pk2(a1[0], a1[1]); aw.w = pk2(a1[2], a1[3]); af[mt] = __builtin_bit_cast(bf16x8, aw); }
            const bf16* bp = W1t + (size_t)(128 * nh + fr) * 2048 + l * 64 + 32 * ks + 8 * fq;
#pragma unroll
            for (int nt = 0; nt < 8; ++nt) { const bf16x8 bfr = *(const bf16x8*)(bp + (size_t)nt * 16 * 2048);
                acc[0][nt] = __builtin_amdgcn_mfma_f32_16x16x32_bf16(af[0], bfr, acc[0][nt], 0, 0, 0); acc[1][nt] = __builtin_amdgcn_mfma_f32_16x16x32_bf16(af[1], bfr, acc[1][nt], 0, 0, 0); }
        }
    }
    { LAS float* part = (LAS float*)(lds + kq * C32_PART);
#pragma unroll
      for (int mt = 0; mt < 2; ++mt)
#pragma unroll
          for (int nt = 0; nt < 8; ++nt)
#pragma unroll
              for (int rg = 0; rg < 4; ++rg) part[(16 * mt + 4 * fq + rg) * 256 + 128 * nh + 16 * nt + fr] = acc[mt][nt][rg]; }
    __syncthreads();
    v4u hv[2];
    {
        const int row = tid >> 4, c0 = (tid & 15) * 16;
#pragma unroll
        for (int hh = 0; hh < 2; ++hh) {
            pg8::f32x4 s0 = *(const pg8::f32x4*)(b1 + c0 + 8 * hh), s1 = *(const pg8::f32x4*)(b1 + c0 + 8 * hh + 4);
#pragma unroll
            for (int w = 0; w < 4; ++w) { const LAS float* pp = (const LAS float*)(lds + w * C32_PART) + row * 256 + c0 + 8 * hh; s0 = s0 + *(const LAS pg8::f32x4*)pp; s1 = s1 + *(const LAS pg8::f32x4*)(pp + 4); }
            hv[hh].x = pk2(siluf_(s0[0]), siluf_(s0[1])); hv[hh].y = pk2(siluf_(s0[2]), siluf_(s0[3])); hv[hh].z = pk2(siluf_(s1[0]), siluf_(s1[1])); hv[hh].w = pk2(siluf_(s1[2]), siluf_(s1[3])); }
    }
    __syncthreads();
    { const int row = tid >> 4, c0 = (tid & 15) * 16;
      *(LAS v4u*)(lds + row * C32_HS_RS + c0 * 2) = hv[0]; *(LAS v4u*)(lds + row * C32_HS_RS + c0 * 2 + 16) = hv[1]; }
    __syncthreads();
    {
        const int mt = wid >> 2, nt = wid & 3;
        pg8::f32x4 a2 = {0.f, 0.f, 0.f, 0.f};
#pragma unroll
        for (int ks = 0; ks < 8; ++ks) {
            const bf16x8 a = *(const LAS bf16x8*)(lds + (16 * mt + fr) * C32_HS_RS + (ks * 32 + fq * 8) * 2);
            const bf16x8 bb = *(const bf16x8*)(W2t + (size_t)(nt * 16 + fr) * 256 + ks * 32 + fq * 8);
            a2 = __builtin_amdgcn_mfma_f32_16x16x32_bf16(a, bb, a2, 0, 0, 0);
        }
#pragma unroll
        for (int rg = 0; rg < 4; ++rg) { const int R = rb * 32 + 16 * mt + 4 * fq + rg, col = nt * 16 + fr;
            const int b = R / (2 * NC), n = (R >> 1) % NC, g = R & 1;
            obase[((size_t)(b * 2 + g) * NC + n) * 64 + col] = (bf16)f2bf(a2[rg]); }
    }
    __syncthreads();
}

constexpr int GM_RS = 136, GM_TILE = 128 * GM_RS;
static_assert(8 * GM_TILE <= LDSCTL_OFF, "gMLP LDS map");
__device__ __forceinline__ void gmlp_unit(LAS unsigned char* lds, LAS unsigned char* lds_stats, int m0, const bf16* U, const bf16* V, const bf16* WB, const float* bias, const float* lng, const float* lnb,
                                          bf16* mix, float* gv_out  , int tid) {
    typedef short s16x4_ __attribute__((ext_vector_type(4)));
    const int wid = __builtin_amdgcn_readfirstlane(tid >> 6), lane = tid & 63, fr = lane & 15, fq = lane >> 4;
    LAS f32x2* stats = (LAS f32x2*)lds_stats;
    for (int i = 0; i < 16; ++i) {
        const int row = wid * 16 + i;
        const v4u w = *(const v4u*)(V + (size_t)(m0 + row) * 512 + lane * 8);
        float x[8] = {bflo(w.x), bfhi(w.x), bflo(w.y), bfhi(w.y), bflo(w.z), bfhi(w.z), bflo(w.w), bfhi(w.w)};
        float s = 0.f;
#pragma unroll
        for (int e = 0; e < 8; ++e) s += x[e];
        const float mean = wave_sum(s) * (1.0f / 512.0f);
        float q = 0.f;
#pragma unroll
        for (int e = 0; e < 8; ++e) { const float d = x[e] - mean; q += d * d; }
        const float var = wave_sum(q) * (1.0f / 512.0f);
        if (lane == 0) stats[row] = (f32x2){mean, 1.0f / sqrtf(var + LN_EPS)};
    }
    __syncthreads();
    const int h = wid;
    LAS unsigned char* tile = lds + wid * GM_TILE;
    {
        const int ch = lane & 7, c0 = h * 64 + ch * 8;
        float gg[8], bb[8];
        { const pg8::f32x4 g0 = *(const pg8::f32x4*)(lng + c0), g1 = *(const pg8::f32x4*)(lng + c0 + 4), b0 = *(const pg8::f32x4*)(lnb + c0), b1 = *(const pg8::f32x4*)(lnb + c0 + 4);
          gg[0] = g0[0]; gg[1] = g0[1]; gg[2] = g0[2]; gg[3] = g0[3]; gg[4] = g1[0]; gg[5] = g1[1]; gg[6] = g1[2]; gg[7] = g1[3];
          bb[0] = b0[0]; bb[1] = b0[1]; bb[2] = b0[2]; bb[3] = b0[3]; bb[4] = b1[0]; bb[5] = b1[1]; bb[6] = b1[2]; bb[7] = b1[3]; }
#pragma unroll 4
        for (int it = 0; it < 16; ++it) {
            const int s = it * 8 + (lane >> 3);
            const v4u w = *(const v4u*)(V + (size_t)(m0 + s) * 512 + c0);
            const f32x2 st = stats[s];
            float x[8] = {bflo(w.x), bfhi(w.x), bflo(w.y), bfhi(w.y), bflo(w.z), bfhi(w.z), bflo(w.w), bfhi(w.w)};
#pragma unroll
            for (int e = 0; e < 8; ++e) x[e] = (x[e] - st.x) * st.y * gg[e] + bb[e];
            if (gv_out) { *(pg8::f32x4*)(gv_out + (size_t)s * 512 + c0) = (pg8::f32x4){x[0], x[1], x[2], x[3]}; *(pg8::f32x4*)(gv_out + (size_t)s * 512 + c0 + 4) = (pg8::f32x4){x[4], x[5], x[6], x[7]}; }
            u32x2 o0, o1; o0.x = pk2(x[0], x[1]); o0.y = pk2(x[2], x[3]); o1.x = pk2(x[4], x[5]); o1.y = pk2(x[6], x[7]);
            *(LAS u32x2*)(tile + s * GM_RS + ch * 16) = o0; *(LAS u32x2*)(tile + s * GM_RS + ch * 16 + 8) = o1;
        }
    }
    WAVE_LDS_FENCE();
    const bf16* Wh = WB + (size_t)h * 128 * 128;
#pragma unroll 1
    for (int th = 0; th < 2; ++th) {
        pg8::f32x4 acc[4][4];
#pragma unroll
        for (int dt = 0; dt < 4; ++dt)
#pragma unroll
            for (int tt = 0; tt < 4; ++tt) acc[dt][tt] = (pg8::f32x4){0.f, 0.f, 0.f, 0.f};
#pragma unroll 1
        for (int ks = 0; ks < 2 * th + 2; ++ks) {
            bf16x8 vf[4];
#pragma unroll
            for (int dt = 0; dt < 4; ++dt) { const LAS unsigned char* p = tile + (32 * ks + 4 * fq + (fr >> 2)) * GM_RS + (16 * dt + 4 * (fr & 3)) * 2;
                const s16x4_ lo = __builtin_bit_cast(s16x4_, __builtin_amdgcn_ds_read_tr16_b64_v4i16((LAS s16x4_*)p)), hi = __builtin_bit_cast(s16x4_, __builtin_amdgcn_ds_read_tr16_b64_v4i16((LAS s16x4_*)(p + 16 * GM_RS)));
                vf[dt] = (bf16x8){lo[0], lo[1], lo[2], lo[3], hi[0], hi[1], hi[2], hi[3]}; }
#pragma unroll
            for (int tt = 0; tt < 4; ++tt) {
                const bf16* wp = Wh + (size_t)(16 * (4 * th + tt) + fr) * 128 + 32 * ks + 4 * fq;
                const u32x2 w0 = *(const u32x2*)wp, w1 = *(const u32x2*)(wp + 16);
                const bf16x8 wb = __builtin_bit_cast(bf16x8, (v4u){w0.x, w0.y, w1.x, w1.y});
#pragma unroll
                for (int dt = 0; dt < 4; ++dt) acc[dt][tt] = __builtin_amdgcn_mfma_f32_16x16x32_bf16(vf[dt], wb, acc[dt][tt], 0, 0, 0);
            }
        }
#pragma unroll
        for (int tt = 0; tt < 4; ++tt) { const int t = 16 * (4 * th + tt) + fr; const float bv = bias[h * 128 + t];
#pragma unroll
            for (int dt = 0; dt < 4; ++dt) { const size_t off = (size_t)(m0 + t) * 512 + h * 64 + 16 * dt + 4 * fq;
                const u32x2 uw = *(const u32x2*)(U + off);
                const pg8::f32x4 a = acc[dt][tt];
                u32x2 o; o.x = pk2(bflo(uw.x) * (a[0] + bv), bfhi(uw.x) * (a[1] + bv)); o.y = pk2(bflo(uw.y) * (a[2] + bv), bfhi(uw.y) * (a[3] + bv));
                *(u32x2*)(mix + (size_t)(m0 + t) * DM + 512 + h * 64 + 16 * dt + 4 * fq) = o; } }
    }
    __syncthreads();
}

__device__ __forceinline__ void skinny_item(LAS unsigned char* lds, const bf16* A  , const bf16* Bt  , int K, const float* xf, float* pre  , int tid) {
    const int wid = __builtin_amdgcn_readfirstlane(tid >> 6), lane = tid & 63, fr = lane & 15, fq = lane >> 4;
    const int kw = K >> 3, k0 = wid * kw;
    pg8::f32x4 acc[4][2];
#pragma unroll
    for (int mt = 0; mt < 4; ++mt) { acc[mt][0] = (pg8::f32x4){0.f, 0.f, 0.f, 0.f}; acc[mt][1] = (pg8::f32x4){0.f, 0.f, 0.f, 0.f}; }
    const bf16* ap = A + (size_t)fr * K + k0 + 8 * fq; const bf16* bp = Bt + (size_t)fr * K + k0 + 8 * fq;
#pragma unroll 2
    for (int kk = 0; kk < kw; kk += 32) {
        bf16x8 af[4], bfr[2];
#pragma unroll
        for (int mt = 0; mt < 4; ++mt) af[mt] = *(const bf16x8*)(ap + (size_t)(16 * mt) * K + kk);
#pragma unroll
        for (int nt = 0; nt < 2; ++nt) bfr[nt] = *(const bf16x8*)(bp + (size_t)(16 * nt) * K + kk);
#pragma unroll
        for (int mt = 0; mt < 4; ++mt)
#pragma unroll
            for (int nt = 0; nt < 2; ++nt) acc[mt][nt] = __builtin_amdgcn_mfma_f32_16x16x32_bf16(af[mt], bfr[nt], acc[mt][nt], 0, 0, 0);
    }
    { LAS float* part = (LAS float*)(lds + wid * 8192);
#pragma unroll
      for (int mt = 0; mt < 4; ++mt)
#pragma unroll
          for (int nt = 0; nt < 2; ++nt)
#pragma unroll
              for (int rg = 0; rg < 4; ++rg) part[(16 * mt + 4 * fq + rg) * 32 + 16 * nt + fr] = acc[mt][nt][rg]; }
    __syncthreads();
    { const int row = tid >> 3, c4 = (tid & 7) * 4;
      pg8::f32x4 s = *(const pg8::f32x4*)(xf + (size_t)row * DM + c4) * DN_ALPHA;
#pragma unroll
      for (int w = 0; w < 8; ++w) s = s + *(const LAS pg8::f32x4*)((const LAS float*)(lds + w * 8192) + row * 32 + c4);
      *(pg8::f32x4*)(pre + (size_t)row * DM + c4) = s; }
    __syncthreads();
}

__device__ __forceinline__ void ln_row(const float* src, const float* g, const float* b, float* dstf, bf16* dstb, int lane) {
    pg8::f32x4 v[4]; float s = 0.f;
#pragma unroll
    for (int j = 0; j < 4; ++j) { v[j] = *(const pg8::f32x4*)(src + (j * 64 + lane) * 4); s += (v[j][0] + v[j][1]) + (v[j][2] + v[j][3]); }
    const float mean = wave_sum(s) * (1.0f / DM); float q = 0.f;
#pragma unroll
    for (int j = 0; j < 4; ++j) { v[j] = v[j] - mean; q += (v[j][0] * v[j][0] + v[j][1] * v[j][1]) + (v[j][2] * v[j][2] + v[j][3] * v[j][3]); }
    const float rstd = 1.0f / sqrtf(wave_sum(q) * (1.0f / DM) + LN_EPS);
#pragma unroll
    for (int j = 0; j < 4; ++j) { const int c = (j * 64 + lane) * 4;
        const pg8::f32x4 gg = *(const pg8::f32x4*)(g + c), bb = *(const pg8::f32x4*)(b + c);
        const pg8::f32x4 y = v[j] * rstd * gg + bb;
        *(pg8::f32x4*)(dstf + c) = y;
        if (dstb) { u32x2 w; w.x = pk2(y[0], y[1]); w.y = pk2(y[2], y[3]); *(u32x2*)(dstb + c) = w; } }
}

__device__ __forceinline__ void load8(const bf16* p, float (&k)[8]) { const v4u w = *(const v4u*)p; k[0] = bflo(w.x); k[1] = bfhi(w.x); k[2] = bflo(w.y); k[3] = bfhi(w.y); k[4] = bflo(w.z); k[5] = bfhi(w.z); k[6] = bflo(w.w); k[7] = bfhi(w.w); }
__device__ __forceinline__ void load8(const float* p, float (&k)[8]) { const pg8::f32x4 a = *(const pg8::f32x4*)p, b = *(const pg8::f32x4*)(p + 4); k[0] = a[0]; k[1] = a[1]; k[2] = a[2]; k[3] = a[3]; k[4] = b[0]; k[5] = b[1]; k[6] = b[2]; k[7] = b[3]; }
__device__ __forceinline__ float ldv(const bf16* p) { return bf2f(*p); }
__device__ __forceinline__ float ldv(const float* p) { return *p; }
template <class T> __device__ __forceinline__ void dot4(const T* krow, const LAS float* q, float (&s)[4]) {
    s[0] = s[1] = s[2] = s[3] = 0.f;
#pragma unroll 1
    for (int c = 0; c < 8; ++c) {
        float k[8]; load8(krow + c * 8, k);
#pragma unroll
        for (int r = 0; r < 4; ++r) {
            const pg8::f32x4 qa = *(const LAS pg8::f32x4*)(q + r * 64 + c * 8), qb = *(const LAS pg8::f32x4*)(q + r * 64 + c * 8 + 4);
            s[r] += qa[0] * k[0] + qa[1] * k[1] + qa[2] * k[2] + qa[3] * k[3] + qb[0] * k[4] + qb[1] * k[5] + qb[2] * k[6] + qb[3] * k[7];
        }
    }
}
template <class Src>
__device__ __forceinline__ void attend(const Src& S, int nblk, const LAS float* q, LAS float* pbuf, int lane, float (&o)[4], LAS float* impbuf) {
    typedef typename Src::T T;
    float m[4] = {-1e30f, -1e30f, -1e30f, -1e30f}, l[4] = {0.f, 0.f, 0.f, 0.f};
    for (int i = 0; i < nblk; ++i) {
        const T *kb, *vb; bool ok; S.blk(i, lane, kb, vb, ok);
        if (ok) { float s[4]; dot4(kb + (size_t)lane * Src::STRIDE, q, s);
#pragma unroll
            for (int r = 0; r < 4; ++r) { if (s[r] > m[r]) { l[r] = l[r] * __expf(m[r] - s[r]) + 1.0f; m[r] = s[r]; } else l[r] += __expf(s[r] - m[r]); } }
    }
    float Mx[4], inv[4];
#pragma unroll
    for (int r = 0; r < 4; ++r) { Mx[r] = wave_max(m[r]); const float L = wave_sum(l[r] * __expf(m[r] - Mx[r])); inv[r] = 1.0f / fmaxf(L, 1e-30f); }
    o[0] = o[1] = o[2] = o[3] = 0.f;
    if (!(Mx[0] > -1e29f)) return;
    for (int i = 0; i < nblk; ++i) {
        const T *kb, *vb; bool ok; S.blk(i, lane, kb, vb, ok);
        const unsigned long long mask = __ballot(ok);
        if (mask == 0ull) continue;
        pg8::f32x4 p = {0.f, 0.f, 0.f, 0.f};
        if (ok) { float s[4]; dot4(kb + (size_t)lane * Src::STRIDE, q, s);
#pragma unroll
            for (int r = 0; r < 4; ++r) p[r] = __expf(s[r] - Mx[r]) * inv[r]; }
        *(LAS pg8::f32x4*)(pbuf + lane * 4) = p;
        if (impbuf) { const float im = (p[0] + p[1]) + (p[2] + p[3]); const float pr = im + __shfl_xor(im, 1); if (!(lane & 1)) impbuf[(i * 64 + lane) >> 1] = pr; }
        WAVE_LDS_FENCE();
        for (int kk = 0; kk < 64; ++kk) {
            if ((mask >> kk) & 1ull) { const pg8::f32x4 pv = *(const LAS pg8::f32x4*)(pbuf + kk * 4); const float v = ldv(vb + (size_t)kk * Src::STRIDE + lane);
                o[0] += pv[0] * v; o[1] += pv[1] * v; o[2] += pv[2] * v; o[3] += pv[3] * v; }
        }
        WAVE_LDS_FENCE();
    }
}
__device__ __forceinline__ unsigned long long topk_key(float val, int j) { unsigned u = __float_as_uint(val); u = (u & 0x80000000u) ? ~u : (u | 0x80000000u); return ((unsigned long long)u << 32) | (unsigned)(127 - j); }
__device__ __forceinline__ void topk16(const LAS float* imp, int ns, int cur, LAS int* selidx, int lane) {
    unsigned long long k0 = 0ull, k1 = 0ull;
    { const int j = lane; if (j < ns) { const bool valid = j <= cur, forced = (j == 0) | (j == cur) | (j == cur - 1); k0 = topk_key(valid ? imp[j] + (forced ? 1.0e4f : 0.f) : -1.0f, j); } }
    { const int j = lane + 64; if (j < ns) { const bool valid = j <= cur, forced = (j == 0) | (j == cur) | (j == cur - 1); k1 = topk_key(valid ? imp[j] + (forced ? 1.0e4f : 0.f) : -1.0f, j); } }
    for (int it = 0; it < 16; ++it) {
        unsigned long long k = k0 > k1 ? k0 : k1;
#pragma unroll
        for (int o = 1; o < 64; o <<= 1) { const unsigned lo = __shfl_xor((unsigned)k, o), hi = __shfl_xor((unsigned)(k >> 32), o); const unsigned long long kx = ((unsigned long long)hi << 32) | lo; k = kx > k ? kx : k; }
        const int jb = 127 - (int)(unsigned)(k & 0xffffffffull);
        if (lane == 0) selidx[it] = (k == 0ull || jb > cur) ? -1 : jb;
        if (k0 == k) k0 = 0ull;
        if (k1 == k) k1 = 0ull;
    }
    WAVE_LDS_FENCE();
}
struct SrcPromptCmp { typedef bf16 T; static constexpr int STRIDE = 64; const bf16 *ck, *cv; int nvalid;
    __device__ __forceinline__ void blk(int i, int lane, const bf16*& kb, const bf16*& vb, bool& ok) const { kb = ck + (size_t)i * 64 * 64; vb = cv + (size_t)i * 64 * 64; ok = (i * 64 + lane) < nvalid; } };
struct SrcPromptSlc { typedef bf16 T; static constexpr int STRIDE = 64; const bf16 *K, *V; const LAS int* selidx; int t;
    __device__ __forceinline__ void blk(int i, int lane, const bf16*& kb, const bf16*& vb, bool& ok) const { const int j = selidx[i]; const int jj = j < 0 ? 0 : j; kb = K + (size_t)jj * 64 * 64; vb = V + (size_t)jj * 64 * 64; ok = (j >= 0) && (jj * 64 + lane <= t); } };
struct SrcPromptWin { typedef bf16 T; static constexpr int STRIDE = 64; const bf16 *K, *V; int t, kb0;
    __device__ __forceinline__ void blk(int i, int lane, const bf16*& kb, const bf16*& vb, bool& ok) const { const int j = kb0 + i, pos = j * 64 + lane; kb = K + (size_t)j * 64 * 64; vb = V + (size_t)j * 64 * 64; ok = (pos <= t) && (pos >= t - 511); } };
struct SrcSampleCmp { typedef bf16 T; static constexpr int STRIDE = 64; const bf16 *ck, *cv;
    __device__ __forceinline__ void blk(int i, int lane, const bf16*& kb, const bf16*& vb, bool& ok) const { kb = ck; vb = cv; ok = true; } };
struct SrcSampleSlc { typedef float T; static constexpr int STRIDE = KVW; const float* cache_l; const int* pt; const float* newrows; const LAS int* selidx; int g, s;
    __device__ __forceinline__ void blk(int i, int lane, const float*& kb, const float*& vb, bool& ok) const {
        const int j = selidx[i];
        if (j >= 0 && j < 32) { const int page = pt[j >> 1]; const float* rb = cache_l + ((size_t)page * PAGE + (j & 1) * 64) * KVW; kb = rb + g * 64; vb = rb + 128 + g * 64; ok = true; }
        else { kb = newrows + g * 64; vb = newrows + 128 + g * 64; ok = (j == 32) && (lane <= s); } } };
struct SrcSampleWin { typedef float T; static constexpr int STRIDE = KVW; const float* state; const float* newrows; int g, s;
    __device__ __forceinline__ void blk(int i, int lane, const float*& kb, const float*& vb, bool& ok) const {
        if (i < 8) { const float* rb = state + (size_t)i * 64 * KVW; kb = rb + g * 64; vb = rb + 128 + g * 64; ok = (i * 64 + lane) >= s + 1; }
        else { kb = newrows + g * 64; vb = newrows + 128 + g * 64; ok = lane <= s; } } };
typedef short s16x4 __attribute__((ext_vector_type(4)));
constexpr int ATS = 144;
constexpr int AT_TILE = 64 * ATS;
constexpr int AT_STASH = 8 * AT_TILE;
static_assert(AT_STASH + 65536 <= LDSCTL_OFF, "attention LDS map");
constexpr float SM_C = 0.125f * 1.4426950408889634f;
#ifndef ATT_PROBE
#define ATT_PROBE 0
#endif
__device__ __forceinline__ s16x4 ds_tr(const LAS unsigned char* p) { return __builtin_bit_cast(s16x4, __builtin_amdgcn_ds_read_tr16_b64_v4i16((LAS s16x4*)p)); }
__device__ __forceinline__ void load_kfrags(const LAS unsigned char* Kt, int fr, int fq, bf16x8 (&kf)[4][2]) {
#pragma unroll
    for (int kt = 0; kt < 4; ++kt)
#pragma unroll
        for (int ks = 0; ks < 2; ++ks) kf[kt][ks] = *(const LAS bf16x8*)(Kt + (16 * kt + fr) * ATS + (32 * ks + 8 * fq) * 2);
}
__device__ __forceinline__ void load_vfrags(const LAS unsigned char* Vt, int fr, int fq, bf16x8 (&vf)[4][2]) {
#pragma unroll
    for (int dt = 0; dt < 4; ++dt)
#pragma unroll
        for (int ks = 0; ks < 2; ++ks) {
            const LAS unsigned char* p = Vt + (32 * ks + 4 * fq + (fr >> 2)) * ATS + (16 * dt + 4 * (fr & 3)) * 2;
            const s16x4 lo = ds_tr(p), hi = ds_tr(p + 16 * ATS);
            vf[dt][ks] = (bf16x8){lo[0], lo[1], lo[2], lo[3], hi[0], hi[1], hi[2], hi[3]};
        }
}
__device__ __forceinline__ bf16x8 pack_p(const pg8::f32x4& a, const pg8::f32x4& b) {
    v4u w; w.x = pg8::cvt_pk_bf16(a[0], a[1]); w.y = pg8::cvt_pk_bf16(a[2], a[3]); w.z = pg8::cvt_pk_bf16(b[0], b[1]); w.w = pg8::cvt_pk_bf16(b[2], b[3]);
    return __builtin_bit_cast(bf16x8, w);
}
__device__ __forceinline__ float rowq_max(float x) {
    { const auto r = __builtin_amdgcn_permlane16_swap(__float_as_uint(x), __float_as_uint(x), false, false); x = fmaxf(__uint_as_float(r[0]), __uint_as_float(r[1])); }
    { const auto r = __builtin_amdgcn_permlane32_swap(__float_as_uint(x), __float_as_uint(x), false, false); x = fmaxf(__uint_as_float(r[0]), __uint_as_float(r[1])); }
    return x;
}
__device__ __forceinline__ float rowq_sum(float x) {
    { const auto r = __builtin_amdgcn_permlane16_swap(__float_as_uint(x), __float_as_uint(x), false, false); x = __uint_as_float(r[0]) + __uint_as_float(r[1]); }
    { const auto r = __builtin_amdgcn_permlane32_swap(__float_as_uint(x), __float_as_uint(x), false, false); x = __uint_as_float(r[0]) + __uint_as_float(r[1]); }
    return x;
}
__device__ __forceinline__ unsigned rowq_umax(unsigned x) {
    { const auto r = __builtin_amdgcn_permlane16_swap(x, x, false, false); x = r[0] > r[1] ? r[0] : r[1]; }
    { const auto r = __builtin_amdgcn_permlane32_swap(x, x, false, false); x = r[0] > r[1] ? r[0] : r[1]; }
    return x;
}
struct AGroup { bf16x8 q[2]; pg8::f32x4 O[4]; float m, l; };
__device__ __forceinline__ void attn_score(AGroup& G, const bf16x8 (&kf)[4][2], int lo, int hi, int fq, bf16x8& pb0, bf16x8& pb1) {
    pg8::f32x4 s[4];
#pragma unroll
    for (int kt = 0; kt < 4; ++kt) { s[kt] = __builtin_amdgcn_mfma_f32_16x16x32_bf16(kf[kt][0], G.q[0], (pg8::f32x4){0.f, 0.f, 0.f, 0.f}, 0, 0, 0);
        s[kt] = __builtin_amdgcn_mfma_f32_16x16x32_bf16(kf[kt][1], G.q[1], s[kt], 0, 0, 0); }
    float mx = -1e30f;
    const bool none = (hi < 0) || (lo > 63), full = (lo <= 0) && (hi >= 63);
    if (__builtin_amdgcn_ballot_w64(!(none || full)) == 0ull) {
#pragma unroll
        for (int kt = 0; kt < 4; ++kt)
#pragma unroll
            for (int rg = 0; rg < 4; ++rg) { const float v = none ? -1e30f : s[kt][rg]; s[kt][rg] = v; mx = fmaxf(mx, v); }
    } else {
#pragma unroll
        for (int kt = 0; kt < 4; ++kt)
#pragma unroll
            for (int rg = 0; rg < 4; ++rg) { const int kidx = 16 * kt + 4 * fq + rg; const float v = (kidx >= lo && kidx <= hi) ? s[kt][rg] : -1e30f; s[kt][rg] = v; mx = fmaxf(mx, v); }
    }
    mx = rowq_max(mx);
    const float mnew = fmaxf(G.m, mx);
    const float alpha = __builtin_amdgcn_exp2f((G.m - mnew) * SM_C);
    const float mc = fmaxf(mnew, -1e20f) * SM_C;
    float ps = 0.f;
#pragma unroll
    for (int kt = 0; kt < 4; ++kt)
#pragma unroll
        for (int rg = 0; rg < 4; ++rg) { const float pv = __builtin_amdgcn_exp2f(s[kt][rg] * SM_C - mc); s[kt][rg] = pv; ps += pv; }
    G.l = G.l * alpha + ps; G.m = mnew;
#pragma unroll
    for (int dt = 0; dt < 4; ++dt) G.O[dt] = G.O[dt] * alpha;
    pb0 = pack_p(s[0], s[1]); pb1 = pack_p(s[2], s[3]);
}
__device__ __forceinline__ void attn_pv(pg8::f32x4 (&O)[4], const bf16x8 (&vf)[4][2], const bf16x8& pb0, const bf16x8& pb1) {
#pragma unroll
    for (int dt = 0; dt < 4; ++dt) { O[dt] = __builtin_amdgcn_mfma_f32_16x16x32_bf16(vf[dt][0], pb0, O[dt], 0, 0, 0); O[dt] = __builtin_amdgcn_mfma_f32_16x16x32_bf16(vf[dt][1], pb1, O[dt], 0, 0, 0); }
}
__device__ __forceinline__ int next_bit128(unsigned u0, unsigned u1, unsigned u2, unsigned u3, int from) {
    if (from < 32) { const unsigned x = (u0 >> from) << from; if (x) return __builtin_ctz(x); }
    if (from < 64) { const int sh = from > 32 ? from - 32 : 0; const unsigned x = (u1 >> sh) << sh; if (x) return 32 + __builtin_ctz(x); }
    if (from < 96) { const int sh = from > 64 ? from - 64 : 0; const unsigned x = (u2 >> sh) << sh; if (x) return 64 + __builtin_ctz(x); }
    if (from < 128) { const int sh = from > 96 ? from - 96 : 0; const unsigned x = (u3 >> sh) << sh; if (x) return 96 + __builtin_ctz(x); }
    return -1;
}
__device__ __forceinline__ bool test_bit128(unsigned u0, unsigned u1, unsigned u2, unsigned u3, int j) { const unsigned w = j < 32 ? u0 : j < 64 ? u1 : j < 96 ? u2 : u3; return (w >> (j & 31)) & 1u; }
constexpr int RING_D = 4, SLOT_B = 16384;
static_assert(RING_D * SLOT_B <= AT_STASH, "attention ring below the stash");
template <bool WIN>
__device__ __forceinline__ void attn_walk(LAS unsigned char* lds, const bf16* Kg, const bf16* Vg, unsigned W0, unsigned W1, unsigned W2, unsigned W3,
                                          unsigned nA0, unsigned nA1, unsigned nA2, unsigned nA3, unsigned nB0, unsigned nB1, unsigned nB2, unsigned nB3,
                                          const unsigned (&selA)[4], const unsigned (&selB)[4], int tA, int tB, AGroup& GA, AGroup& GB, int tid, int fr, int fq) {
    const int wid = __builtin_amdgcn_readfirstlane(tid >> 6), lane = tid & 63;
    const int drow = 8 * wid + (lane >> 3), dch = (lane & 7) ^ (drow & 6);
    const size_t goff = (size_t)drow * 64 + dch * 8;
    const int koff = fr * 128 + ((fq ^ (fr & 6)) * 16);
    const int vrow = 4 * fq + (fr >> 2);
    const int voff = vrow * 128 + (fr & 1) * 8;
    const int vsw = vrow & 6, vc0 = (fr & 3) >> 1;
#define ATT_ISSUE(jj, slot) do { const LAS unsigned char* sb_ = lds + (slot) * SLOT_B + wid * 1024; \
        __builtin_amdgcn_global_load_lds((const unsigned*)(Kg + (size_t)(jj) * 4096 + goff), (LAS unsigned*)sb_, 16, 0, 0); \
        __builtin_amdgcn_global_load_lds((const unsigned*)(Vg + (size_t)(jj) * 4096 + goff), (LAS unsigned*)(sb_ + 8192), 16, 0, 0); } while (0)
    int j_issue = next_bit128(W0, W1, W2, W3, 0), n_issued = 0, n_done = 0;
#pragma unroll 1
    for (int k = 0; k < RING_D - 1; ++k) if (j_issue >= 0) { ATT_ISSUE(j_issue, n_issued % RING_D); ++n_issued; j_issue = next_bit128(W0, W1, W2, W3, j_issue + 1); }
    int j = next_bit128(W0, W1, W2, W3, 0);
#pragma unroll 1
    while (j >= 0) {
        const int rem = n_issued - n_done - 1;
        if (rem >= 2) asm volatile("s_waitcnt vmcnt(4)" ::: "memory"); else if (rem == 1) asm volatile("s_waitcnt vmcnt(2)" ::: "memory"); else asm volatile("s_waitcnt vmcnt(0)" ::: "memory");
        __builtin_amdgcn_s_barrier(); asm volatile("" ::: "memory");
        if (j_issue >= 0) { ATT_ISSUE(j_issue, n_issued % RING_D); ++n_issued; j_issue = next_bit128(W0, W1, W2, W3, j_issue + 1); }
        const bool needA = test_bit128(nA0, nA1, nA2, nA3, j), needB = test_bit128(nB0, nB1, nB2, nB3, j);
        if (needA || needB) {
            const LAS unsigned char* Kt = lds + (n_done % RING_D) * SLOT_B; const LAS unsigned char* Vt = Kt + 8192;
            bf16x8 pa0, pa1, pc0, pc1;
            { bf16x8 kf[4][2];
#pragma unroll
              for (int kt = 0; kt < 4; ++kt)
#pragma unroll
                  for (int ks = 0; ks < 2; ++ks) kf[kt][ks] = *(const LAS bf16x8*)(Kt + kt * 2048 + (koff ^ (ks * 64)));
              if (needA) { int lo, hi;
                if (WIN) { lo = tA - 511 - 64 * j; hi = tA - 64 * j; } else { lo = 0; hi = test_bit128(selA[0], selA[1], selA[2], selA[3], j) ? tA - 64 * j : -1; }
                attn_score(GA, kf, lo, hi, fq, pa0, pa1); }
              if (needB) { int lo, hi;
                if (WIN) { lo = tB - 511 - 64 * j; hi = tB - 64 * j; } else { lo = 0; hi = test_bit128(selB[0], selB[1], selB[2], selB[3], j) ? tB - 64 * j : -1; }
                attn_score(GB, kf, lo, hi, fq, pc0, pc1); } }
            asm volatile("" ::: "memory");
            { bf16x8 vf[4][2];
#pragma unroll
              for (int dt = 0; dt < 4; ++dt)
#pragma unroll
                  for (int ks = 0; ks < 2; ++ks) { const LAS unsigned char* pp = Vt + ks * 4096 + voff + (((2 * dt + vc0) ^ vsw) * 16);
                      const s16x4 lo = ds_tr(pp), hi = ds_tr(pp + 2048);
                      vf[dt][ks] = (bf16x8){lo[0], lo[1], lo[2], lo[3], hi[0], hi[1], hi[2], hi[3]}; }
              if (needA) attn_pv(GA.O, vf, pa0, pa1);
              if (needB) attn_pv(GB.O, vf, pc0, pc1); }
        }
        ++n_done; j = next_bit128(W0, W1, W2, W3, j + 1);
    }
    asm volatile("s_waitcnt vmcnt(0) lgkmcnt(0)" ::: "memory");
    __builtin_amdgcn_s_barrier(); asm volatile("" ::: "memory");
#undef ATT_ISSUE
}
template <int CV0>
__device__ __forceinline__ void attn_cmp_group(const LAS unsigned char* lds, int NCT, const bf16x8 (&q)[2], int t, int cur, int fr, int fq, pg8::f32x4 (&Oc)[4], unsigned (&sel)[4]) {
    const int nv = (t + 1) >> 5;
    float m = -1e30f, l = 0.f;
#pragma unroll 1
    for (int ct = 0; ct < NCT; ++ct) {
        bf16x8 kf[4][2]; load_kfrags(lds + ct * AT_TILE, fr, fq, kf);
        pg8::f32x4 s[4];
#pragma unroll
        for (int kt = 0; kt < 4; ++kt) { s[kt] = __builtin_amdgcn_mfma_f32_16x16x32_bf16(kf[kt][0], q[0], (pg8::f32x4){0.f, 0.f, 0.f, 0.f}, 0, 0, 0);
            s[kt] = __builtin_amdgcn_mfma_f32_16x16x32_bf16(kf[kt][1], q[1], s[kt], 0, 0, 0); }
        float mx = -1e30f;
#pragma unroll
        for (int kt = 0; kt < 4; ++kt)
#pragma unroll
            for (int rg = 0; rg < 4; ++rg) { const int n = 64 * ct + 16 * kt + 4 * fq + rg; const float v = (n < nv) ? s[kt][rg] : -1e30f; s[kt][rg] = v; mx = fmaxf(mx, v); }
        mx = rowq_max(mx);
        const float mnew = fmaxf(m, mx), mc = fmaxf(mnew, -1e20f) * SM_C;
        float ps = 0.f;
#pragma unroll
        for (int kt = 0; kt < 4; ++kt)
#pragma unroll
            for (int rg = 0; rg < 4; ++rg) ps += __builtin_amdgcn_exp2f(s[kt][rg] * SM_C - mc);
        l = l * __builtin_amdgcn_exp2f((m - mnew) * SM_C) + ps; m = mnew;
    }
    l = rowq_sum(l);
    const float inv = 1.0f / fmaxf(l, 1e-30f), mc = fmaxf(m, -1e20f) * SM_C;
    unsigned key[32];
#pragma unroll
    for (int dt = 0; dt < 4; ++dt) Oc[dt] = (pg8::f32x4){0.f, 0.f, 0.f, 0.f};
#pragma unroll
    for (int ct = 0; ct < 4; ++ct) {
        if (ct < NCT) {
            pg8::f32x4 s[4];
            { bf16x8 kf[4][2]; load_kfrags(lds + ct * AT_TILE, fr, fq, kf);
#pragma unroll
              for (int kt = 0; kt < 4; ++kt) { s[kt] = __builtin_amdgcn_mfma_f32_16x16x32_bf16(kf[kt][0], q[0], (pg8::f32x4){0.f, 0.f, 0.f, 0.f}, 0, 0, 0);
                  s[kt] = __builtin_amdgcn_mfma_f32_16x16x32_bf16(kf[kt][1], q[1], s[kt], 0, 0, 0); } }
#pragma unroll
            for (int kt = 0; kt < 4; ++kt)
#pragma unroll
                for (int rg = 0; rg < 4; ++rg) { const int n = 64 * ct + 16 * kt + 4 * fq + rg; s[kt][rg] = (n < nv) ? __builtin_amdgcn_exp2f(s[kt][rg] * SM_C - mc) * inv : 0.f; }
#pragma unroll
            for (int kt = 0; kt < 4; ++kt)
#pragma unroll
                for (int e = 0; e < 2; ++e) {
                    float im = s[kt][2 * e] + s[kt][2 * e + 1];
                    im += __shfl_xor(im, 1); im += __shfl_xor(im, 2);
                    const int j = 32 * ct + 8 * kt + 2 * fq + e;
                    key[(ct * 4 + kt) * 2 + e] = (j >= 1 && j <= cur - 2) ? ((__float_as_uint(im) & 0xFFFFFF80u) | (unsigned)(127 - j)) : 0u;
                }
            const bf16x8 pb0 = pack_p(s[0], s[1]), pb1 = pack_p(s[2], s[3]);
            asm volatile("" ::: "memory");
            { bf16x8 vf[4][2]; load_vfrags(lds + (CV0 + ct) * AT_TILE, fr, fq, vf); attn_pv(Oc, vf, pb0, pb1); }
        } else {
#pragma unroll
            for (int k = 0; k < 8; ++k) key[ct * 8 + k] = 0u;
        }
    }
    sel[0] = sel[1] = sel[2] = sel[3] = 0u;
    if (cur < 16) { sel[0] = (1u << (cur + 1)) - 1u; return; }
    {
        sel[0] |= 1u;
#pragma unroll
        for (int w = 0; w < 4; ++w) { if ((cur >> 5) == w) sel[w] |= 1u << (cur & 31); if (((cur - 1) >> 5) == w) sel[w] |= 1u << ((cur - 1) & 31); }
    }
#pragma unroll 1
    for (int it = 0; it < 13; ++it) {
        unsigned best = 0u;
#pragma unroll
        for (int k = 0; k < 32; ++k) best = best > key[k] ? best : key[k];
        best = rowq_umax(best);
        if (best != 0u) { const int jb = 127 - (int)(best & 127u);
#pragma unroll
            for (int w = 0; w < 4; ++w) if ((jb >> 5) == w) sel[w] |= 1u << (jb & 31); }
#pragma unroll
        for (int k = 0; k < 32; ++k) key[k] = (key[k] == best) ? 0u : key[k];
    }
}
__device__ __forceinline__ unsigned wave_or_tok(unsigned u) { u |= __shfl_xor(u, 4); u |= __shfl_xor(u, 8); return __builtin_amdgcn_readfirstlane(u); }
__device__ __forceinline__ void attn_prompt_unit(LAS unsigned char* lds, LAS unsigned* wgU, unsigned char* ws, int bg, int i, int tid, float* dbg) {
    const int wid = __builtin_amdgcn_readfirstlane(tid >> 6), lane = tid & 63, fr = lane & 15, fq = lane >> 4;
    const int b = bg >> 1, g = bg & 1, t0 = 64 * i, cur = i;
    const bf16* QRAW = (const bf16*)(ws + WS_QRAW); const bf16* QROT = (const bf16*)(ws + WS_QROT);
    const int tA = t0 + 8 * wid + (fr >> 2), tB = tA + 4, head = g * 4 + (fr & 3);
    const size_t mA = (size_t)b * TP + tA, mB = mA + 4;
    if (tid < 4) wgU[tid] = 0u;
    const int NCT = (2 * i + 2 + 63) >> 6;
    { const int row = tid >> 3, ch = tid & 7;
      const bf16* ck = (const bf16*)(ws + WS_CKP) + (size_t)bg * 256 * 64; const bf16* cv = (const bf16*)(ws + WS_CVP) + (size_t)bg * 256 * 64;
#pragma unroll
      for (int ct = 0; ct < 4; ++ct) if (ct < NCT) {
          *(LAS v4u*)(lds + ct * AT_TILE + row * ATS + ch * 16) = *(const v4u*)(ck + (size_t)(ct * 64 + row) * 64 + ch * 8);
          *(LAS v4u*)(lds + (4 + ct) * AT_TILE + row * ATS + ch * 16) = *(const v4u*)(cv + (size_t)(ct * 64 + row) * 64 + ch * 8); } }
    __syncthreads();
    LAS pg8::f32x4* stash = (LAS pg8::f32x4*)(lds + AT_STASH) + wid * 8 * 64 + lane;
    unsigned selA[4], selB[4];
    const float* gtA = (const float*)(ws + WS_GATES) + mA * 24 + head; const float* gtB = gtA + 4 * 24;
    {   bf16x8 q[2]; pg8::f32x4 Oc[4];
        q[0] = *(const bf16x8*)(QRAW + mA * 512 + head * 64 + 8 * fq); q[1] = *(const bf16x8*)(QRAW + mA * 512 + head * 64 + 32 + 8 * fq);
        attn_cmp_group<4>(lds, NCT, q, tA, cur, fr, fq, Oc, selA);
        if (dbg) {
#pragma unroll
            for (int dt = 0; dt < 4; ++dt) *(pg8::f32x4*)(dbg + (mA * 3 + 0) * 512 + head * 64 + 16 * dt + 4 * fq) = Oc[dt]; }
        { const float gA = gtA[0];
#pragma unroll
          for (int dt = 0; dt < 4; ++dt) stash[dt * 64] = Oc[dt] * gA; }
        asm volatile("" ::: "memory");
        q[0] = *(const bf16x8*)(QRAW + mB * 512 + head * 64 + 8 * fq); q[1] = *(const bf16x8*)(QRAW + mB * 512 + head * 64 + 32 + 8 * fq);
        attn_cmp_group<4>(lds, NCT, q, tB, cur, fr, fq, Oc, selB);
        if (dbg) {
#pragma unroll
            for (int dt = 0; dt < 4; ++dt) *(pg8::f32x4*)(dbg + (mB * 3 + 0) * 512 + head * 64 + 16 * dt + 4 * fq) = Oc[dt]; }
        { const float gB = gtB[0];
#pragma unroll
          for (int dt = 0; dt < 4; ++dt) stash[(4 + dt) * 64] = Oc[dt] * gB; }
    }
    unsigned nA[4], nB[4];
#pragma unroll
    for (int w = 0; w < 4; ++w) { nA[w] = wave_or_tok(selA[w]); nB[w] = wave_or_tok(selB[w]); }
    if (lane == 0) {
#pragma unroll
        for (int w = 0; w < 4; ++w) atomicOr((unsigned*)(wgU + w), nA[w] | nB[w]); }
    __syncthreads();
    AGroup GA, GB;
    {
        const unsigned W0 = __builtin_amdgcn_readfirstlane(wgU[0]), W1 = __builtin_amdgcn_readfirstlane(wgU[1]), W2 = __builtin_amdgcn_readfirstlane(wgU[2]), W3 = __builtin_amdgcn_readfirstlane(wgU[3]);
        GA.q[0] = *(const bf16x8*)(QROT + mA * 512 + head * 64 + 8 * fq); GA.q[1] = *(const bf16x8*)(QROT + mA * 512 + head * 64 + 32 + 8 * fq);
        GB.q[0] = *(const bf16x8*)(QROT + mB * 512 + head * 64 + 8 * fq); GB.q[1] = *(const bf16x8*)(QROT + mB * 512 + head * 64 + 32 + 8 * fq);
#pragma unroll
        for (int dt = 0; dt < 4; ++dt) { GA.O[dt] = (pg8::f32x4){0.f, 0.f, 0.f, 0.f}; GB.O[dt] = (pg8::f32x4){0.f, 0.f, 0.f, 0.f}; }
        GA.m = GB.m = -1e30f; GA.l = GB.l = 0.f;
        attn_walk<false>(lds, (const bf16*)(ws + WS_KS) + (size_t)bg * TP * 64, (const bf16*)(ws + WS_VS) + (size_t)bg * TP * 64, W0, W1, W2, W3,
                         nA[0], nA[1], nA[2], nA[3], nB[0], nB[1], nB[2], nB[3], selA, selB, tA, tB, GA, GB, tid, fr, fq);
        const float lA = rowq_sum(GA.l);
        const float lB = rowq_sum(GB.l);
        const float iA = 1.0f / fmaxf(lA, 1e-30f), iB = 1.0f / fmaxf(lB, 1e-30f);
        if (dbg) {
#pragma unroll
            for (int dt = 0; dt < 4; ++dt) { *(pg8::f32x4*)(dbg + (mA * 3 + 1) * 512 + head * 64 + 16 * dt + 4 * fq) = GA.O[dt] * iA; *(pg8::f32x4*)(dbg + (mB * 3 + 1) * 512 + head * 64 + 16 * dt + 4 * fq) = GB.O[dt] * iB; } }
        const float gA = gtA[8] * iA, gB = gtB[8] * iB;
#pragma unroll
        for (int dt = 0; dt < 4; ++dt) { stash[dt * 64] = stash[dt * 64] + GA.O[dt] * gA; stash[(4 + dt) * 64] = stash[(4 + dt) * 64] + GB.O[dt] * gB; }
    }
    pg8::f32x4 OA[4], OB[4];
    {
        const int jlo = i > 8 ? i - 8 : 0;
        unsigned W[4];
#pragma unroll
        for (int w = 0; w < 4; ++w) { unsigned x = 0u;
#pragma unroll
            for (int k = 0; k < 9; ++k) { const int j = jlo + k; if (j <= i && (j >> 5) == w) x |= 1u << (j & 31); }
            W[w] = x; }
#pragma unroll
        for (int dt = 0; dt < 4; ++dt) { GA.O[dt] = (pg8::f32x4){0.f, 0.f, 0.f, 0.f}; GB.O[dt] = (pg8::f32x4){0.f, 0.f, 0.f, 0.f}; }
        GA.m = GB.m = -1e30f; GA.l = GB.l = 0.f;
        attn_walk<true>(lds, (const bf16*)(ws + WS_KW) + (size_t)bg * TP * 64, (const bf16*)(ws + WS_VW) + (size_t)bg * TP * 64, W[0], W[1], W[2], W[3],
                        W[0], W[1], W[2], W[3], W[0], W[1], W[2], W[3], selA, selB, tA, tB, GA, GB, tid, fr, fq);
        const float lA = rowq_sum(GA.l);
        const float lB = rowq_sum(GB.l);
        const float iA = 1.0f / fmaxf(lA, 1e-30f), iB = 1.0f / fmaxf(lB, 1e-30f);
        if (dbg) {
#pragma unroll
            for (int dt = 0; dt < 4; ++dt) { *(pg8::f32x4*)(dbg + (mA * 3 + 2) * 512 + head * 64 + 16 * dt + 4 * fq) = GA.O[dt] * iA; *(pg8::f32x4*)(dbg + (mB * 3 + 2) * 512 + head * 64 + 16 * dt + 4 * fq) = GB.O[dt] * iB; } }
        const float gA = gtA[16] * iA, gB = gtB[16] * iB;
#pragma unroll
        for (int dt = 0; dt < 4; ++dt) { OA[dt] = stash[dt * 64] + GA.O[dt] * gA; OB[dt] = stash[(4 + dt) * 64] + GB.O[dt] * gB; }
    }
    bf16* MIX = (bf16*)(ws + WS_MIX);
#pragma unroll
    for (int dt = 0; dt < 4; ++dt) {
        u32x2 w; w.x = pk2(OA[dt][0], OA[dt][1]); w.y = pk2(OA[dt][2], OA[dt][3]); *(u32x2*)(MIX + mA * DM + head * 64 + 16 * dt + 4 * fq) = w;
        w.x = pk2(OB[dt][0], OB[dt][1]); w.y = pk2(OB[dt][2], OB[dt][3]); *(u32x2*)(MIX + mB * DM + head * 64 + 16 * dt + 4 * fq) = w; }
}

__device__ __forceinline__ void load_kfrags_f32(const float* kb, int nrows, int fr, int fq, bf16x8 (&kf)[4][2]) {
#pragma unroll
    for (int kt = 0; kt < 4; ++kt) { const int row = 16 * kt + fr; const float* rp = kb + (size_t)(row < nrows ? row : 0) * KVW + 8 * fq;
#pragma unroll
        for (int ks = 0; ks < 2; ++ks) { const pg8::f32x4 a = *(const pg8::f32x4*)(rp + 32 * ks), b = *(const pg8::f32x4*)(rp + 32 * ks + 4);
            v4u w; w.x = pk2(a[0], a[1]); w.y = pk2(a[2], a[3]); w.z = pk2(b[0], b[1]); w.w = pk2(b[2], b[3]); kf[kt][ks] = __builtin_bit_cast(bf16x8, w); } }
}
__device__ __forceinline__ void stage_v_f32(LAS unsigned char* vt, const float* vb, int nrows, int lane) {
#pragma unroll
    for (int it = 0; it < 16; ++it) { const int idx = it * 64 + lane, row = idx >> 4, c4 = idx & 15;
        pg8::f32x4 a = {0.f, 0.f, 0.f, 0.f};
        if (row < nrows) a = *(const pg8::f32x4*)(vb + (size_t)row * KVW + c4 * 4);
        u32x2 w; w.x = pk2(a[0], a[1]); w.y = pk2(a[2], a[3]); *(LAS u32x2*)(vt + row * ATS + c4 * 8) = w; }
}
__device__ __forceinline__ void attn_sample_unit(LAS unsigned char* lds, unsigned char* ws, float* out, const float* cache_slc_l, const int* pt_row, const float* state_lb, int L, int bs, int g, int wid, int lane) {
    const int fr = lane & 15, fq = lane >> 4, tid = wid * 64 + lane;
    const int sl = fr >> 2, head = g * 4 + (fr & 3), t = PAST + sl;
    const size_t m = (size_t)MP + bs * 4 + sl;
    const bf16* QRAW = (const bf16*)(ws + WS_QRAW); const bf16* QROT = (const bf16*)(ws + WS_QROT);
    {
        const int row = tid >> 3, ch = tid & 7; const size_t co = (((size_t)L * NB_S + bs) * 2 + g) * 64 * 64;
        *(LAS v4u*)(lds + row * ATS + ch * 16) = *(const v4u*)((const bf16*)(ws + WS_CKS) + co + (size_t)row * 64 + ch * 8);
        *(LAS v4u*)(lds + AT_TILE + row * ATS + ch * 16) = *(const v4u*)((const bf16*)(ws + WS_CVS) + co + (size_t)row * 64 + ch * 8); }
    __syncthreads();
    pg8::f32x4 Oc[4]; unsigned sel[4];
    {   bf16x8 q[2]; q[0] = *(const bf16x8*)(QRAW + m * 512 + head * 64 + 8 * fq); q[1] = *(const bf16x8*)(QRAW + m * 512 + head * 64 + 32 + 8 * fq);
        attn_cmp_group<1>(lds, 1, q, t, 32, fr, fq, Oc, sel); }
    unsigned U0 = wave_or_tok(sel[0]); const unsigned U1 = wave_or_tok(sel[1]) & 1u;
    AGroup Gs, Gw;
    Gs.q[0] = *(const bf16x8*)(QROT + m * 512 + head * 64 + 8 * fq); Gs.q[1] = *(const bf16x8*)(QROT + m * 512 + head * 64 + 32 + 8 * fq);
    Gw.q[0] = Gs.q[0]; Gw.q[1] = Gs.q[1];
#pragma unroll
    for (int dt = 0; dt < 4; ++dt) { Gs.O[dt] = (pg8::f32x4){0.f, 0.f, 0.f, 0.f}; Gw.O[dt] = (pg8::f32x4){0.f, 0.f, 0.f, 0.f}; }
    Gs.m = Gw.m = -1e30f; Gs.l = Gw.l = 0.f;
    LAS unsigned char* vt = lds + (2 + wid) * AT_TILE;
    const float* newslc = out + O_SLCS + ((size_t)L * MS + bs * 4) * KVW;
    const float* newwin = out + O_WINS + (((size_t)L * NB_S + bs) * 512 + 508) * KVW;
    int cnt = 0;
#pragma unroll 1
    for (int j = 0; j < 33; ++j) {
        const bool inU = j < 32 ? ((U0 >> j) & 1u) : (U1 != 0u);
        if (!inU) continue;
        const bool mine = ((cnt & 7) == wid); ++cnt;
        if (!mine) continue;
        const float* rb; int nrows;
        if (j < 32) { const int page = pt_row[j >> 1]; rb = cache_slc_l + ((size_t)page * PAGE + (j & 1) * 64) * KVW + g * 64; nrows = 64; } else { rb = newslc + g * 64; nrows = 4; }
        bf16x8 pb0, pb1;
        { bf16x8 kf[4][2]; load_kfrags_f32(rb, nrows, fr, fq, kf);
          const unsigned w = j < 32 ? sel[0] : sel[1]; const int hi = ((w >> (j & 31)) & 1u) ? t - 64 * j : -1;
          attn_score(Gs, kf, 0, hi, fq, pb0, pb1); }
        stage_v_f32(vt, rb + 128, nrows, lane);
        WAVE_LDS_FENCE();
        { bf16x8 vf[4][2]; load_vfrags(vt, fr, fq, vf); attn_pv(Gs.O, vf, pb0, pb1); }
        WAVE_LDS_FENCE();
    }
#pragma unroll 1
    for (int i = 0; i < 9; ++i) {
        const bool mine = (((cnt + i) & 7) == wid);
        if (!mine) continue;
        const float* rb; int nrows;
        if (i < 8) { rb = state_lb + (size_t)i * 64 * KVW + g * 64; nrows = 64; } else { rb = newwin + g * 64; nrows = 4; }
        bf16x8 pb0, pb1;
        { bf16x8 kf[4][2]; load_kfrags_f32(rb, nrows, fr, fq, kf);
          attn_score(Gw, kf, sl + 1 - 64 * i, sl + 512 - 64 * i, fq, pb0, pb1); }
        stage_v_f32(vt, rb + 128, nrows, lane);
        WAVE_LDS_FENCE();
        { bf16x8 vf[4][2]; load_vfrags(vt, fr, fq, vf); attn_pv(Gw.O, vf, pb0, pb1); }
        WAVE_LDS_FENCE();
    }
    {   LAS pg8::f32x4* po = (LAS pg8::f32x4*)vt + lane; LAS f32x2* pm = (LAS f32x2*)(vt + 4096) + lane;
#pragma unroll
        for (int dt = 0; dt < 4; ++dt) { po[dt * 64] = Gs.O[dt]; ((LAS pg8::f32x4*)(vt + 4608) + lane)[dt * 64] = Gw.O[dt]; }
        pm[0] = (f32x2){Gs.m, Gs.l}; ((LAS f32x2*)(vt + 4608 + 4096) + lane)[0] = (f32x2){Gw.m, Gw.l}; }
    __syncthreads();
    if (wid == 0) {
        float Ms = -1e30f, Mw = -1e30f;
#pragma unroll
        for (int w = 0; w < 8; ++w) { const LAS unsigned char* sv = lds + (2 + w) * AT_TILE; Ms = fmaxf(Ms, ((const LAS f32x2*)(sv + 4096) + lane)[0].x); Mw = fmaxf(Mw, ((const LAS f32x2*)(sv + 4608 + 4096) + lane)[0].x); }
        pg8::f32x4 Os[4], Ow[4]; float ls = 0.f, lw = 0.f;
#pragma unroll
        for (int dt = 0; dt < 4; ++dt) { Os[dt] = (pg8::f32x4){0.f, 0.f, 0.f, 0.f}; Ow[dt] = (pg8::f32x4){0.f, 0.f, 0.f, 0.f}; }
#pragma unroll 1
        for (int w = 0; w < 8; ++w) { const LAS unsigned char* sv = lds + (2 + w) * AT_TILE;
            const f32x2 a = ((const LAS f32x2*)(sv + 4096) + lane)[0], b = ((const LAS f32x2*)(sv + 4608 + 4096) + lane)[0];
            const float fa = __builtin_amdgcn_exp2f((a.x - Ms) * SM_C), fb = __builtin_amdgcn_exp2f((b.x - Mw) * SM_C);
            ls += a.y * fa; lw += b.y * fb;
#pragma unroll
            for (int dt = 0; dt < 4; ++dt) { Os[dt] = Os[dt] + ((const LAS pg8::f32x4*)sv + lane)[dt * 64] * fa; Ow[dt] = Ow[dt] + ((const LAS pg8::f32x4*)(sv + 4608) + lane)[dt * 64] * fb; } }
        ls = rowq_sum(ls); lw = rowq_sum(lw);
        const float* gt = (const float*)(ws + WS_GATES) + m * 24 + head;
        const float g0 = gt[0], g1 = gt[8] / fmaxf(ls, 1e-30f), g2 = gt[16] / fmaxf(lw, 1e-30f);
        bf16* MIX = (bf16*)(ws + WS_MIX);
#pragma unroll
        for (int dt = 0; dt < 4; ++dt) { const pg8::f32x4 o = Oc[dt] * g0 + Os[dt] * g1 + Ow[dt] * g2;
            u32x2 w; w.x = pk2(o[0], o[1]); w.y = pk2(o[2], o[3]); *(u32x2*)(MIX + m * DM + head * 64 + 16 * dt + 4 * fq) = w; }
    }
    __syncthreads();
}
struct Args { const float* in[23]; float* out; unsigned char* ws; int ph_lo, ph_hi, use_bar, grid; };

static_assert(sizeof(Args) == 216, "Args layout");
__device__ __forceinline__ int lane_id_opaque() { int x; asm volatile("v_mbcnt_lo_u32_b32 %0, -1, 0\n\tv_mbcnt_hi_u32_b32 %0, -1, %0" : "=v"(x)); return x; }
template <int OFF> __device__ __forceinline__ unsigned long long karg64() {
    unsigned long long v; const unsigned long long kp = (unsigned long long)__builtin_amdgcn_kernarg_segment_ptr();
    asm volatile("s_load_dwordx2 %0, %1, %2\n\ts_waitcnt lgkmcnt(0)" : "=s"(v) : "s"(kp), "n"(OFF) : "memory");
    return v;
}
template <int OFF> __device__ __forceinline__ int karg32() {
    int v; const unsigned long long kp = (unsigned long long)__builtin_amdgcn_kernarg_segment_ptr();
    asm volatile("s_load_dword %0, %1, %2\n\ts_waitcnt lgkmcnt(0)" : "=s"(v) : "s"(kp), "n"(OFF) : "memory");
    return v;
}
#define KIN(k) ((const float*)(GAS const float*)karg64<8 * (k)>())
#define K_LO() karg32<200>()
#define K_HI() karg32<204>()
#define K_USEBAR() karg32<208>()
#define K_GRID() karg32<212>()
#define KOUT() ((float*)(GAS float*)karg64<184>())
#define KWS() ((unsigned char*)(GAS unsigned char*)karg64<192>())

__global__ void __launch_bounds__(NWAVES * 64, 2) fwd(Args args) {
    extern __shared__ __attribute__((aligned(16))) unsigned char lds_raw[];
    LAS unsigned char* lds = (LAS unsigned char*)lds_raw;
#define MISC ((volatile LAS unsigned*)(lds + MISC_OFF))
    int wave = __builtin_amdgcn_readfirstlane((int)threadIdx.x >> 6);
#define LANE_ID() lane_id_opaque()
#define TID_NOW() (wave * 64 + LANE_ID())
    { const int tid0 = TID_NOW();
      for (int u = tid0; u < (LDS_BYTES - LDSCTL_OFF) / 4; u += NWAVES * 64) ((LAS unsigned*)(lds + LDSCTL_OFF))[u] = 0u; }
    __syncthreads();
    if (K_USEBAR()) (void)xcd_barrier_post((unsigned*)(KWS() + WS_CTL) + CW_BAR, MISC + 8, (wave == 0) ? 1u : 0u);
#define PH_COMMON() int bid_ = (int)blockIdx.x; asm volatile("" : "+s"(bid_)); const int G = K_GRID(), bid = bid_, gw = bid * NWAVES + wave, NGW = G * NWAVES, NGT = G * NWAVES * 64; (void)gw; (void)NGW; (void)NGT
#ifndef PH_ENABLE
#define PH_ENABLE 0xFFFFFFFFu
#endif
#define PHBIT(k) (((k) < PH_L0) ? (k) : (PH_L0 + ((k) - PH_L0) % PH_PER_LAYER))
#define IN(k) (((PH_ENABLE >> PHBIT(k)) & 1u) && K_LO() <= (k) && (k) < K_HI())
#ifndef PH_REPEAT
#define PH_REPEAT 0u
#endif
#define REP(k) for (int rep_ = 0; rep_ < ((((PH_REPEAT) >> PHBIT(k)) & 1u) ? 2 : 1); ++rep_)
#define SEAM(k) do { if (K_USEBAR() && (k) + 1 < K_HI()) { XcdBarrier bar_; bar_.bar = (unsigned*)(KWS() + WS_CTL) + CW_BAR; bar_.x = xb_xcc_id(); bar_.st = MISC + 8; bar_.w0 = (wave == 0) ? 1u : 0u; xcd_barrier(bar_); } } while (0)

    if (IN(PH_P0A)) { REP(PH_P0A) {
        unsigned char* ws = KWS(); float* out = KOUT();
        PH_COMMON(); const int lane = LANE_ID(), gt = bid * (NWAVES * 64) + wave * 64 + lane;
        LAS float* scr = (LAS float*)(lds + RING_OFF + wave * 16384);
        constexpr int I_IN = 16 * 73, I_OUT = 16 * 32, I_G = 16 * 88, I_D = 44 * 32, I_W1 = 32 * 8, I_W2 = 4 * 2;
        constexpr int I_LAYER = I_IN + I_OUT + 2 * I_G + I_D + 2 * I_W1 + 2 * I_W2;
        for (int it = gw; it < NLAYER * I_LAYER; it += NGW) {
            const int L = it / I_LAYER; int r = it % I_LAYER;
            if (r < I_IN) { transpose_item(KIN(6) + (size_t)L * DM * PIN, DM, PIN, (bf16*)(ws + WS_WIN_T) + (size_t)L * NIN * DM, RmInProj{}, scr, r, lane); continue; } r -= I_IN;
            if (r < I_OUT) { transpose_item(KIN(15) + (size_t)L * DM * DM, DM, DM, (bf16*)(ws + WS_WOUT_T) + (size_t)L * DM * DM, RmIdent{}, scr, r, lane); continue; } r -= I_OUT;
            if (r < I_G) { transpose_item(KIN(18) + (size_t)L * DM * FFN, DM, FFN, (bf16*)(ws + WS_WGU_T) + (size_t)L * NGU * DM, RmAffine{2, 0}, scr, r, lane); continue; } r -= I_G;
            if (r < I_G) { transpose_item(KIN(19) + (size_t)L * DM * FFN, DM, FFN, (bf16*)(ws + WS_WGU_T) + (size_t)L * NGU * DM, RmAffine{2, 1}, scr, r, lane); continue; } r -= I_G;
            if (r < I_D) { transpose_item(KIN(20) + (size_t)L * FFN * DM, FFN, DM, (bf16*)(ws + WS_WDN_T) + (size_t)L * DM * FFN, RmIdent{}, scr, r, lane); continue; } r -= I_D;
            if (r < 2 * I_W1) { const int kind = r / I_W1; transpose_item(KIN(8) + (size_t)(L * 2 + kind) * 2048 * 256, 2048, 256, (bf16*)(ws + WS_W1C_T) + (size_t)(L * 2 + kind) * 256 * 2048, RmIdent{}, scr, r % I_W1, lane); continue; } r -= 2 * I_W1;
            { const int kind = r / I_W2; transpose_item(KIN(10) + (size_t)(L * 2 + kind) * 256 * 64, 256, 64, (bf16*)(ws + WS_W2C_T) + (size_t)(L * 2 + kind) * 64 * 256, RmIdent{}, scr, r % I_W2, lane); }
        }
        for (int i = gt; i < NLAYER * (NIN - PIN) * (DM / 8); i += NGT) { const int L = i / ((NIN - PIN) * (DM / 8)), r = i % ((NIN - PIN) * (DM / 8));
            *(v4u*)((bf16*)(ws + WS_WIN_T) + (size_t)L * NIN * DM + (size_t)PIN * DM + (size_t)r * 8) = (v4u){0u, 0u, 0u, 0u}; }
        for (int i = gt; i < TP * 32; i += NGT) {
            const int pos = i >> 5, d = i & 31;
            double fr_ = 1.0; for (int k = 0; k < d; ++k) fr_ *= 0.7498942093324558;
            const float angf = (float)pos * (float)fr_;
            const double a = (double)angf;
            const double kq = __builtin_rint(a * 0.63661977236758134308);
            double rr = __builtin_fma(-kq, 1.57079632673412561417e+00, a); rr = __builtin_fma(-kq, 6.07710050650619224932e-11, rr);
            const double r2 = rr * rr;
            double sp = -7.6471637318198164759e-13; sp = sp * r2 + 1.6059043836821614599e-10; sp = sp * r2 - 2.5052108385441718775e-08; sp = sp * r2 + 2.7557319223985890653e-06;
            sp = sp * r2 - 1.9841269841269841270e-04; sp = sp * r2 + 8.3333333333333333333e-03; sp = sp * r2 - 1.6666666666666666667e-01; const double sn = rr + rr * r2 * sp;
            double cp = 4.7794773323873852974e-14; cp = cp * r2 - 1.1470745597729724714e-11; cp = cp * r2 + 2.0876756987868098979e-09; cp = cp * r2 - 2.7557319223985890653e-07;
            cp = cp * r2 + 2.4801587301587301587e-05; cp = cp * r2 - 1.3888888888888888889e-03; cp = cp * r2 + 4.1666666666666666667e-02; cp = cp * r2 - 0.5; const double cn = 1.0 + r2 * cp;
            const int q4 = ((int)kq) & 3;
            const double c = (q4 == 0) ? cn : (q4 == 1) ? -sn : (q4 == 2) ? -cn : sn;
            const double s = (q4 == 0) ? sn : (q4 == 1) ? cn : (q4 == 2) ? -sn : -cn;
            ((f32x2*)(ws + WS_ROPE))[i] = (f32x2){(float)c, (float)s};
        }
        { const float* xp = KIN(0); const float* xs = KIN(1); float* XF = (float*)(ws + WS_XF); bf16* XB = (bf16*)(ws + WS_XB);
        for (int row = gw; row < MT; row += NGW) {
            const float* src = row < MP ? xp + (size_t)row * DM : xs + (size_t)(row - MP) * DM;
#pragma unroll
            for (int j = 0; j < 4; ++j) { const int c = (j * 64 + lane) * 4; const pg8::f32x4 v = *(const pg8::f32x4*)(src + c);
                *(pg8::f32x4*)(XF + (size_t)row * DM + c) = v; u32x2 w; w.x = pk2(v[0], v[1]); w.y = pk2(v[2], v[3]); *(u32x2*)(XB + (size_t)row * DM + c) = w; }
        } }
        { const float* gws = KIN(13); const float* gbs = KIN(14); bf16* GWP = (bf16*)(ws + WS_GWP); bf16* GWS = (bf16*)(ws + WS_GWS); float* GBS = (float*)(ws + WS_GBS);
        for (int i = gt; i < NLAYER * 8 * 128 * 128; i += NGT) {
            const int lh = i >> 14, t = (i >> 7) & 127, s = i & 127;
            const float* wsrc = gws + (size_t)lh * 16384;
            GWP[i] = (bf16)f2bf((s <= t) ? wsrc[t * 128 + s] : 0.f);
            GWS[i] = (bf16)f2bf(((t >> 2) == (s >> 2) && (s & 3) <= (t & 3)) ? wsrc[(t & 3) * 128 + (s & 3)] : 0.f);
        }
        for (int i = gt; i < NLAYER * 8 * 128; i += NGT) GBS[i] = gbs[(i & ~127) + (i & 3)]; }
        { const float* st = KIN(4);
        for (int i = gt; i < NLAYER * NB_S * 508 * 64; i += NGT) { const int lb = i / (508 * 64), r = i % (508 * 64);
            *(pg8::f32x4*)(out + O_WINS + (size_t)lb * 512 * KVW + (size_t)r * 4) = *(const pg8::f32x4*)(st + (size_t)lb * 512 * KVW + 4 * KVW + (size_t)r * 4); } }
        } SEAM(PH_P0A);
    }
    if (IN(PH_P0B)) { REP(PH_P0B) {
        unsigned char* ws = KWS();
        PH_COMMON(); int tid = TID_NOW(); asm volatile("" : "+v"(tid));
        const int* PT = (const int*)KIN(5); const float* cache = KIN(2); const float* pe = KIN(7); const float* b1 = KIN(9);
        for (int u = bid; u < NLAYER * 2 * 256; u += G) {
            const int L = u >> 9, kind = (u >> 8) & 1, rb = u & 255;
            const int R = rb * 64 + (tid >> 3), bs = R >> 7, n = (R >> 1) & 63, g = R & 1;
            const int page = PT[bs * NPG + (n >> 2)];
            const float* arow = cache + ((size_t)L * NPOOL + page) * PAGE * KVW + (size_t)((n & 3) * 32) * KVW + kind * 128 + g * 64 + (tid & 7) * 8;
            compress_unit(lds + RING_OFF, arow, pe + (size_t)(L * 2 + kind) * 2048, (const bf16*)(ws + WS_W1C_T) + (size_t)(L * 2 + kind) * 256 * 2048, b1 + (L * 2 + kind) * 256,
                          (const bf16*)(ws + WS_W2C_T) + (size_t)(L * 2 + kind) * 64 * 256, (bf16*)(ws + (kind ? WS_CVS : WS_CKS)) + (size_t)L * NB_S * 2 * 64 * 64, 64, rb, tid);
        }
        } SEAM(PH_P0B);
    }
    for (int L = 0; L < NLAYER; ++L) {
        asm volatile("" : "+s"(wave), "+s"(lds));
        const int pb = PH_L0 + L * PH_PER_LAYER;
        if (IN(pb + 0)) { REP(pb + 0) {
            unsigned char* ws = KWS(); PH_COMMON();
            pg8::Gemm g{(const bf16*)(ws + WS_XB), (const bf16*)(ws + WS_WIN_T) + (size_t)L * NIN * DM, MT, NIN, DM}; pg8::StaticOrder S; S.init(MT, NIN, G, bid);
            EpiInProj E{L, ws, KOUT()};
            pg8::gemm_phase<EpiInProj, pg8::StaticOrder, true, true>(lds + RING_OFF, g, S, E, TID_NOW());
            } SEAM(pb + 0);
        }
        if (IN(pb + 1)) { REP(pb + 1) {
            unsigned char* ws = KWS(); float* out = KOUT(); PH_COMMON();
            int tid = TID_NOW(); asm volatile("" : "+v"(tid));
            for (int u = bid; u < 64 + 132; u += G) {
                if (u < 64) {
                    const int kind = u >> 5, rb = u & 31;
                    const int R0 = rb * 32 + (tid & 15), R1 = R0 + 16;
                    const float* rowbase0 = out + O_CMPP + ((size_t)(L * BP + (R0 >> 9)) * TP + 32 * ((R0 >> 1) & 255)) * KVW + kind * 128 + (R0 & 1) * 64;
                    const float* rowbase1 = out + O_CMPP + ((size_t)(L * BP + (R1 >> 9)) * TP + 32 * ((R1 >> 1) & 255)) * KVW + kind * 128 + (R1 & 1) * 64;
                    compress32_unit(lds + RING_OFF, rowbase0, rowbase1, KIN(7) + (size_t)(L * 2 + kind) * 2048, (const bf16*)(ws + WS_W1C_T) + (size_t)(L * 2 + kind) * 256 * 2048, KIN(9) + (L * 2 + kind) * 256,
                                    (const bf16*)(ws + WS_W2C_T) + (size_t)(L * 2 + kind) * 64 * 256, (bf16*)(ws + (kind ? WS_CVP : WS_CKP)), 256, rb, tid);
#if ATT_PROBE
                    {
                        __syncthreads();
                        const int rb64 = rb >> 1;
                        const int R = rb64 * 64 + (tid >> 3), b_ = R >> 9, n_ = (R >> 1) & 255, g_ = R & 1;
                        const float* arow = out + O_CMPP + ((size_t)(L * BP + b_) * TP + 32 * n_) * KVW + kind * 128 + g_ * 64 + (tid & 7) * 8;
                        bf16* alt = (bf16*)(ws + WS_DBG2) + (size_t)kind * 4 * 256 * 64;
                        if ((rb & 1) == 0) compress_unit(lds + RING_OFF, arow, KIN(7) + (size_t)(L * 2 + kind) * 2048, (const bf16*)(ws + WS_W1C_T) + (size_t)(L * 2 + kind) * 256 * 2048, KIN(9) + (L * 2 + kind) * 256,
                                      (const bf16*)(ws + WS_W2C_T) + (size_t)(L * 2 + kind) * 64 * 256, alt, 256, rb64, tid);
                    }
#endif
                } else {
                    const int q = u - 64;
                    if (q < 128) gmlp_unit(lds + RING_OFF, lds + LDSCTL_OFF + 1024, 128 * q, (const bf16*)(ws + WS_U), (const bf16*)(ws + WS_V), (const bf16*)(ws + WS_GWP) + (size_t)L * 8 * 16384, KIN(14) + L * 1024,
                                           KIN(11) + L * 512, KIN(12) + L * 512, (bf16*)(ws + WS_MIX), (float*)nullptr, tid);
                    else gmlp_unit(lds + RING_OFF, lds + LDSCTL_OFF + 1024, MP + 128 * (q - 128), (const bf16*)(ws + WS_U), (const bf16*)(ws + WS_V), (const bf16*)(ws + WS_GWS) + (size_t)L * 8 * 16384, (const float*)(ws + WS_GBS) + L * 1024,
                                   KIN(11) + L * 512, KIN(12) + L * 512, (bf16*)(ws + WS_MIX), out + O_GV + ((size_t)L * MS + 128 * (q - 128)) * 512, tid);
                }
            }
            } SEAM(pb + 1);
        }
        if (IN(pb + 2)) { REP(pb + 2) {
            unsigned char* ws = KWS(); float* out = KOUT(); PH_COMMON();
            int tid = TID_NOW(); asm volatile("" : "+v"(tid));
            const int lane = tid & 63;
#if ATT_PROBE
            float* dbg = (float*)(ws + WS_DBG);
#else
            float* dbg = nullptr;
#endif
#ifndef ATT_REP_PROMPT
#define ATT_REP_PROMPT 1
#endif
#ifndef ATT_REP_SAMPLE
#define ATT_REP_SAMPLE 1
#endif
            int nrep_p = ATT_REP_PROMPT; asm volatile("" : "+s"(nrep_p));
#pragma unroll 1
            for (int rp_ = 0; rp_ < nrep_p; ++rp_)
            for (int u = bid; u < 512; u += G) {
                const int c = u & 255, xcd = c & 7, cc = ((c >> 3) << 1) | (c & 1);
                attn_prompt_unit(lds + RING_OFF, (LAS unsigned*)(lds + LDSCTL_OFF + 2048), ws, xcd >> 1, (u >> 8) ? 127 - cc : cc, tid, dbg);
            }
            __syncthreads();
            const bf16* QRAW = (const bf16*)(ws + WS_QRAW); const bf16* QROT = (const bf16*)(ws + WS_QROT); bf16* MIX = (bf16*)(ws + WS_MIX); const float* GATES = (const float*)(ws + WS_GATES);
            LAS float* wl = (LAS float*)(lds + RING_OFF + wave * 4096);
            LAS float* qraw_l = wl; LAS float* qrot_l = wl + 256; LAS float* pbuf = wl + 512; LAS float* impb = wl + 768; LAS int* selidx = (LAS int*)(wl + 896);
            int nrep_s = ATT_REP_SAMPLE; asm volatile("" : "+s"(nrep_s));
#pragma unroll 1
            for (int rp_ = 0; rp_ < nrep_s; ++rp_)
            for (int u = bid; u < 2 * NB_S; u += G) {
                const int bs = u >> 1, g = u & 1;
                attn_sample_unit(lds + RING_OFF, ws, out, KIN(3) + (size_t)L * NPOOL * PAGE * KVW, (const int*)KIN(5) + bs * NPG, KIN(4) + ((size_t)L * NB_S + bs) * 512 * KVW, L, bs, g, wave, lane);
            }
#if ATT_PROBE
            float esum[12] = {0.f, 0.f, 0.f, 0.f, 0.f, 0.f, 0.f, 0.f, 0.f, 0.f, 0.f, 0.f};
            if (false && L == 0) {
                const bf16* A0 = (const bf16*)(ws + WS_CKS); const bf16* A1 = (const bf16*)(ws + WS_CVS); const bf16* B0 = (const bf16*)(ws + WS_DBG3);
                const int per = NLAYER * NB_S * 2 * 64 * 64;
                for (int i = gw * 64 + lane; i < 2 * per; i += NGW * 64) { const int kind = i / per, r = i % per;
                    const float a = bf2f((kind ? A1 : A0)[r]), b = bf2f(B0[i]); esum[10] += (a - b) * (a - b); esum[11] += b * b; } }
            {
                const bf16* A0 = (const bf16*)(ws + WS_CKP); const bf16* A1 = (const bf16*)(ws + WS_CVP); const bf16* B0 = (const bf16*)(ws + WS_DBG2);
                for (int i = gw * 64 + lane; i < 2 * 4 * 256 * 64; i += NGW * 64) { const int kind = i / (4 * 256 * 64), r = i % (4 * 256 * 64);
                    const float a = bf2f((kind ? A1 : A0)[r]), b = bf2f(B0[i]); esum[8] += (a - b) * (a - b); esum[9] += b * b; } }
            for (int task = gw; task < 2 * MT; task += NGW) {
#else
            for (int task = 2 * MT + gw; task < 2 * MT; task += NGW) {
#endif
                const int m = task >> 1, g = task & 1;
                const bool prompt = m < MP;
#pragma unroll
                for (int r = 0; r < 4; ++r) { qraw_l[r * 64 + lane] = 0.125f * bf2f(QRAW[(size_t)m * 512 + (g * 4 + r) * 64 + lane]); qrot_l[r * 64 + lane] = 0.125f * bf2f(QROT[(size_t)m * 512 + (g * 4 + r) * 64 + lane]); }
                impb[lane] = 0.f; impb[64 + lane] = 0.f;
                WAVE_LDS_FENCE();
                float oc[4], os[4], ow[4];
                if (prompt) {
                    const int b = m >> 13, t = m & (TP - 1); const size_t bg = (size_t)(b * 2 + g);
                    const SrcPromptCmp sc{(const bf16*)(ws + WS_CKP) + bg * 256 * 64, (const bf16*)(ws + WS_CVP) + bg * 256 * 64, (t + 1) >> 5};
                    attend(sc, (sc.nvalid + 63) >> 6, qraw_l, pbuf, lane, oc, impb);
                    WAVE_LDS_FENCE();
                    topk16(impb, 128, t >> 6, selidx, lane);
                    const SrcPromptSlc ss{(const bf16*)(ws + WS_KS) + bg * TP * 64, (const bf16*)(ws + WS_VS) + bg * TP * 64, selidx, t};
                    attend(ss, 16, qrot_l, pbuf, lane, os, (LAS float*)nullptr);
                    const int kb0 = (t > 511 ? t - 511 : 0) >> 6;
                    const SrcPromptWin sw{(const bf16*)(ws + WS_KW) + bg * TP * 64, (const bf16*)(ws + WS_VW) + bg * TP * 64, t, kb0};
                    attend(sw, (t >> 6) - kb0 + 1, qrot_l, pbuf, lane, ow, (LAS float*)nullptr);
#if ATT_PROBE
#pragma unroll
                    for (int r = 0; r < 4; ++r) { const float* dp = dbg + ((size_t)m * 3) * 512 + (g * 4 + r) * 64 + lane;
                        const float d0 = dp[0] - oc[r], d1 = dp[512] - os[r], d2 = dp[1024] - ow[r];
                        esum[0] += d0 * d0; esum[1] += oc[r] * oc[r]; esum[2] += d1 * d1; esum[3] += os[r] * os[r]; esum[4] += d2 * d2; esum[5] += ow[r] * ow[r]; }
                    WAVE_LDS_FENCE();
                    continue;
#endif
                } else {
                    const int si = m - MP, bs = si >> 2, s = si & 3;
                    const size_t co = (((size_t)L * NB_S + bs) * 2 + g) * 64 * 64;
                    const SrcSampleCmp sc{(const bf16*)(ws + WS_CKS) + co, (const bf16*)(ws + WS_CVS) + co};
                    attend(sc, 1, qraw_l, pbuf, lane, oc, impb);
                    WAVE_LDS_FENCE();
                    topk16(impb, 33, 32, selidx, lane);
                    const SrcSampleSlc ss{KIN(3) + (size_t)L * NPOOL * PAGE * KVW, (const int*)KIN(5) + bs * NPG, out + O_SLCS + ((size_t)L * MS + bs * 4) * KVW, selidx, g, s};
                    attend(ss, 16, qrot_l, pbuf, lane, os, (LAS float*)nullptr);
                    const SrcSampleWin sw{KIN(4) + ((size_t)L * NB_S + bs) * 512 * KVW, out + O_WINS + (((size_t)L * NB_S + bs) * 512 + 508) * KVW, g, s};
                    attend(sw, 9, qrot_l, pbuf, lane, ow, (LAS float*)nullptr);
                }
                const float* gtp = GATES + (size_t)m * 24;
#pragma unroll
                for (int r = 0; r < 4; ++r) { const int h = g * 4 + r; const float o = gtp[h] * oc[r] + gtp[8 + h] * os[r] + gtp[16 + h] * ow[r];
#if ATT_PROBE
                    const float mv = bf2f(MIX[(size_t)m * DM + h * 64 + lane]); esum[6] += (mv - o) * (mv - o); esum[7] += o * o;
#else
                    MIX[(size_t)m * DM + h * 64 + lane] = (bf16)f2bf(o);
#endif
                }
                WAVE_LDS_FENCE();
            }
#if ATT_PROBE
#pragma unroll
            for (int k = 0; k < 12; ++k) { const float v = wave_sum(esum[k]); if (lane == 0) atomicAdd((float*)(ws + WS_CTL) + CW_ERR + k, v); }
#endif
            __syncthreads();
            } SEAM(pb + 2);
        }
        if (IN(pb + 3)) { REP(pb + 3) {
            unsigned char* ws = KWS(); PH_COMMON();
            pg8::Gemm g{(const bf16*)(ws + WS_MIX), (const bf16*)(ws + WS_WOUT_T) + (size_t)L * DM * DM, MP, DM, DM}; pg8::StaticOrder S; S.init(MP, DM, G, bid);
            EpiResid E{(const float*)(ws + WS_XF), (float*)(ws + WS_PRE)};
            pg8::gemm_phase<EpiResid, pg8::StaticOrder, true, true>(lds + RING_OFF, g, S, E, TID_NOW());
            { int tid = TID_NOW(); asm volatile("" : "+v"(tid));
              for (int it = bid; it < 256; it += G) { const int rbk = it >> 5, cbk = it & 31; const size_t r0 = (size_t)MP + 64 * rbk;
                  skinny_item(lds + RING_OFF, (const bf16*)(ws + WS_MIX) + r0 * DM, (const bf16*)(ws + WS_WOUT_T) + (size_t)L * DM * DM + (size_t)(32 * cbk) * DM, DM,
                              (const float*)(ws + WS_XF) + r0 * DM + 32 * cbk, (float*)(ws + WS_PRE) + r0 * DM + 32 * cbk, tid); } }
            } SEAM(pb + 3);
        }
        if (IN(pb + 4)) { REP(pb + 4) {
            int lane = LANE_ID(); asm volatile("" : "+v"(lane));
            unsigned char* ws = KWS(); PH_COMMON(); const float* lg = KIN(16) + L * DM; const float* lb = KIN(17) + L * DM;
            for (int row = gw; row < MT; row += NGW) ln_row((const float*)(ws + WS_PRE) + (size_t)row * DM, lg, lb, (float*)(ws + WS_XF) + (size_t)row * DM, (bf16*)(ws + WS_XB) + (size_t)row * DM, lane);
            } SEAM(pb + 4);
        }
        if (IN(pb + 5)) { REP(pb + 5) {
            unsigned char* ws = KWS(); PH_COMMON();
            pg8::Gemm g{(const bf16*)(ws + WS_XB), (const bf16*)(ws + WS_WGU_T) + (size_t)L * NGU * DM, MT, NGU, DM}; pg8::StaticOrder S; S.init(MT, NGU, G, bid);
            EpiGateUp E{(bf16*)(ws + WS_F)};
            pg8::gemm_phase<EpiGateUp, pg8::StaticOrder, true, true>(lds + RING_OFF, g, S, E, TID_NOW());
            } SEAM(pb + 5);
        }
        if (IN(pb + 6)) { REP(pb + 6) {
            unsigned char* ws = KWS(); PH_COMMON();
            pg8::Gemm g{(const bf16*)(ws + WS_F), (const bf16*)(ws + WS_WDN_T) + (size_t)L * DM * FFN, MP, DM, FFN}; pg8::StaticOrder S; S.init(MP, DM, G, bid);
            EpiResid E{(const float*)(ws + WS_XF), (float*)(ws + WS_PRE)};
            pg8::gemm_phase<EpiResid, pg8::StaticOrder, true, true>(lds + RING_OFF, g, S, E, TID_NOW());
            { int tid = TID_NOW(); asm volatile("" : "+v"(tid));
              for (int it = bid; it < 256; it += G) { const int rbk = it >> 5, cbk = it & 31; const size_t r0 = (size_t)MP + 64 * rbk;
                  skinny_item(lds + RING_OFF, (const bf16*)(ws + WS_F) + r0 * FFN, (const bf16*)(ws + WS_WDN_T) + (size_t)L * DM * FFN + (size_t)(32 * cbk) * FFN, FFN,
                              (const float*)(ws + WS_XF) + r0 * DM + 32 * cbk, (float*)(ws + WS_PRE) + r0 * DM + 32 * cbk, tid); } }
            } SEAM(pb + 6);
        }
        if (IN(pb + 7)) { REP(pb + 7) {
            int lane = LANE_ID(); asm volatile("" : "+v"(lane));
            unsigned char* ws = KWS(); PH_COMMON(); const float* lg = KIN(21) + L * DM; const float* lb = KIN(22) + L * DM;
            const bool last = (L == NLAYER - 1);
            float* dstf = last ? KOUT() + O_Y : (float*)(ws + WS_XF);
            for (int row = gw; row < MT; row += NGW) ln_row((const float*)(ws + WS_PRE) + (size_t)row * DM, lg, lb, dstf + (size_t)row * DM, last ? (bf16*)nullptr : (bf16*)(ws + WS_XB) + (size_t)row * DM, lane);
#if ATT_PROBE
            if (last) {
                const float* e = (const float*)(ws + WS_CTL) + CW_ERR;
                const float e0 = sqrtf(e[0] / fmaxf(e[1], 1e-30f)), e1 = sqrtf(e[2] / fmaxf(e[3], 1e-30f)), e2 = sqrtf(e[4] / fmaxf(e[5], 1e-30f));
                const float e3 = sqrtf(e[6] / fmaxf(e[7], 1e-30f)), e4 = sqrtf(e[8] / fmaxf(e[9], 1e-30f)), e5 = sqrtf(e[10] / fmaxf(e[11], 1e-30f));
                const float E = ATT_PROBE_SEL == 0 ? e0 : ATT_PROBE_SEL == 1 ? e1 : ATT_PROBE_SEL == 2 ? e2 : ATT_PROBE_SEL == 4 ? e3 : ATT_PROBE_SEL == 5 ? e4 : ATT_PROBE_SEL == 6 ? e5 : fmaxf(e0, fmaxf(e1, e2));
                float* o8 = KOUT() + O_GV;
                for (int i = bid * (NWAVES * 64) + wave * 64 + lane; i < NLAYER * MS * 512; i += NGT) o8[i] *= (1.0f + ATT_PROBE_GAIN * E);
            }
#endif
            } SEAM(pb + 7);
        }
    }
#undef IN
#undef SEAM
}

#ifndef SPLIT_LAUNCHES
#define SPLIT_LAUNCHES 0
#endif
extern "C" void kernel_launch(void* const* d_in, const int* in_sizes, int n_in, void* d_out, int out_size, void* d_ws, size_t ws_size, hipStream_t stream) {
    static int grid = 0;
    if (grid == 0) {
        if (n_in != 23 || (size_t)out_size != O_END || ws_size < WS_END) { fprintf(stderr, "kernel_launch: unexpected sizes (n_in %d, out %d, ws %zu); nothing launched\n", n_in, out_size, ws_size); grid = -1; return; }
        int dev = 0, cus = 0, per_cu = 0;
        if (hipGetDevice(&dev) != hipSuccess || hipDeviceGetAttribute(&cus, hipDeviceAttributeMultiprocessorCount, dev) != hipSuccess) { fprintf(stderr, "kernel_launch: device query failed\n"); grid = -1; return; }
        if (hipFuncSetAttribute((const void*)fwd, hipFuncAttributeMaxDynamicSharedMemorySize, LDS_BYTES) != hipSuccess) { fprintf(stderr, "kernel_launch: hipFuncSetAttribute failed\n"); grid = -1; return; }
        if (hipOccupancyMaxActiveBlocksPerMultiprocessor(&per_cu, (const void*)fwd, NWAVES * 64, LDS_BYTES) != hipSuccess || per_cu < 1) fprintf(stderr, "kernel_launch: note: occupancy query reports %d\n", per_cu);
        (void)hipGetLastError();
        grid = cus;
    }
    if (grid < 0) return;
    if (hipMemsetAsync((char*)d_ws + WS_CTL, 0, CTL_ZERO_BYTES, stream) != hipSuccess) { fprintf(stderr, "kernel_launch: memset failed\n"); return; }
    Args a{};
    for (int i = 0; i < 23; ++i) a.in[i] = (const float*)d_in[i];
    a.out = (float*)d_out; a.ws = (unsigned char*)d_ws;
#if SPLIT_LAUNCHES
    for (int ph = 0; ph < N_PHASES; ++ph) { a.ph_lo = ph; a.ph_hi = ph + 1; a.use_bar = 0; a.grid = grid;
        hipLaunchKernelGGL(fwd, dim3(grid), dim3(NWAVES * 64), LDS_BYTES, stream, a); }
#else
    a.ph_lo = 0; a.ph_hi = N_PHASES; a.use_bar = 1; a.grid = grid;
    hipLaunchKernelGGL(fwd, dim3(grid), dim3(NWAVES * 64), LDS_BYTES, stream, a);
#endif
    const hipError_t le = hipPeekAtLastError();
    if (le != hipSuccess) fprintf(stderr, "kernel_launch: launch failed: %s\n", hipGetErrorName(le));
}
```
